# Optimizing an MI355X kernel written in HIP

```python
import jax, jax.numpy as jnp
from jax import lax
import numpy as np

D_MODEL = 2048
BATCH = 4
SEQ = 2048
DEPTH = 1
DEC_BATCH = 128
DEC_SEQ = 1
PAST_LEN = 16384
PAGE_SIZE = 128

D_RNN = D_MODEL // 2
N_RNN_BLOCKS = 8
RNN_BLOCK = D_RNN // N_RNN_BLOCKS
CONV_W = 4
LRU_C = 8.0
D_POOL = D_MODEL // 2
POOL_WINDOWS = (2, 4, 8, 16)
N_POOL_GROUPS = len(POOL_WINDOWS)
POOL_GROUP = D_POOL // N_POOL_GROUPS
POOL_HIST = max(POOL_WINDOWS) - 1
N_MEM = 256
N_XHEADS = 4
XHEAD_DIM = D_MODEL // 8
D_X = N_XHEADS * XHEAD_DIM
N_BRANCH = 3
D_MIX = D_RNN + D_POOL + D_X
D_IN = 2 * D_MIX + N_BRANCH * D_MODEL
EPS = 1e-6

kernel_name = "hybrid_rglru_pool_memxattn_step"


def rmsnorm(x, g):
    xf = x.astype(jnp.float32)
    y = xf * lax.rsqrt(jnp.mean(xf * xf, axis=-1, keepdims=True) + EPS)
    return (y * g.astype(jnp.float32)).astype(x.dtype)


def causal_conv(x, buf, w, b):
    L = x.shape[1]
    ext = jnp.concatenate([buf.astype(x.dtype), x], axis=1)
    out = b + sum(w[k] * ext[:, k:k + L] for k in range(CONV_W))
    return out, ext[:, -(CONV_W - 1):]


def rg_lru(x, h0, w_a, b_a, w_x, b_x, lam):
    B, L, _ = x.shape
    xb = x.reshape(B, L, N_RNN_BLOCKS, RNN_BLOCK)
    r = jax.nn.sigmoid((jnp.einsum('blnd,nde->blne', xb, w_a).reshape(B, L, D_RNN) + b_a).astype(jnp.float32))
    i = jax.nn.sigmoid((jnp.einsum('blnd,nde->blne', xb, w_x).reshape(B, L, D_RNN) + b_x).astype(jnp.float32))
    log_a = -LRU_C * r * jax.nn.softplus(-lam.astype(jnp.float32))
    a = jnp.exp(log_a)
    mult = jnp.sqrt(-jnp.expm1(2.0 * log_a))
    bterm = mult * i * x.astype(jnp.float32)
    bterm = bterm.at[:, 0].add(a[:, 0] * h0.astype(jnp.float32))

    def combine(lhs, rhs):
        a1, b1 = lhs
        a2, b2 = rhs
        return a1 * a2, a2 * b1 + b2

    _, h = lax.associative_scan(combine, (a, bterm), axis=1)
    return h.astype(x.dtype), h[:, -1].astype(x.dtype)


def pool_mix(x, hist, pos, w_pool, pool_scale):
    L = x.shape[1]
    ext = jnp.concatenate([hist.astype(jnp.float32), x.astype(jnp.float32)], axis=1)
    cs = jnp.concatenate([jnp.zeros_like(ext[:, :1]), jnp.cumsum(ext, axis=1)], axis=1)
    end = cs[:, POOL_HIST + 1:POOL_HIST + 1 + L]
    xf = x.astype(jnp.float32)
    outs = []
    for g, w in enumerate(POOL_WINDOWS):
        c0, c1 = g * POOL_GROUP, (g + 1) * POOL_GROUP
        start = cs[:, POOL_HIST + 1 - w:POOL_HIST + 1 - w + L, c0:c1]
        cnt = jnp.minimum(pos + 1, w).astype(jnp.float32)[None, :, None]
        d = (end[..., c0:c1] - start) / cnt - xf[..., c0:c1]
        outs.append(jnp.einsum('bld,de->ble', d, w_pool[g].astype(jnp.float32)))
    out = jnp.concatenate(outs, axis=-1) * pool_scale.astype(jnp.float32)
    return out.astype(x.dtype), ext[:, -POOL_HIST:].astype(x.dtype)


def mem_kv(mem, g_mem, w_kv):
    B, M, _ = mem.shape
    kv = rmsnorm(mem, g_mem) @ w_kv
    k, v = jnp.split(kv, 2, axis=-1)
    return k.reshape(B, M, N_XHEADS, XHEAD_DIM), v.reshape(B, M, N_XHEADS, XHEAD_DIM)


def cross_attn(q, k, v):
    B, L = q.shape[:2]
    s = jnp.einsum('blhd,bmhd->bhlm', q, k).astype(jnp.float32) * (XHEAD_DIM ** -0.5)
    p = jax.nn.softmax(s, axis=-1)
    o = jnp.einsum('bhlm,bmhd->blhd', p.astype(v.dtype), v)
    return o.reshape(B, L, D_X)


def layer(x, pos, conv_buf, h0, pool_hist, mem_k, mem_v, g_pre, w_in, conv_w, conv_b,
          w_rg_a, b_rg_a, w_rg_x, b_rg_x, lru_lambda, w_pool, pool_scale, w_branch, w_out, g_post):
    B, L, _ = x.shape
    u = rmsnorm(x, g_pre)
    z = u @ w_in
    cuts = [D_RNN, 2 * D_RNN, 2 * D_RNN + D_POOL, 2 * D_RNN + 2 * D_POOL,
            2 * D_RNN + 2 * D_POOL + D_X, 2 * D_MIX]
    xr, gr, xp, gp, q, gx, gates = jnp.split(z, cuts, axis=-1)
    xr_c, new_conv = causal_conv(xr, conv_buf, conv_w, conv_b)
    h, h_last = rg_lru(xr_c, h0, w_rg_a, b_rg_a, w_rg_x, b_rg_x, lru_lambda)
    o_r = h * jax.nn.silu(gr)
    o_p, new_hist = pool_mix(xp, pool_hist, pos, w_pool, pool_scale)
    o_p = o_p * jax.nn.silu(gp)
    o_x = cross_attn(q.reshape(B, L, N_XHEADS, XHEAD_DIM), mem_k, mem_v) * jax.nn.silu(gx)
    y_r = o_r @ w_branch[:D_RNN]
    y_p = o_p @ w_branch[D_RNN:D_RNN + D_POOL]
    y_x = o_x @ w_branch[D_RNN + D_POOL:]
    gs = jax.nn.sigmoid(gates.astype(jnp.float32)).reshape(B, L, N_BRANCH, D_MODEL).astype(x.dtype)
    merged = gs[:, :, 0] * y_r + gs[:, :, 1] * y_p + gs[:, :, 2] * y_x
    out = merged @ w_out
    return x + rmsnorm(out, g_post), new_conv, h_last, new_hist


def setup_inputs(seed: int = 0) -> dict:
    key = jax.random.key(seed)
    ks = jax.random.split(key, 32)
    f32 = jnp.float32

    def nrm(k, shape, scale):
        return jax.random.normal(k, shape, f32) * scale

    a0 = jax.random.uniform(ks[12], (DEPTH, D_RNN), f32, 0.9, 0.999) ** (1.0 / LRU_C)
    return {
        'x_prompt': nrm(ks[0], (BATCH, SEQ, D_MODEL), 1.0),
        'x_sample': nrm(ks[1], (DEC_BATCH, DEC_SEQ, D_MODEL), 1.0),
        'mem_prompt': nrm(ks[2], (BATCH, N_MEM, D_MODEL), 1.0),
        'state_rglru_h': nrm(ks[3], (DEPTH, DEC_BATCH, D_RNN), 0.5),
        'state_conv': nrm(ks[4], (DEPTH, DEC_BATCH, CONV_W - 1, D_RNN), 1.0),
        'state_pool': nrm(ks[5], (DEPTH, DEC_BATCH, POOL_HIST, D_POOL), 1.0),
        'cache_mem_k': nrm(ks[6], (DEPTH, DEC_BATCH, N_MEM, N_XHEADS, XHEAD_DIM), 1.0),
        'cache_mem_v': nrm(ks[7], (DEPTH, DEC_BATCH, N_MEM, N_XHEADS, XHEAD_DIM), 1.0),
        'g_pre': 1.0 + nrm(ks[8], (DEPTH, D_MODEL), 0.05),
        'w_in': nrm(ks[9], (DEPTH, D_MODEL, D_IN), D_MODEL ** -0.5),
        'conv_w': nrm(ks[10], (DEPTH, CONV_W, D_RNN), CONV_W ** -0.5),
        'conv_b': nrm(ks[11], (DEPTH, D_RNN), 0.02),
        'w_rg_a': nrm(ks[13], (DEPTH, N_RNN_BLOCKS, RNN_BLOCK, RNN_BLOCK), RNN_BLOCK ** -0.5),
        'b_rg_a': nrm(ks[14], (DEPTH, D_RNN), 0.02),
        'w_rg_x': nrm(ks[15], (DEPTH, N_RNN_BLOCKS, RNN_BLOCK, RNN_BLOCK), RNN_BLOCK ** -0.5),
        'b_rg_x': nrm(ks[16], (DEPTH, D_RNN), 0.02),
        'lru_lambda': jnp.log(a0) - jnp.log1p(-a0),
        'w_pool': nrm(ks[17], (DEPTH, N_POOL_GROUPS, POOL_GROUP, POOL_GROUP), POOL_GROUP ** -0.5),
        'pool_scale': 1.0 + nrm(ks[18], (DEPTH, D_POOL), 0.05),
        'g_mem': 1.0 + nrm(ks[19], (DEPTH, D_MODEL), 0.05),
        'w_kv': nrm(ks[20], (DEPTH, D_MODEL, 2 * D_X), D_MODEL ** -0.5),
        'w_branch': nrm(ks[21], (DEPTH, D_MIX, D_MODEL), (D_MIX // N_BRANCH) ** -0.5),
        'w_out': nrm(ks[22], (DEPTH, D_MODEL, D_MODEL), D_MODEL ** -0.5),
        'g_post': 1.0 + nrm(ks[23], (DEPTH, D_MODEL), 0.05),
    }


def reference(x_prompt, x_sample, mem_prompt, state_rglru_h, state_conv, state_pool,
              cache_mem_k, cache_mem_v, g_pre, w_in, conv_w, conv_b, w_rg_a, b_rg_a,
              w_rg_x, b_rg_x, lru_lambda, w_pool, pool_scale, g_mem, w_kv, w_branch,
              w_out, g_post):
    B, S, _ = x_prompt.shape
    pos_p = jnp.arange(S, dtype=jnp.int32)
    pos_s = PAST_LEN + jnp.arange(x_sample.shape[1], dtype=jnp.int32)
    yp, ys = x_prompt, x_sample
    hp_l, cp_l, pp_l, mk_l, mv_l, hs_l, cs_l, ps_l = [], [], [], [], [], [], [], []
    for l in range(DEPTH):
        lw = (g_pre[l], w_in[l], conv_w[l], conv_b[l], w_rg_a[l], b_rg_a[l], w_rg_x[l],
              b_rg_x[l], lru_lambda[l], w_pool[l], pool_scale[l], w_branch[l], w_out[l], g_post[l])
        mk, mv = mem_kv(mem_prompt, g_mem[l], w_kv[l])
        zc = jnp.zeros((B, CONV_W - 1, D_RNN), yp.dtype)
        zh = jnp.zeros((B, D_RNN), yp.dtype)
        zp = jnp.zeros((B, POOL_HIST, D_POOL), yp.dtype)
        yp, c_p, h_p, p_p = layer(yp, pos_p, zc, zh, zp, mk, mv, *lw)
        ys, c_s, h_s, p_s = layer(ys, pos_s, state_conv[l], state_rglru_h[l], state_pool[l],
                                  cache_mem_k[l], cache_mem_v[l], *lw)
        hp_l.append(h_p); cp_l.append(c_p); pp_l.append(p_p); mk_l.append(mk); mv_l.append(mv)
        hs_l.append(h_s); cs_l.append(c_s); ps_l.append(p_s)
    new_h_prompt = jnp.stack(hp_l)
    new_conv_prompt = jnp.stack(cp_l)
    new_pool_prompt = jnp.stack(pp_l)
    mem_k_prompt = jnp.stack(mk_l)
    mem_v_prompt = jnp.stack(mv_l)
    new_h_sample = jnp.stack(hs_l)
    new_conv_sample = jnp.stack(cs_l)
    new_pool_sample = jnp.stack(ps_l)
    return (yp, ys, new_h_prompt, new_conv_prompt, new_pool_prompt, mem_k_prompt, mem_v_prompt,
            new_h_sample, new_conv_sample, new_pool_sample)
```

```cpp
#include <hip/hip_runtime.h>
#include <hip/hip_cooperative_groups.h>
#include <cstdio>
#include <cstdint>
namespace cg = cooperative_groups;

#define LAS __attribute__((address_space(3)))
typedef unsigned short bf16_t;
typedef short bf16x8 __attribute__((ext_vector_type(8)));
typedef short bf16x4 __attribute__((ext_vector_type(4)));
typedef float f32x4 __attribute__((ext_vector_type(4)));
typedef float f32x2 __attribute__((ext_vector_type(2)));
typedef unsigned u32x4 __attribute__((ext_vector_type(4)));
typedef unsigned u32x2 __attribute__((ext_vector_type(2)));

#ifndef MK_N_LAUNCHES
#define MK_N_LAUNCHES 1
#endif
#ifndef CG_SEAM_MASK
#define CG_SEAM_MASK 0
#endif
#define USE_CG_SEAM(k) (((CG_SEAM_MASK) >> (k)) & 1)
#ifndef PROBE_REPEAT
#define PROBE_REPEAT -1
#endif

constexpr int DM = 2048, NBATCH = 4, SEQ = 2048, NS = 128;
constexpr int MP = NBATCH * SEQ;
constexpr int MTOT = MP + NS;
constexpr int MPAD = 8448;
constexpr int DIN = 12288, DMIX = 3072, NMEM = 256;
constexpr int ZC_XR = 0, ZC_GR = 1024, ZC_XP = 2048, ZC_GP = 3072, ZC_Q = 4096, ZC_GX = 5120, ZC_GT = 6144;
constexpr float EPS = 1e-6f;
constexpr float LOG2E = 1.4426950408889634f;

constexpr size_t OFF_Y = 0;
constexpr size_t OFF_NHP = 17039360, OFF_NCP = 17043456, OFF_NPP = 17055744, OFF_MEMK = 17117184, OFF_MEMV = 18165760;
constexpr size_t OFF_NHS = 19214336, OFF_NCS = 19345408, OFF_NPS = 19738624, OUT_TOTAL = 21704704;

constexpr size_t MiB = 1u << 20;
constexpr size_t WS_CTL = 0, WS_WINT = 1 * MiB, WS_WKVT = 49 * MiB, WS_WBT = 57 * MiB, WS_WOT = 69 * MiB, WS_WRGT = 77 * MiB, WS_WPT = 77 * MiB + 512 * 1024;
constexpr size_t WS_U = 78 * MiB, WS_MEMN = 111 * MiB, WS_KB = 115 * MiB, WS_VT = 117 * MiB, WS_Z = 119 * MiB, WS_OALL = 317 * MiB, WS_PART = 367 * MiB;
constexpr size_t WS_MERGED = 433 * MiB, WS_OUTB = 466 * MiB, WS_END = 500 * MiB;
constexpr size_t WS_GR = WS_CTL + 256 * 1024;
constexpr size_t CTL_ZERO_BYTES = 65536;
constexpr int LDS_BYTES = 147456;
constexpr int LDS_MISC_OFF = 147200;

struct Params {
    const float* x_prompt; const float* x_sample; const float* mem; const float* st_h; const float* st_conv; const float* st_pool;
    const float* cache_k; const float* cache_v; const float* g_pre; const float* w_in; const float* conv_w; const float* conv_b;
    const float* w_rg_a; const float* b_rg_a; const float* w_rg_x; const float* b_rg_x; const float* lam; const float* w_pool;
    const float* pool_scale; const float* g_mem; const float* w_kv; const float* w_branch; const float* w_out; const float* g_post;
    float* out; unsigned char* ws; int ph_lo, ph_hi;
};

__device__ __forceinline__ unsigned f2bf(float f) { unsigned u = __builtin_bit_cast(unsigned, f); return (u + 0x7fffu + ((u >> 16) & 1u)) >> 16; }
__device__ __forceinline__ unsigned pk2(float lo, float hi) { unsigned r; asm volatile("v_cvt_pk_bf16_f32 %0, %1, %2" : "=v"(r) : "v"(lo), "v"(hi)); return r; }
__device__ __forceinline__ float bf_lo(unsigned u) { return __builtin_bit_cast(float, u << 16); }
__device__ __forceinline__ float bf_hi(unsigned u) { return __builtin_bit_cast(float, u & 0xffff0000u); }
__device__ __forceinline__ float bf2f(bf16_t b) { return __builtin_bit_cast(float, ((unsigned)b) << 16); }
__device__ __forceinline__ unsigned cvt_pk_bf16(float lo, float hi) { unsigned r; asm volatile("v_cvt_pk_bf16_f32 %0, %1, %2" : "=v"(r) : "v"(lo), "v"(hi)); return r; }
__device__ __forceinline__ float wave_sum(float v) {
#pragma unroll
    for (int o = 1; o < 64; o <<= 1) v += __shfl_xor(v, o);
    return v;
}
__device__ __forceinline__ float wave_max(float v) {
#pragma unroll
    for (int o = 1; o < 64; o <<= 1) v = fmaxf(v, __shfl_xor(v, o));
    return v;
}
__device__ __forceinline__ float sigmoid_f(float x) { return __builtin_amdgcn_rcpf(1.0f + __builtin_amdgcn_exp2f(-x * LOG2E)); }
__device__ __forceinline__ float silu_f(float x) { return x * sigmoid_f(x); }


#define XB_TMO      128
#define XB_XCNT(j)  (256  + 64 * (j))
#define XB_XSUB(j)  (1280 + 64 * (j))
#define XB_XGEN(j)  (2304 + 64 * (j))
#define XB_TOP      3328
#define XB_TOPGEN   3392
#define XCD_BAR_WORDS 3456
#define XB_SPIN_CAP (1u << 18)
__device__ __forceinline__ unsigned xb_ld(unsigned* p)              { return __hip_atomic_load(p, __ATOMIC_RELAXED, __HIP_MEMORY_SCOPE_AGENT); }
__device__ __forceinline__ unsigned xb_add(unsigned* p, unsigned v) { return __hip_atomic_fetch_add(p, v, __ATOMIC_RELAXED, __HIP_MEMORY_SCOPE_AGENT); }
__device__ __forceinline__ unsigned xb_xcc_id() { return (unsigned)__builtin_amdgcn_s_getreg((3 << 11) | 20) & 0xFu; }
#define XB_SPIN(cond, bar) do { unsigned _sp = 0; while (cond) { __builtin_amdgcn_s_sleep(1); \
    if ((++_sp & 255u) == 0u) { if (xb_ld(&(bar)[XB_TMO])) break; if (_sp > XB_SPIN_CAP) { atomicAdd(&(bar)[XB_TMO], 1u); break; } } } } while (0)
struct XcdBarrier { unsigned* bar; unsigned x; volatile LAS unsigned* st; };
__device__ __forceinline__ XcdBarrier xcd_barrier_post(unsigned* bar, volatile LAS unsigned* st) {
    XcdBarrier b; b.bar = bar; b.x = xb_xcc_id(); b.st = st;
    if (threadIdx.x == 0) (void)xb_add(&bar[XB_XCNT(b.x)], 1u);
    return b;
}
__device__ __forceinline__ void xcd_barrier_complete(unsigned* bar, unsigned x, unsigned& nloc, unsigned& nx) {
    const unsigned G = gridDim.x * gridDim.y * gridDim.z;
    unsigned sum, cnt, mine, sp = 0u;
    for (;;) {
        sum = 0u; cnt = 0u; mine = 0u;
#pragma unroll
        for (unsigned j = 0; j < 16; ++j) { const unsigned c = xb_ld(&bar[XB_XCNT(j)]); sum += c; cnt += (c > 0u) ? 1u : 0u; mine = (j == x) ? c : mine; }
        if (sum == G) break;
        __builtin_amdgcn_s_sleep(1);
        if ((++sp & 255u) == 0u) { if (xb_ld(&bar[XB_TMO])) break; if (sp > XB_SPIN_CAP) { atomicAdd(&bar[XB_TMO], 1u); break; } }
    }
    nloc = mine > 0u ? mine : 1u; nx = cnt > 0u ? cnt : 1u;
}
__device__ __forceinline__ void xcd_barrier(const XcdBarrier& b) {
    asm volatile("s_waitcnt vmcnt(0)" ::: "memory");
    __syncthreads();
    if (threadIdx.x == 0) {
        unsigned* bar = b.bar;
        __builtin_amdgcn_s_waitcnt(0);
        unsigned nloc = b.st[0], nx = b.st[1];
        if (nloc == 0u) { xcd_barrier_complete(bar, b.x, nloc, nx); b.st[0] = nloc; b.st[1] = nx; }
        const unsigned old = xb_add(&bar[XB_XSUB(b.x)], 1u);
        const unsigned gen = old / nloc;
        if (old + 1u == (gen + 1u) * nloc) {
            __builtin_amdgcn_fence(__ATOMIC_RELEASE, "agent");
            asm volatile("s_waitcnt vmcnt(0)" ::: "memory");
            const unsigned og = xb_add(&bar[XB_TOP], 1u);
            const unsigned tg = og / nx;
            if (og + 1u == (tg + 1u) * nx) xb_add(&bar[XB_TOPGEN], 1u);
            else XB_SPIN(xb_ld(&bar[XB_TOPGEN]) == tg, bar);
            __builtin_amdgcn_fence(__ATOMIC_ACQUIRE, "agent");
            xb_add(&bar[XB_XGEN(b.x)], 1u);
            asm volatile("s_waitcnt vmcnt(0)" ::: "memory");
        } else {
            XB_SPIN(xb_ld(&bar[XB_XGEN(b.x)]) == gen, bar);
            __builtin_amdgcn_fence(__ATOMIC_ACQUIRE, "agent");
            asm volatile("s_waitcnt vmcnt(0)" ::: "memory");
        }
    }
    __syncthreads();
}

namespace pg8 {
constexpr int BM = 256, BK = 64, HALF = 128, HTB = HALF * BK * 2, STAGE_BYTES = 8 * HTB, NXCD = 8, WGM = 4;
__device__ __forceinline__ int lds_byte(int r, int c) { const int st = (r >> 4) * 2 + (c >> 5), rr = r & 15, cc = c & 31, ob = rr * 64 + cc * 2; return st * 1024 + (ob ^ (((ob >> 9) & 1) << 5)); }
__device__ __forceinline__ void stage_rc(int b, int& R, int& C) { const int st = b / 1024, sb = b % 1024, swz = sb ^ (((sb >> 9) & 1) << 5); R = (st >> 1) * 16 + swz / 64; C = (st & 1) * 32 + (swz % 64) / 2; }
__device__ __forceinline__ int perm32(int rho) { const int n = rho >> 4, i = rho & 15; return 8 * (i >> 2) + 4 * n + (i & 3); }

struct Unit { const char* A; const char* B; int pm, pn, kind, aux, nt, half, ks, grp; };
struct TileOrder {
    int nM, nN, nwg;
    __device__ __forceinline__ void init(int nM_, int nN_) { nM = nM_; nN = nN_; nwg = nM_ * nN_; }
    __device__ __forceinline__ void map(int L, int& pm, int& pn) const {
        int wgid = L; { const int q = nwg / NXCD, r = nwg % NXCD, xcd = wgid % NXCD, off = wgid / NXCD; wgid = (xcd < r ? xcd * (q + 1) : r * (q + 1) + (xcd - r) * q) + off; }
        const int nig = WGM * nN, gid = wgid / nig, fm = gid * WGM, gsz = (nM - fm) < WGM ? (nM - fm) : WGM;
        pm = fm + ((wgid % nig) % gsz); pn = (wgid % nig) / gsz;
    }
};

template <class Epi, class Sched>
__device__ __forceinline__ void gemm_phase(LAS unsigned char* lds, const int lda, const int ldb, const Sched& S, const Epi& E) {
    const int tid = threadIdx.x, wid = __builtin_amdgcn_readfirstlane(tid >> 6), lane = tid & 63, wr = wid >> 2, wc = wid & 3, fr = lane & 15, fq = lane >> 4;
    unsigned voffA[2], voffB[2];
#pragma unroll
    for (int i = 0; i < 2; ++i) { int R, C; stage_rc(tid * 16 + i * 8192, R, C); const int Rb = (R & ~31) + perm32(R & 31);
        voffA[i] = (unsigned)(R * lda + C) * 2u; voffB[i] = (unsigned)(Rb * ldb + C) * 2u; }
    const size_t kstep = (size_t)(BK * 2);
    const size_t hstepA = (size_t)HALF * lda * 2, hstepB = (size_t)HALF * ldb * 2;
    const unsigned ldsw = (unsigned)wid * 1024u;
    const int aoff = lds_byte(wr * 64 + fr, fq * 8), boff = lds_byte(wc * 32 + fr, fq * 8);
#define PG8_SA(b, h) (((b) * 2 + (h)) * HTB)
#define PG8_SB(b, h) ((4 + (b) * 2 + (h)) * HTB)
#define PG8_STAGE(bufoff, gbase, voff) do { _Pragma("unroll") for (int _i = 0; _i < 2; ++_i) \
        __builtin_amdgcn_global_load_lds((const unsigned*)((const char*)(gbase) + (voff)[_i]), (LAS unsigned*)(lds + (bufoff) + ldsw + _i * 8192), 16, 0, 0); } while (0)
#define PG8_LDA(dst, b, h) do { _Pragma("unroll") for (int m = 0; m < 4; ++m) _Pragma("unroll") for (int k = 0; k < 2; ++k) dst[m][k] = *(const LAS bf16x8*)(lds + PG8_SA(b, h) + aoff + m * 2048 + k * 1024); } while (0)
#define PG8_LDB(dst, b, h) do { _Pragma("unroll") for (int n = 0; n < 2; ++n) _Pragma("unroll") for (int k = 0; k < 2; ++k) dst[n][k] = *(const LAS bf16x8*)(lds + PG8_SB(b, h) + boff + n * 2048 + k * 1024); } while (0)
#define PG8_MMA(ai, bj, At, Bt) do { __builtin_amdgcn_s_setprio(1); _Pragma("unroll") for (int m = 0; m < 4; ++m) _Pragma("unroll") for (int n = 0; n < 2; ++n) _Pragma("unroll") for (int k = 0; k < 2; ++k) \
        acc[ai][bj][m][n] = __builtin_amdgcn_mfma_f32_16x16x32_bf16(Bt[n][k], At[m][k], acc[ai][bj][m][n], 0, 0, 0); __builtin_amdgcn_s_setprio(0); } while (0)
#define PG8_WAIT_V(n) asm volatile("s_waitcnt vmcnt(" #n ")" ::: "memory")
#define PG8_WAIT_L(n) asm volatile("s_waitcnt lgkmcnt(" #n ")" ::: "memory")
#define PG8_BAR __builtin_amdgcn_s_barrier()
#define PG8_SCHED __builtin_amdgcn_sched_barrier(0)
    Unit cur, nxt; int ui = 0;
    if (!S.next(0, cur)) return;
    f32x4 acc[2][2][4][2];
#pragma unroll
    for (int a = 0; a < 2; ++a)
#pragma unroll
        for (int b = 0; b < 2; ++b)
#pragma unroll
            for (int m = 0; m < 4; ++m)
#pragma unroll
                for (int n = 0; n < 2; ++n) acc[a][b][m][n] = (f32x4){0.f, 0.f, 0.f, 0.f};
    bf16x8 At[4][2], B0[2][2], B1[2][2];
    const char* cA = cur.A; const char* cB = cur.B;
    PG8_STAGE(PG8_SB(0, 0), cB, voffB); PG8_STAGE(PG8_SB(0, 1), cB + hstepB, voffB); PG8_STAGE(PG8_SA(0, 0), cA, voffA); PG8_STAGE(PG8_SA(0, 1), cA + hstepA, voffA);
    if (wr == 1) PG8_BAR;
    PG8_WAIT_V(2); PG8_BAR;
    PG8_STAGE(PG8_SB(1, 0), cB + kstep, voffB); PG8_STAGE(PG8_SA(1, 0), cA + kstep, voffA); PG8_STAGE(PG8_SB(1, 1), cB + hstepB + kstep, voffB);
    PG8_WAIT_V(6); PG8_BAR;
    for (;;) {
        const bool has_next = S.next(ui + 1, nxt);
        const char* nA = has_next ? nxt.A : cA; const char* nB = has_next ? nxt.B : cB;
        const int nt = cur.nt; const bool full = (cur.half == 0);
        for (int t = 0; t < nt; t += 2) {
            const bool last = (t == nt - 2);
            if (last && has_next) S.a_ready(nxt);
            const char* a1 = cA + (size_t)(t + 1) * kstep;
            const char* a2 = last ? nA : cA + (size_t)(t + 2) * kstep; const char* b2 = last ? nB : cB + (size_t)(t + 2) * kstep;
            const char* a3 = a2 + kstep; const char* b3 = b2 + kstep;
            PG8_LDB(B0, 0, 0); PG8_LDB(B1, 0, 1); PG8_SCHED; PG8_LDA(At, 0, 0); PG8_STAGE(PG8_SA(1, 1), a1 + hstepA, voffA);
            PG8_WAIT_V(8); PG8_WAIT_L(0); PG8_BAR; PG8_MMA(0, 0, At, B0); PG8_MMA(0, 1, At, B1); PG8_BAR; PG8_SCHED;
            PG8_LDA(At, 0, 1); PG8_STAGE(PG8_SB(0, 0), b2, voffB); PG8_STAGE(PG8_SB(0, 1), b2 + hstepB, voffB); PG8_STAGE(PG8_SA(0, 0), a2, voffA);
            PG8_WAIT_V(8); PG8_WAIT_L(0); PG8_BAR; if (full) { PG8_MMA(1, 0, At, B0); PG8_MMA(1, 1, At, B1); } PG8_BAR; PG8_SCHED;
            PG8_LDB(B0, 1, 0); PG8_LDB(B1, 1, 1); PG8_SCHED; PG8_LDA(At, 1, 0); PG8_STAGE(PG8_SA(0, 1), a2 + hstepA, voffA);
            PG8_WAIT_V(8); PG8_WAIT_L(0); PG8_BAR; PG8_MMA(0, 0, At, B0); PG8_MMA(0, 1, At, B1); PG8_BAR; PG8_SCHED;
            PG8_LDA(At, 1, 1); PG8_STAGE(PG8_SB(1, 0), b3, voffB); PG8_STAGE(PG8_SB(1, 1), b3 + hstepB, voffB); PG8_STAGE(PG8_SA(1, 0), a3, voffA);
            PG8_WAIT_V(8); PG8_WAIT_L(0); PG8_BAR; if (full) { PG8_MMA(1, 0, At, B0); PG8_MMA(1, 1, At, B1); } PG8_BAR; PG8_SCHED;
        }
        if (wr == 0) PG8_BAR;
        E(acc, cur, wr, wc, fr, fq);
        if (!has_next) break;
#pragma unroll
        for (int a = 0; a < 2; ++a)
#pragma unroll
            for (int b = 0; b < 2; ++b)
#pragma unroll
                for (int m = 0; m < 4; ++m)
#pragma unroll
                    for (int n = 0; n < 2; ++n) acc[a][b][m][n] = (f32x4){0.f, 0.f, 0.f, 0.f};
        cur = nxt; cA = nA; cB = nB; ++ui;
        if (wr == 1) PG8_BAR;
    }
    PG8_WAIT_V(0);
    PG8_BAR;
#undef PG8_SA
#undef PG8_SB
#undef PG8_STAGE
#undef PG8_LDA
#undef PG8_LDB
#undef PG8_MMA
#undef PG8_WAIT_V
#undef PG8_WAIT_L
#undef PG8_BAR
#undef PG8_SCHED
}
}

constexpr int SLAB_FLOATS = 32 * 512 * 4;
constexpr int CW_CNT = 4096;
constexpr int CNT_P1S = 0, CNT_P1KV = 48, CNT_P3S = 80, CNT_P4S = 88;
constexpr int CW_DONE4 = 10240;
constexpr int CW_DONE = 13312;
template <int NSL, bool HALF, int KS>
__device__ __forceinline__ unsigned share_body(f32x4 (&acc)[2][2][4][2], const float* slabs, int tid) {
    unsigned mask = 0;
    const f32x4* p0 = (const f32x4*)slabs + tid;
#pragma unroll
    for (int c = 0; c < (HALF ? 8 : 16); ++c) { if (c % NSL != KS) continue;
        const int ai = c >> 3, bj = (c >> 2) & 1, m = c & 3; mask |= 1u << c;
#pragma unroll
        for (int s = 0; s < NSL; ++s) { if (s == KS) continue;
            acc[ai][bj][m][0] += p0[(size_t)s * (SLAB_FLOATS / 4) + (size_t)(c * 2 + 0) * 512]; acc[ai][bj][m][1] += p0[(size_t)s * (SLAB_FLOATS / 4) + (size_t)(c * 2 + 1) * 512]; }
        asm volatile("" ::: "memory"); }
    return mask;
}
template <int NSL, bool HALF>
__device__ __forceinline__ unsigned splitk_share(f32x4 (&acc)[2][2][4][2], float* slabs, int ks, unsigned* cnt, volatile LAS unsigned* misc) {
    int tid_ = threadIdx.x; asm volatile("" : "+v"(tid_));
    const int tid = tid_;
    {
      const unsigned long long pa = (unsigned long long)(slabs + (size_t)ks * SLAB_FLOATS);
      const unsigned plo = __builtin_amdgcn_readfirstlane((unsigned)pa), phi = __builtin_amdgcn_readfirstlane((unsigned)(pa >> 32));
      const __amdgpu_buffer_rsrc_t rs = __builtin_amdgcn_make_buffer_rsrc((void*)(((unsigned long long)phi << 32) | plo), (short)0, SLAB_FLOATS * 4, 0x00020000);
#pragma unroll
      for (int ai = 0; ai < (HALF ? 1 : 2); ++ai)
#pragma unroll
          for (int bj = 0; bj < 2; ++bj)
#pragma unroll
              for (int m = 0; m < 4; ++m)
#pragma unroll
                  for (int n = 0; n < 2; ++n) __builtin_amdgcn_raw_buffer_store_b128(__builtin_bit_cast(u32x4, acc[ai][bj][m][n]), rs, (unsigned)tid * 16u, ((((ai * 2 + bj) * 4 + m) * 2 + n) * 512) * 16, 16); }
    asm volatile("s_waitcnt vmcnt(0)" ::: "memory");
    __syncthreads();
    if (tid == 0) {
        (void)__hip_atomic_fetch_add(cnt, 1u, __ATOMIC_RELAXED, __HIP_MEMORY_SCOPE_AGENT);
        unsigned spins = 0;
        while (__hip_atomic_load(cnt, __ATOMIC_RELAXED, __HIP_MEMORY_SCOPE_AGENT) < (unsigned)NSL) { __builtin_amdgcn_s_sleep(2); if (++spins > (1u << 21)) break; }
        __builtin_amdgcn_fence(__ATOMIC_ACQUIRE, "agent"); asm volatile("s_waitcnt vmcnt(0)" ::: "memory");
    }
    __syncthreads();
    unsigned mask = 0;
    if (NSL >= 1 && ks == 0) mask = share_body<NSL, HALF, 0>(acc, slabs, tid);
    if (NSL >= 2 && ks == 1) mask = share_body<NSL, HALF, (NSL >= 2 ? 1 : 0)>(acc, slabs, tid);
    if (NSL >= 3 && ks == 2) mask = share_body<NSL, HALF, (NSL >= 3 ? 2 : 0)>(acc, slabs, tid);
    if (NSL >= 4 && ks == 3) mask = share_body<NSL, HALF, (NSL >= 4 ? 3 : 0)>(acc, slabs, tid);
    if (NSL >= 5 && ks == 4) mask = share_body<NSL, HALF, (NSL >= 5 ? 4 : 0)>(acc, slabs, tid);
    if (NSL >= 6 && ks == 5) mask = share_body<NSL, HALF, (NSL >= 6 ? 5 : 0)>(acc, slabs, tid);
    return mask;
}

__device__ __forceinline__ void publish_count(unsigned* ctr) {
    asm volatile("s_waitcnt vmcnt(0)" ::: "memory"); __syncthreads();
    if (threadIdx.x == 0) { __builtin_amdgcn_fence(__ATOMIC_RELEASE, "agent"); asm volatile("s_waitcnt vmcnt(0)" ::: "memory"); __hip_atomic_fetch_add(ctr, 1u, __ATOMIC_RELAXED, __HIP_MEMORY_SCOPE_AGENT); }
}
__device__ __forceinline__ void publish_count_wt(unsigned* ctr) {
    asm volatile("s_waitcnt vmcnt(0)" ::: "memory"); __syncthreads();
    if (threadIdx.x == 0) __hip_atomic_fetch_add(ctr, 1u, __ATOMIC_RELAXED, __HIP_MEMORY_SCOPE_AGENT);
}
__device__ __forceinline__ void poll_count(unsigned* ctr, unsigned need) {
    unsigned spins = 0;
    while (__hip_atomic_load(ctr, __ATOMIC_RELAXED, __HIP_MEMORY_SCOPE_AGENT) < need) { __builtin_amdgcn_s_sleep(4); if (++spins > (1u << 21)) break; }
    __builtin_amdgcn_fence(__ATOMIC_ACQUIRE, "agent"); asm volatile("s_waitcnt vmcnt(0)" ::: "memory");
}

struct SchedP1 {
    int mode; int G, c; pg8::TileOrder to; const char* U; const char* WinT; const char* MEMN; const char* WkvT;
    __device__ __forceinline__ void a_ready(const pg8::Unit&) const {}
    __device__ __forceinline__ bool next(int i, pg8::Unit& u) const {
        const int L = i * G + c;
        int e;
        if (mode == 1) e = L;
        else { if (L < 32 * 48) { int pm, pn; to.map(L, pm, pn); u.A = U + (size_t)pm * 256 * 2048 * 2; u.B = WinT + (size_t)pn * 256 * 2048 * 2; u.pm = pm; u.pn = pn; u.kind = 0; u.nt = 32; u.half = 0; u.ks = 0; u.grp = 0; return true; }
            if (mode == 0) return false;
            e = L - 32 * 48; }
        if (e >= 80) return false;
        u.nt = 32; u.ks = 0; u.grp = 0;
        if (e < 32) { const int pm = e & 3, pn = e >> 2;
            u.A = MEMN + (size_t)pm * 256 * 2048 * 2; u.B = WkvT + (size_t)pn * 256 * 2048 * 2; u.pm = pm; u.pn = pn; u.kind = 2; u.half = 0; }
        else { const int t = e - 32;
            u.A = U + (size_t)32 * 256 * 2048 * 2; u.B = WinT + (size_t)t * 256 * 2048 * 2; u.pm = 32; u.pn = t; u.kind = 1; u.half = 1; }
        return true;
    }
};
template <bool EXTRA>
struct EpiP1T {
    bf16_t* Z; float* out; bf16_t* KB; bf16_t* VT; float* slabs; unsigned* cnt; volatile LAS unsigned* misc; unsigned* done; LAS unsigned char* ldsx;
    __device__ __forceinline__ void publish(int which) const {
        asm volatile("s_waitcnt vmcnt(0)" ::: "memory"); __syncthreads();
        if (threadIdx.x == 0) __hip_atomic_fetch_add(done + 64 * which, 1u, __ATOMIC_RELAXED, __HIP_MEMORY_SCOPE_AGENT);
    }
    __device__ __forceinline__ void operator()(f32x4 (&acc)[2][2][4][2], const pg8::Unit& u, int wr, int wc, int fr, int fq) const {
        const int row0 = u.pm * 256 + wr * 64 + fr, col0 = u.pn * 256 + wc * 32 + 8 * fq;
        unsigned cm = 0xffffu;

        if (!EXTRA || u.kind != 2) {
            const int seg = u.pn >> 2;
            const int act = (seg >= 6) ? 2 : ((seg & 1) ? 1 : 0);
#pragma unroll
            for (int ai = 0; ai < 2; ++ai) { if (ai == 1 && u.half) break;
#pragma unroll
                for (int m = 0; m < 4; ++m) { bf16_t* rowp = Z + (size_t)(row0 + ai * 128 + m * 16) * DIN + col0;
#pragma unroll
                    for (int bj = 0; bj < 2; ++bj) { if (EXTRA && !((cm >> ((ai * 2 + bj) * 4 + m)) & 1u)) continue;
                        f32x4 v0 = acc[ai][bj][m][0], v1 = acc[ai][bj][m][1];
                        if (act == 1) {
#pragma unroll
                            for (int j = 0; j < 4; ++j) { v0[j] = silu_f(v0[j]); v1[j] = silu_f(v1[j]); } }
                        else if (act == 2) {
#pragma unroll
                            for (int j = 0; j < 4; ++j) { v0[j] = sigmoid_f(v0[j]); v1[j] = sigmoid_f(v1[j]); } }
                        u32x4 w; w.x = cvt_pk_bf16(v0[0], v0[1]); w.y = cvt_pk_bf16(v0[2], v0[3]); w.z = cvt_pk_bf16(v1[0], v1[1]); w.w = cvt_pk_bf16(v1[2], v1[3]);
                        if (!EXTRA) __builtin_nontemporal_store(w, (u32x4*)(rowp + bj * 128));
                        else __builtin_amdgcn_raw_buffer_store_b128(w, __builtin_amdgcn_make_buffer_rsrc((void*)Z, (short)0, (int)((size_t)MPAD * DIN * 2), 0x00020000), (unsigned)((row0 + ai * 128 + m * 16) * DIN + col0 + bj * 128) * 2u, 0, 16); } } }
            if (EXTRA) publish(1);
        } else {
            const bool isV = u.pn >= 4;
            const int c0 = isV ? col0 - 1024 : col0;
            float* ob = out + (isV ? OFF_MEMV : OFF_MEMK);
            const __amdgpu_buffer_rsrc_t kvrs = __builtin_amdgcn_make_buffer_rsrc((void*)(isV ? VT : KB), (short)0, 1024 * 1024 * 2, 0x00020000);
#pragma unroll
            for (int ai = 0; ai < 2; ++ai)
#pragma unroll
                for (int m = 0; m < 4; ++m) { const int row = row0 + ai * 128 + m * 16;
#pragma unroll
                    for (int bj = 0; bj < 2; ++bj) { if (!((cm >> ((ai * 2 + bj) * 4 + m)) & 1u)) continue;
                        const f32x4 v0 = acc[ai][bj][m][0], v1 = acc[ai][bj][m][1]; const int col = c0 + bj * 128;
                        __builtin_nontemporal_store(v0, (f32x4*)(ob + (size_t)row * 1024 + col)); __builtin_nontemporal_store(v1, (f32x4*)(ob + (size_t)row * 1024 + col + 4));
                        u32x4 w; w.x = cvt_pk_bf16(v0[0], v0[1]); w.y = cvt_pk_bf16(v0[2], v0[3]); w.z = cvt_pk_bf16(v1[0], v1[1]); w.w = cvt_pk_bf16(v1[2], v1[3]);
                        if (!isV) __builtin_amdgcn_raw_buffer_store_b128(w, kvrs, (unsigned)(row * 1024 + col) * 2u, 0, 16);
                        else {
                            LAS unsigned char* pc = ldsx + 131072 + (threadIdx.x >> 6) * 1024;
                            *(LAS u32x4*)(pc + fr * 64 + fq * 16) = w;
                            asm volatile("s_waitcnt lgkmcnt(0)" ::: "memory");
                            const int lane = threadIdx.x & 63, tc = lane >> 1, th = lane & 1;
                            const LAS bf16_t* rp = (const LAS bf16_t*)(pc + (8 * th) * 64 + tc * 2);
                            u32x4 t; t.x = (unsigned)rp[0 * 32] | ((unsigned)rp[1 * 32] << 16); t.y = (unsigned)rp[2 * 32] | ((unsigned)rp[3 * 32] << 16);
                            t.z = (unsigned)rp[4 * 32] | ((unsigned)rp[5 * 32] << 16); t.w = (unsigned)rp[6 * 32] | ((unsigned)rp[7 * 32] << 16);
                            const int colb = (u.pn - 4) * 256 + wc * 32 + bj * 128, rowb = u.pm * 256 + wr * 64 + ai * 128 + m * 16;
                            __builtin_amdgcn_raw_buffer_store_b128(t, kvrs, (unsigned)((colb + tc) * 1024 + rowb + 8 * th) * 2u, 0, 16);
                            asm volatile("s_waitcnt lgkmcnt(0)" ::: "memory"); } } }
            publish(0);
        }
    }
};
__device__ __forceinline__ void wait_done(unsigned* done) {
    if (threadIdx.x == 0) { unsigned spins = 0;
        while (__hip_atomic_load(done, __ATOMIC_RELAXED, __HIP_MEMORY_SCOPE_AGENT) < 32u || __hip_atomic_load(done + 64, __ATOMIC_RELAXED, __HIP_MEMORY_SCOPE_AGENT) < 48u) { __builtin_amdgcn_s_sleep(8); if (++spins > (1u << 21)) break; }
        __builtin_amdgcn_fence(__ATOMIC_ACQUIRE, "agent"); asm volatile("s_waitcnt vmcnt(0)" ::: "memory"); }
    __syncthreads();
}
struct SchedP3 {
    int G, c; pg8::TileOrder to; const char* OALL; const char* WbT;
    __device__ __forceinline__ void a_ready(const pg8::Unit&) const {}
    __device__ __forceinline__ bool next(int i, pg8::Unit& u) const {
        const int nmine = (32 * 8 - c + G - 1) / G;
        if (i < 3 * nmine) { const int ti = i / 3, j = i - 3 * ti; const int L = ti * G + c;
            int pm, pn; to.map(L, pm, pn);
            u.A = OALL + ((size_t)pm * 256 * DMIX + (size_t)j * 1024) * 2; u.B = WbT + ((size_t)pn * 256 * DMIX + (size_t)j * 1024) * 2; u.pm = pm; u.pn = pn; u.kind = 0; u.aux = j; u.nt = 16; u.half = 0; u.ks = 0; u.grp = 0; return true; }
        const int e = (i - 3 * nmine) * G + c;
        if (e >= 48) return false;
        const int pn = e / 6, r = e - 6 * pn, j = r >> 1, k2 = r & 1;
        u.A = OALL + ((size_t)32 * 256 * DMIX + (size_t)j * 1024 + (size_t)k2 * 512) * 2; u.B = WbT + ((size_t)pn * 256 * DMIX + (size_t)j * 1024 + (size_t)k2 * 512) * 2;
        u.pm = 32; u.pn = pn; u.kind = 1; u.aux = j; u.nt = 8; u.half = 1; u.ks = r; u.grp = pn; return true;
    }
};
struct EpiP3 {
    const bf16_t* Z; bf16_t* PART; bf16_t* MERGED; float* slabs; unsigned* cnt; volatile LAS unsigned* misc; unsigned* done3;
    __device__ __forceinline__ void operator()(f32x4 (&acc)[2][2][4][2], const pg8::Unit& u, int wr, int wc, int fr, int fq) const {
        const int row0 = u.pm * 256 + wr * 64 + fr, col0 = u.pn * 256 + wc * 32 + 8 * fq, j = u.aux;
        if (u.kind == 0) {
            const __amdgpu_buffer_rsrc_t mrs = __builtin_amdgcn_make_buffer_rsrc((void*)MERGED, (short)0, (int)((size_t)MPAD * DM * 2), 0x00020000);
#pragma unroll
            for (int ai = 0; ai < 2; ++ai)
#pragma unroll
                for (int m = 0; m < 4; ++m) { const size_t row = (size_t)(row0 + ai * 128 + m * 16);
#pragma unroll
                    for (int bj = 0; bj < 2; ++bj) { const int col = col0 + bj * 128;
                        const u32x4 g = __builtin_nontemporal_load((const u32x4*)(Z + row * DIN + ZC_GT + j * DM + col));
                        f32x4 p0 = (f32x4){0.f, 0.f, 0.f, 0.f}, p1 = p0;
                        if (j > 0) { const u32x4 pp = *(const u32x4*)(PART + row * DM + col); p0 = (f32x4){bf_lo(pp.x), bf_hi(pp.x), bf_lo(pp.y), bf_hi(pp.y)}; p1 = (f32x4){bf_lo(pp.z), bf_hi(pp.z), bf_lo(pp.w), bf_hi(pp.w)}; }
                        const f32x4 a0 = acc[ai][bj][m][0], a1 = acc[ai][bj][m][1];
                        p0[0] += bf_lo(g.x) * a0[0]; p0[1] += bf_hi(g.x) * a0[1]; p0[2] += bf_lo(g.y) * a0[2]; p0[3] += bf_hi(g.y) * a0[3];
                        p1[0] += bf_lo(g.z) * a1[0]; p1[1] += bf_hi(g.z) * a1[1]; p1[2] += bf_lo(g.w) * a1[2]; p1[3] += bf_hi(g.w) * a1[3];
                        u32x4 w; w.x = cvt_pk_bf16(p0[0], p0[1]); w.y = cvt_pk_bf16(p0[2], p0[3]); w.z = cvt_pk_bf16(p1[0], p1[1]); w.w = cvt_pk_bf16(p1[2], p1[3]);
                        if (j < 2) *(u32x4*)(PART + row * DM + col) = w;
                        else __builtin_amdgcn_raw_buffer_store_b128(w, mrs, (unsigned)(row * DM + col) * 2u, 0, 16); } }
            if (j == 2) publish_count_wt(done3 + 64 * u.pm);
        } else {
#pragma unroll
            for (int m = 0; m < 4; ++m) { const size_t row = (size_t)(row0 + m * 16);
#pragma unroll
                for (int bj = 0; bj < 2; ++bj) { const int col = col0 + bj * 128;
                    const u32x4 g = __builtin_nontemporal_load((const u32x4*)(Z + row * DIN + ZC_GT + j * DM + col));
                    f32x4& a0 = acc[0][bj][m][0]; f32x4& a1 = acc[0][bj][m][1];
                    a0[0] *= bf_lo(g.x); a0[1] *= bf_hi(g.x); a0[2] *= bf_lo(g.y); a0[3] *= bf_hi(g.y);
                    a1[0] *= bf_lo(g.z); a1[1] *= bf_hi(g.z); a1[2] *= bf_lo(g.w); a1[3] *= bf_hi(g.w); } }
            const __amdgpu_buffer_rsrc_t mrs2 = __builtin_amdgcn_make_buffer_rsrc((void*)MERGED, (short)0, (int)((size_t)MPAD * DM * 2), 0x00020000);
            const unsigned cm = splitk_share<6, true>(acc, slabs + (size_t)u.grp * 6 * SLAB_FLOATS, u.ks, cnt + 64 * u.grp, misc);
#pragma unroll
            for (int m = 0; m < 4; ++m) { const size_t row = (size_t)(row0 + m * 16);
#pragma unroll
                for (int bj = 0; bj < 2; ++bj) { if (!((cm >> (bj * 4 + m)) & 1u)) continue;
                    const int col = col0 + bj * 128; const f32x4 p0 = acc[0][bj][m][0], p1 = acc[0][bj][m][1];
                    u32x4 w; w.x = cvt_pk_bf16(p0[0], p0[1]); w.y = cvt_pk_bf16(p0[2], p0[3]); w.z = cvt_pk_bf16(p1[0], p1[1]); w.w = cvt_pk_bf16(p1[2], p1[3]);
                    __builtin_amdgcn_raw_buffer_store_b128(w, mrs2, (unsigned)(row * DM + col) * 2u, 0, 16); } }
            publish_count_wt(done3 + 64 * 32);
        }
    }
};
struct SchedP4 {
    int G, c; pg8::TileOrder to; const char* MERGED; const char* WoT; unsigned* done3;
    __device__ __forceinline__ bool next(int i, pg8::Unit& u) const {
        const int L = i * G + c;
        if (L < 32 * 8) { int pm, pn; to.map(L, pm, pn);
            u.A = MERGED + (size_t)pm * 256 * DM * 2; u.B = WoT + (size_t)pn * 256 * DM * 2; u.pm = pm; u.pn = pn; u.kind = 0; u.aux = 0; u.nt = 32; u.half = 0; u.ks = 0; u.grp = 0; return true; }
        const int e = L - 32 * 8 - 48;
        if (e < 0 || e >= 32) return false;
        const int pn = e >> 2, ks = e & 3;
        u.A = MERGED + ((size_t)32 * 256 * DM + (size_t)ks * 512) * 2; u.B = WoT + ((size_t)pn * 256 * DM + (size_t)ks * 512) * 2; u.pm = 32; u.pn = pn; u.kind = 1; u.aux = 0; u.nt = 8; u.half = 1; u.ks = ks; u.grp = pn; return true;
    }
    __device__ __forceinline__ void a_ready(const pg8::Unit& n) const {
        if (threadIdx.x == 0) poll_count(done3 + 64 * n.pm, n.kind == 0 ? 8u : 48u);
        asm volatile("" ::: "memory"); __builtin_amdgcn_s_barrier(); asm volatile("" ::: "memory");
    }
};
struct EpiP4 {
    bf16_t* OUTF; float* slabs; unsigned* cnt; volatile LAS unsigned* misc; unsigned* done4;
    __device__ __forceinline__ void operator()(f32x4 (&acc)[2][2][4][2], const pg8::Unit& u, int wr, int wc, int fr, int fq) const {
        const int row0 = u.pm * 256 + wr * 64 + fr, col0 = u.pn * 256 + wc * 32 + 8 * fq;
        const __amdgpu_buffer_rsrc_t ors = __builtin_amdgcn_make_buffer_rsrc((void*)OUTF, (short)0, (int)((size_t)MPAD * DM * 2), 0x00020000);
        unsigned cm = 0xffffu;
        if (u.kind != 0) cm = splitk_share<4, true>(acc, slabs + (size_t)u.grp * 4 * SLAB_FLOATS, u.ks, cnt + 64 * u.grp, misc);
#pragma unroll
        for (int ai = 0; ai < 2; ++ai) { if (ai == 1 && u.half) break;
#pragma unroll
            for (int m = 0; m < 4; ++m) { const unsigned ooff = (unsigned)((row0 + ai * 128 + m * 16) * DM + col0) * 2u;
#pragma unroll
                for (int bj = 0; bj < 2; ++bj) { if (!((cm >> ((ai * 2 + bj) * 4 + m)) & 1u)) continue;
                    const f32x4 v0 = acc[ai][bj][m][0], v1 = acc[ai][bj][m][1];
                    u32x4 w; w.x = cvt_pk_bf16(v0[0], v0[1]); w.y = cvt_pk_bf16(v0[2], v0[3]); w.z = cvt_pk_bf16(v1[0], v1[1]); w.w = cvt_pk_bf16(v1[2], v1[3]);
                    __builtin_amdgcn_raw_buffer_store_b128(w, ors, ooff, bj * 256, 16); } } }
        publish_count_wt(done4 + 64 * u.pm);
    }
};

__device__ __forceinline__ void p0_transpose_item(const float* W, int N, bf16_t* WT, int ldt, LAS float* scr, int kb, int nb, int lane) {
    const int k0 = 64 * kb, n0 = 64 * nb;
    f32x4 v[16];
#pragma unroll
    for (int i = 0; i < 16; ++i) { const int idx = lane + 64 * i; v[i] = __builtin_nontemporal_load((const f32x4*)(W + (size_t)(k0 + (idx >> 4)) * N + n0 + 4 * (idx & 15))); }
#pragma unroll
    for (int i = 0; i < 16; ++i) { const int idx = lane + 64 * i, kr = idx >> 4; *(LAS f32x4*)(scr + kr * 68 + ((4 * (idx & 15)) ^ (((kr >> 3) & 3) << 3))) = v[i]; }
    asm volatile("s_waitcnt lgkmcnt(0)" ::: "memory");
    const int c = lane & 7;
#pragma unroll
    for (int j = 0; j < 8; ++j) { const int n = (lane >> 3) + 8 * j; const LAS float* s = scr + (8 * c) * 68 + (n ^ ((c & 3) << 3));
        u32x4 o; o.x = pk2(s[0 * 68], s[1 * 68]); o.y = pk2(s[2 * 68], s[3 * 68]); o.z = pk2(s[4 * 68], s[5 * 68]); o.w = pk2(s[6 * 68], s[7 * 68]);
        *(u32x4*)(WT + (size_t)(n0 + n) * ldt + k0 + 8 * c) = o; }
    asm volatile("s_waitcnt lgkmcnt(0)" ::: "memory");
}
__device__ __forceinline__ void rms_row_to_bf16(const float* xrow, const float* g, bf16_t* orow, int lane) {
    const f32x4* xr = (const f32x4*)xrow + lane; const f32x4* gr = (const f32x4*)g + lane;
    f32x4 v[8]; float s = 0.f;
#pragma unroll
    for (int j = 0; j < 8; ++j) { v[j] = __builtin_nontemporal_load(xr + 64 * j); s += (v[j].x * v[j].x + v[j].y * v[j].y) + (v[j].z * v[j].z + v[j].w * v[j].w); }
    const float rs = 1.0f / sqrtf(wave_sum(s) * (1.0f / DM) + EPS);
    u32x2* o8 = (u32x2*)orow + lane;
#pragma unroll
    for (int j = 0; j < 8; ++j) { const f32x4 gg = gr[64 * j]; u32x2 w; w.x = pk2(v[j].x * rs * gg.x, v[j].y * rs * gg.y); w.y = pk2(v[j].z * rs * gg.z, v[j].w * rs * gg.w); o8[64 * j] = w; }
}
__device__ __forceinline__ void p0_prologue(const Params& P, LAS unsigned char* lds, int G, int wave, int lane) {
    LAS float* scr = (LAS float*)(lds + wave * 17408);
    const int gw = blockIdx.x * 8 + wave, NGW = G * 8;
    bf16_t* WinT = (bf16_t*)(P.ws + WS_WINT); bf16_t* WkvT = (bf16_t*)(P.ws + WS_WKVT);
    bf16_t* WrgT = (bf16_t*)(P.ws + WS_WRGT); bf16_t* WpT = (bf16_t*)(P.ws + WS_WPT);
    constexpr int I_WIN = 32 * 192, I_WKV = 32 * 32, I_RG = 2 * 8 * 4, I_WP = 4 * 16;
    constexpr int NITEMS = I_WIN + I_WKV + I_RG + I_WP;
    for (int it = gw; it < NITEMS; it += NGW) {
        int r = it;
        if (r < I_WIN) { p0_transpose_item(P.w_in, DIN, WinT, 2048, scr, r / 192, r % 192, lane); continue; } r -= I_WIN;
        if (r < I_WKV) { p0_transpose_item(P.w_kv, 2048, WkvT, 2048, scr, r / 32, r % 32, lane); continue; } r -= I_WKV;
        if (r < I_RG) { const int gate = r >> 5, blk = (r >> 2) & 7, sub = r & 3;
            p0_transpose_item((gate ? P.w_rg_x : P.w_rg_a) + blk * 16384, 128, WrgT + (size_t)(gate * 8 + blk) * 16384, 128, scr, sub >> 1, sub & 1, lane); continue; } r -= I_RG;
        { const int grp = r >> 4, sub = r & 15;
            p0_transpose_item(P.w_pool + grp * 65536, 256, WpT + (size_t)grp * 65536, 256, scr, sub >> 2, sub & 3, lane); }
    }
    { unsigned long long* GR = (unsigned long long*)(P.ws + WS_GR); for (int i = blockIdx.x * 512 + threadIdx.x; i < 4 * 8 * 16 * 128; i += G * 512) GR[i] = ~0ull; }
    bf16_t* U = (bf16_t*)(P.ws + WS_U); bf16_t* MEMN = (bf16_t*)(P.ws + WS_MEMN);
    for (int m = gw; m < MPAD + 1024; m += NGW) {
        if (m < MP) rms_row_to_bf16(P.x_prompt + (size_t)m * DM, P.g_pre, U + (size_t)m * DM, lane);
        else if (m < MTOT) rms_row_to_bf16(P.x_sample + (size_t)(m - MP) * DM, P.g_pre, U + (size_t)m * DM, lane);
        else if (m < MPAD) { u32x2* o8 = (u32x2*)(U + (size_t)m * DM) + lane;
#pragma unroll
            for (int j = 0; j < 8; ++j) o8[64 * j] = (u32x2){0u, 0u}; }
        else rms_row_to_bf16(P.mem + (size_t)(m - MPAD) * DM, P.g_mem, MEMN + (size_t)(m - MPAD) * DM, lane);
    }
}

__device__ __forceinline__ void deferred_prep(const Params& P, LAS unsigned char* lds, int G, int wave, int lane) {
    const int first = (G == 256) ? 80 : 0, nw = G - first;
    if ((int)blockIdx.x < first) return;
    LAS float* scr = (LAS float*)(lds + wave * 17408);
    const int gw = ((int)blockIdx.x - first) * 8 + wave, NGW = nw * 8;
    bf16_t* WbT = (bf16_t*)(P.ws + WS_WBT); bf16_t* WoT = (bf16_t*)(P.ws + WS_WOT);
    constexpr int I_WB = 48 * 32, I_WO = 32 * 32;
    for (int it = gw; it < I_WB + I_WO; it += NGW) {
        if (it < I_WB) p0_transpose_item(P.w_branch, 2048, WbT, 3072, scr, it / 32, it % 32, lane);
        else { const int r = it - I_WB; p0_transpose_item(P.w_out, 2048, WoT, 2048, scr, r / 32, r % 32, lane); }
    }
    for (int r = gw; r < NS * 14 + NS * 2; r += NGW) {
        const float* src; float* dst;
        if (r < NS * 14) { const int s = r / 14, k = r - 14 * s; src = P.st_pool + ((size_t)s * 15 + k + 1) * 1024; dst = P.out + OFF_NPS + ((size_t)s * 15 + k) * 1024; }
        else { const int q = r - NS * 14, s = q >> 1, k = q & 1; src = P.st_conv + ((size_t)s * 3 + k + 1) * 1024; dst = P.out + OFF_NCS + ((size_t)s * 3 + k) * 1024; }
#pragma unroll
        for (int j = 0; j < 4; ++j) __builtin_nontemporal_store(__builtin_nontemporal_load((const f32x4*)src + 64 * j + lane), (f32x4*)dst + 64 * j + lane);
    }
}

__device__ __forceinline__ f32x2 ldz2(const bf16_t* p) { const unsigned u = *(const unsigned*)p; return (f32x2){bf_lo(u), bf_hi(u)}; }
__device__ __forceinline__ f32x2 lds2(const LAS unsigned char* p) { const unsigned u = *(const LAS unsigned*)p; return (f32x2){bf_lo(u), bf_hi(u)}; }
__device__ __forceinline__ u32x4 mul_bf16x8(u32x4 a, u32x4 b) {
    u32x4 o; o.x = pk2(bf_lo(a.x) * bf_lo(b.x), bf_hi(a.x) * bf_hi(b.x)); o.y = pk2(bf_lo(a.y) * bf_lo(b.y), bf_hi(a.y) * bf_hi(b.y));
    o.z = pk2(bf_lo(a.z) * bf_lo(b.z), bf_hi(a.z) * bf_hi(b.z)); o.w = pk2(bf_lo(a.w) * bf_lo(b.w), bf_hi(a.w) * bf_hi(b.w)); return o;
}
__device__ __forceinline__ float one_minus_exp(float x) {
    const float p = -x * (1.0f + x * (0.5f + x * (0.16666667f + x * (0.041666668f + x * (0.0083333338f + x * 0.0013888889f)))));
    const float d = 1.0f - __builtin_amdgcn_exp2f(x * LOG2E);
    return x > -0.25f ? p : d;
}
constexpr unsigned long long GR_EMPTY = ~0ull;

template <bool SAMPLE>
__device__ __forceinline__ void rglru_unit(const Params& P, LAS unsigned char* lds, int b, int n, int c) {
    constexpr int NMT = SAMPLE ? 2 : 16;
    constexpr int NROW = NMT * 16;
    int tid_ = threadIdx.x; asm volatile("" : "+v"(tid_));
    const int tid = tid_, wid = __builtin_amdgcn_readfirstlane(tid >> 6), lane = tid & 63, fr = lane & 15, fq = lane >> 4;
    const bf16_t* Z = (const bf16_t*)(P.ws + WS_Z); bf16_t* OALL = (bf16_t*)(P.ws + WS_OALL); const bf16_t* WrgT = (const bf16_t*)(P.ws + WS_WRGT);
    unsigned long long* GR = (unsigned long long*)(P.ws + WS_GR);
    constexpr int XS = 272;
    LAS unsigned char* XR = lds; LAS unsigned char* HO = lds; LAS unsigned char* XC = lds + 259 * XS;
    const int rowbase = SAMPLE ? MP + 32 * c : b * SEQ + c * 256;
    __syncthreads();
    if (!SAMPLE) {
        u32x4 xv[9];
#pragma unroll
        for (int i = 0; i < 9; ++i) { const int v = tid + 512 * i, row = v >> 4, cv = v & 15; int t = c * 256 - 3 + row; t = t < 0 ? 0 : (t > SEQ - 1 ? SEQ - 1 : t);
            xv[i] = __builtin_nontemporal_load((const u32x4*)(Z + (size_t)(b * SEQ + t) * DIN + ZC_XR + n * 128 + cv * 8)); }
#pragma unroll
        for (int i = 0; i < 9; ++i) { const int v = tid + 512 * i, row = v >> 4, cv = v & 15; const bool neg = (c * 256 - 3 + row) < 0;
            if (row < 259) *(LAS u32x4*)(XR + row * XS + cv * 16) = neg ? (u32x4){0u, 0u, 0u, 0u} : xv[i]; }
    }
    bf16x8 wa[4], wx[4];
    { const bf16_t* pa = WrgT + ((size_t)(0 * 8 + n) * 128 + 16 * wid + fr) * 128 + 8 * fq; const bf16_t* px = WrgT + ((size_t)(1 * 8 + n) * 128 + 16 * wid + fr) * 128 + 8 * fq;
#pragma unroll
      for (int ks = 0; ks < 4; ++ks) { wa[ks] = *(const bf16x8*)(pa + 32 * ks); wx[ks] = *(const bf16x8*)(px + 32 * ks); } }
    const int e = n * 128 + 16 * wid + fr;
    const float ba = P.b_rg_a[e], bx = P.b_rg_x[e];
    const float c8 = -8.0f * log1pf(expf(-P.lam[e]));
    {
      const int cp = tid & 63, seg = tid >> 6, ch = n * 128 + 2 * cp;
      const f32x2 w0 = *(const f32x2*)(P.conv_w + 0 * 1024 + ch), w1 = *(const f32x2*)(P.conv_w + 1 * 1024 + ch), w2 = *(const f32x2*)(P.conv_w + 2 * 1024 + ch), w3 = *(const f32x2*)(P.conv_w + 3 * 1024 + ch);
      const f32x2 cb = *(const f32x2*)(P.conv_b + ch);
      if (!SAMPLE) {
          __syncthreads();
          const int r0 = 32 * seg;
          f32x2 x3 = lds2(XR + (r0 + 0) * XS + 4 * cp), x2 = lds2(XR + (r0 + 1) * XS + 4 * cp), x1 = lds2(XR + (r0 + 2) * XS + 4 * cp);
#pragma unroll 8
          for (int i = 0; i < 32; ++i) { const int t = c * 256 + r0 + i;
              const f32x2 x0 = lds2(XR + (r0 + i + 3) * XS + 4 * cp);
              const f32x2 xc = cb + w0 * x3 + w1 * x2 + w2 * x1 + w3 * x0;
              *(LAS unsigned*)(XC + (r0 + i) * XS + 4 * cp) = pk2(xc.x, xc.y);
              if (t >= SEQ - 3) *(f32x2*)(P.out + OFF_NCP + (size_t)(b * 3 + (t - (SEQ - 3))) * 1024 + ch) = x0;
              x3 = x2; x2 = x1; x1 = x0; }
      } else {
#pragma unroll
          for (int i = 0; i < 4; ++i) { const int sl = 4 * seg + i, s = 32 * c + sl;
              const f32x2 x3 = *(const f32x2*)(P.st_conv + (size_t)(s * 3 + 0) * 1024 + ch), x2 = *(const f32x2*)(P.st_conv + (size_t)(s * 3 + 1) * 1024 + ch), x1 = *(const f32x2*)(P.st_conv + (size_t)(s * 3 + 2) * 1024 + ch);
              const f32x2 x0 = ldz2(Z + (size_t)(MP + s) * DIN + ZC_XR + ch);
              const f32x2 xc = cb + w0 * x3 + w1 * x2 + w2 * x1 + w3 * x0;
              *(LAS unsigned*)(XC + sl * XS + 4 * cp) = pk2(xc.x, xc.y);
              *(f32x2*)(P.out + OFF_NCS + (size_t)(s * 3 + 2) * 1024 + ch) = x0; }
      } }
    __syncthreads();
    unsigned cumA[NMT][2], hloc[NMT][2];
    float Ac = 1.f, Hc = 0.f;
#pragma unroll
    for (int mt = 0; mt < NMT; ++mt) {
        f32x4 racc = (f32x4){0.f, 0.f, 0.f, 0.f}, iacc = racc;
#pragma unroll
        for (int ks = 0; ks < 4; ++ks) { const bf16x8 a = *(const LAS bf16x8*)(XC + (16 * mt + fr) * XS + (32 * ks + 8 * fq) * 2);
            racc = __builtin_amdgcn_mfma_f32_16x16x32_bf16(a, wa[ks], racc, 0, 0, 0); iacc = __builtin_amdgcn_mfma_f32_16x16x32_bf16(a, wx[ks], iacc, 0, 0, 0); }
        float av[4], bv[4];
#pragma unroll
        for (int j = 0; j < 4; ++j) { const int row = 16 * mt + 4 * fq + j;
            const float r = sigmoid_f(racc[j] + ba), ig = sigmoid_f(iacc[j] + bx);
            const float la = c8 * r;
            av[j] = __builtin_amdgcn_exp2f(la * LOG2E); const float mult = __builtin_amdgcn_sqrtf(one_minus_exp(2.0f * la));
            const float xcv = bf2f(*(const LAS bf16_t*)(XC + row * XS + (16 * wid + fr) * 2));
            bv[j] = mult * ig * xcv; }
        if (!SAMPLE) {
            float Pj[4], Qj[4]; float pp = 1.f, qq = 0.f;
#pragma unroll
            for (int j = 0; j < 4; ++j) { qq = av[j] * qq + bv[j]; pp = av[j] * pp; Pj[j] = pp; Qj[j] = qq; }
            float Arun = Ac, Hrun = Hc, Ain = 1.f, Hin = 0.f;
#pragma unroll
            for (int g = 0; g < 4; ++g) { const float pg = __shfl(pp, fr + 16 * g), qg = __shfl(qq, fr + 16 * g); if (g == fq) { Ain = Arun; Hin = Hrun; } Hrun = pg * Hrun + qg; Arun = pg * Arun; }
            Ac = Arun; Hc = Hrun;
            cumA[mt][0] = cvt_pk_bf16(Pj[0] * Ain, Pj[1] * Ain); cumA[mt][1] = cvt_pk_bf16(Pj[2] * Ain, Pj[3] * Ain);
            hloc[mt][0] = cvt_pk_bf16(Pj[0] * Hin + Qj[0], Pj[1] * Hin + Qj[1]); hloc[mt][1] = cvt_pk_bf16(Pj[2] * Hin + Qj[2], Pj[3] * Hin + Qj[3]);
        } else {
            const int s0 = 32 * c + 16 * mt + 4 * fq;
            float hv[4];
#pragma unroll
            for (int j = 0; j < 4; ++j) { const float h0 = P.st_h[(size_t)(s0 + j) * 1024 + e]; hv[j] = av[j] * h0 + bv[j]; P.out[OFF_NHS + (size_t)(s0 + j) * 1024 + e] = hv[j]; }
            cumA[mt][0] = 0u; cumA[mt][1] = 0u; hloc[mt][0] = cvt_pk_bf16(hv[0], hv[1]); hloc[mt][1] = cvt_pk_bf16(hv[2], hv[3]);
        }
    }
    float carry = 0.f;
    if (!SAMPLE) {
        unsigned long long* gbase = GR + (size_t)((b * 8 + n) * 8) * 128 + 16 * wid + fr;
        if (fq == 0) __hip_atomic_store(gbase + (size_t)c * 128, ((unsigned long long)__builtin_bit_cast(unsigned, Hc) << 32) | (unsigned long long)__builtin_bit_cast(unsigned, Ac), __ATOMIC_RELAXED, __HIP_MEMORY_SCOPE_AGENT);
        if (c > 0) {
            unsigned long long g[7]; unsigned spins = 0;
            for (;;) { bool ok = true;
#pragma unroll
                for (int cc = 0; cc < 7; ++cc) { g[cc] = __hip_atomic_load(gbase + (size_t)cc * 128, __ATOMIC_RELAXED, __HIP_MEMORY_SCOPE_AGENT); }
#pragma unroll
                for (int cc = 0; cc < 7; ++cc) ok = ok && (cc >= c || g[cc] != GR_EMPTY);
                if (__all(ok) || ++spins > (1u << 20)) break;
                __builtin_amdgcn_s_sleep(2); }
#pragma unroll
            for (int cc = 0; cc < 7; ++cc) { const float ga = __builtin_bit_cast(float, (unsigned)g[cc]), gh = __builtin_bit_cast(float, (unsigned)(g[cc] >> 32)); const float nc = ga * carry + gh; carry = (cc < c) ? nc : carry; }
        }
        if (c == 7 && fq == 0) P.out[OFF_NHP + (size_t)b * 1024 + e] = Ac * carry + Hc;
    }
#pragma unroll
    for (int mt = 0; mt < NMT; ++mt)
#pragma unroll
        for (int j = 0; j < 4; ++j) { const int row = 16 * mt + 4 * fq + j;
            const unsigned ca = cumA[mt][j >> 1], hl = hloc[mt][j >> 1];
            const float h = ((j & 1) ? bf_hi(ca) : bf_lo(ca)) * carry + ((j & 1) ? bf_hi(hl) : bf_lo(hl));
            *(LAS bf16_t*)(HO + row * XS + (16 * wid + fr) * 2) = (bf16_t)f2bf(h); }
    __syncthreads();
    { u32x4 gg[NROW / 32];
#pragma unroll
      for (int i = 0; i < NROW / 32; ++i) { const int v = tid + 512 * i, row = v >> 4, cv = v & 15; gg[i] = __builtin_nontemporal_load((const u32x4*)(Z + (size_t)(rowbase + row) * DIN + ZC_GR + n * 128 + cv * 8)); }
#pragma unroll
      for (int i = 0; i < NROW / 32; ++i) { const int v = tid + 512 * i, row = v >> 4, cv = v & 15;
          const u32x4 ho = *(const LAS u32x4*)(HO + row * XS + cv * 16);
          *(u32x4*)(OALL + (size_t)(rowbase + row) * DMIX + n * 128 + cv * 8) = mul_bf16x8(ho, gg[i]); } }
}

template <bool SAMPLE>
__device__ __forceinline__ void pool_unit(const Params& P, LAS unsigned char* lds, int b, int g, int blk) {
    int tid_ = threadIdx.x; asm volatile("" : "+v"(tid_));
    const int tid = tid_, wid = __builtin_amdgcn_readfirstlane(tid >> 6), lane = tid & 63, fr = lane & 15, fq = lane >> 4;
    const bf16_t* Z = (const bf16_t*)(P.ws + WS_Z); bf16_t* OALL = (bf16_t*)(P.ws + WS_OALL); const bf16_t* WpT = (const bf16_t*)(P.ws + WS_WPT);
    constexpr int DS = 528;
    LAS unsigned char* XP = lds; LAS unsigned char* OUT = lds; LAS unsigned char* D = lds + 144 * DS;
    const int W = 2 << g;
    const int rowbase = SAMPLE ? MP + 16 * blk : b * SEQ + blk * 128;
    const int nmt = SAMPLE ? 1 : 8;
    __syncthreads();
    if (!SAMPLE) {
        u32x4 xv[9];
#pragma unroll
        for (int i = 0; i < 9; ++i) { const int v = tid + 512 * i, row = v >> 5, cv = v & 31; int t = blk * 128 - 15 + row; t = t < 0 ? 0 : (t > SEQ - 1 ? SEQ - 1 : t);
            xv[i] = __builtin_nontemporal_load((const u32x4*)(Z + (size_t)(b * SEQ + t) * DIN + ZC_XP + g * 256 + cv * 8)); }
#pragma unroll
        for (int i = 0; i < 9; ++i) { const int v = tid + 512 * i, row = v >> 5, cv = v & 31; const bool neg = (blk * 128 - 15 + row) < 0;
            *(LAS u32x4*)(XP + row * DS + cv * 16) = neg ? (u32x4){0u, 0u, 0u, 0u} : xv[i]; }
        __syncthreads();
    }
    { const int cp = tid & 127, seg = tid >> 7, ch = g * 256 + 2 * cp;
      if (!SAMPLE) {
          const int r0 = 15 + 32 * seg;
          f32x2 s = (f32x2){0.f, 0.f};
          for (int k = 1; k < W; ++k) s += lds2(XP + (r0 - k) * DS + 4 * cp);
#pragma unroll 8
          for (int i = 0; i < 32; ++i) { const int t = blk * 128 + 32 * seg + i;
              const f32x2 x0 = lds2(XP + (r0 + i) * DS + 4 * cp); s += x0;
              const float inv = 1.0f / (float)((t + 1) < W ? (t + 1) : W);
              const f32x2 d = s * inv - x0;
              *(LAS unsigned*)(D + (32 * seg + i) * DS + 4 * cp) = pk2(d.x, d.y);
              s -= lds2(XP + (r0 + i - W + 1) * DS + 4 * cp);
              if (t >= SEQ - 15) *(f32x2*)(P.out + OFF_NPP + (size_t)(b * 15 + (t - (SEQ - 15))) * 1024 + ch) = x0; }
      } else {
          const float inv = 1.0f / (float)W;
#pragma unroll
          for (int i = 0; i < 4; ++i) { const int sl = seg + 4 * i, s_ = 16 * blk + sl;
              const f32x2 x0 = ldz2(Z + (size_t)(MP + s_) * DIN + ZC_XP + ch);
              const float* hp = P.st_pool + (size_t)s_ * 15 * 1024 + ch;
              f32x2 hv[15];
#pragma unroll
              for (int k = 1; k < 16; ++k) hv[k - 1] = *(const f32x2*)(hp + (size_t)(15 - k) * 1024);
              f32x2 s = x0;
#pragma unroll
              for (int k = 1; k < 16; ++k) { const f32x2 a = s + hv[k - 1]; s = (k < W) ? a : s; }
              *(f32x2*)(P.out + OFF_NPS + ((size_t)s_ * 15 + 14) * 1024 + ch) = x0;
              const f32x2 d = s * inv - x0;
              *(LAS unsigned*)(D + sl * DS + 4 * cp) = pk2(d.x, d.y); }
      } }
    __syncthreads();
    {
      bf16x8 bw[2][8];
#pragma unroll
      for (int nt = 0; nt < 2; ++nt) { const bf16_t* pw = WpT + ((size_t)g * 256 + 32 * wid + 16 * nt + fr) * 256 + 8 * fq;
#pragma unroll
          for (int ks = 0; ks < 8; ++ks) bw[nt][ks] = *(const bf16x8*)(pw + 32 * ks); }
      const float ps0 = P.pool_scale[g * 256 + 32 * wid + fr], ps1 = P.pool_scale[g * 256 + 32 * wid + 16 + fr];
#pragma unroll 2
      for (int mt = 0; mt < nmt; ++mt) {
          f32x4 a0 = (f32x4){0.f, 0.f, 0.f, 0.f}, a1 = a0;
#pragma unroll
          for (int ks = 0; ks < 8; ++ks) { const bf16x8 a = *(const LAS bf16x8*)(D + (16 * mt + fr) * DS + (32 * ks + 8 * fq) * 2);
              a0 = __builtin_amdgcn_mfma_f32_16x16x32_bf16(a, bw[0][ks], a0, 0, 0, 0); a1 = __builtin_amdgcn_mfma_f32_16x16x32_bf16(a, bw[1][ks], a1, 0, 0, 0); }
#pragma unroll
          for (int j = 0; j < 4; ++j) { const int row = 16 * mt + 4 * fq + j;
              *(LAS bf16_t*)(OUT + row * DS + (32 * wid + fr) * 2) = (bf16_t)f2bf(a0[j] * ps0); *(LAS bf16_t*)(OUT + row * DS + (32 * wid + 16 + fr) * 2) = (bf16_t)f2bf(a1[j] * ps1); }
      } }
    __syncthreads();
    for (int i = 0; i < nmt; ++i) { const int v = tid + 512 * i, row = v >> 5, cv = v & 31;
        const u32x4 ho = *(const LAS u32x4*)(OUT + row * DS + cv * 16);
        const u32x4 gg = __builtin_nontemporal_load((const u32x4*)(Z + (size_t)(rowbase + row) * DIN + ZC_GP + g * 256 + cv * 8));
        *(u32x4*)(OALL + (size_t)(rowbase + row) * DMIX + 1024 + g * 256 + cv * 8) = mul_bf16x8(ho, gg); }
}

__device__ __forceinline__ void attn_stage(LAS unsigned char* lds, const bf16_t* src  , int wid, int lane) {
#pragma unroll
    for (int i = 0; i < 16; ++i) { const int piece = wid * 16 + i, row = 2 * piece + (lane >> 5), p = lane & 31;
        __builtin_amdgcn_global_load_lds((const unsigned*)(src + (size_t)row * 1024 + ((p ^ (row & 15)) << 3)), (LAS unsigned*)(lds + piece * 1024), 16, 0, 0); }
}
__device__ __forceinline__ void attn_unit(const Params& P, LAS unsigned char* lds, int b, int h, int blk) {
    int tid_ = threadIdx.x; asm volatile("" : "+v"(tid_));
    const int tid = tid_, wid = __builtin_amdgcn_readfirstlane(tid >> 6), lane = tid & 63, fr = lane & 15, fq = lane >> 4;
    const bf16_t* Z = (const bf16_t*)(P.ws + WS_Z); bf16_t* OALL = (bf16_t*)(P.ws + WS_OALL); const bf16_t* KB = (const bf16_t*)(P.ws + WS_KB); const bf16_t* VT = (const bf16_t*)(P.ws + WS_VT);
    const int m0 = b * SEQ + blk * 128 + 16 * wid;
    __syncthreads();
    attn_stage(lds, KB + (size_t)(b * 256) * 1024 + h * 256, wid, lane);
    bf16x8 qf[8];
    { const bf16_t* qp = Z + (size_t)(m0 + fr) * DIN + ZC_Q + h * 256 + 8 * fq;
#pragma unroll
      for (int ks = 0; ks < 8; ++ks) qf[ks] = *(const bf16x8*)(qp + 32 * ks); }
    asm volatile("s_waitcnt vmcnt(0)" ::: "memory");
    __syncthreads();
    f32x4 st[16];
#pragma unroll
    for (int t = 0; t < 16; ++t) { f32x4 a = (f32x4){0.f, 0.f, 0.f, 0.f};
#pragma unroll
        for (int ks = 0; ks < 8; ++ks) { const bf16x8 kf = *(const LAS bf16x8*)(lds + (16 * t + fr) * 512 + (((4 * ks + fq) ^ fr) << 4)); a = __builtin_amdgcn_mfma_f32_16x16x32_bf16(kf, qf[ks], a, 0, 0, 0); }
        st[t] = a; }
    __syncthreads();
    attn_stage(lds, VT + (size_t)(h * 256) * 1024 + b * 256, wid, lane);
    float mx = -3.0e38f;
#pragma unroll
    for (int t = 0; t < 16; ++t) mx = fmaxf(mx, fmaxf(fmaxf(st[t][0], st[t][1]), fmaxf(st[t][2], st[t][3])));
    mx = fmaxf(mx, __shfl_xor(mx, 16)); mx = fmaxf(mx, __shfl_xor(mx, 32));
    const float sc = LOG2E * 0.0625f; float sum = 0.f;
#pragma unroll
    for (int t = 0; t < 16; ++t)
#pragma unroll
        for (int j = 0; j < 4; ++j) { const float p = __builtin_amdgcn_exp2f((st[t][j] - mx) * sc); st[t][j] = p; sum += p; }
    sum += __shfl_xor(sum, 16); sum += __shfl_xor(sum, 32);
    const float inv = 1.0f / sum;
    bf16x8 pf[8];
#pragma unroll
    for (int s = 0; s < 8; ++s) { u32x4 w; w.x = cvt_pk_bf16(st[2 * s][0], st[2 * s][1]); w.y = cvt_pk_bf16(st[2 * s][2], st[2 * s][3]); w.z = cvt_pk_bf16(st[2 * s + 1][0], st[2 * s + 1][1]); w.w = cvt_pk_bf16(st[2 * s + 1][2], st[2 * s + 1][3]);
        pf[s] = __builtin_bit_cast(bf16x8, w); }
    asm volatile("s_waitcnt vmcnt(0)" ::: "memory");
    __syncthreads();
    u32x4 gg[8];
#pragma unroll
    for (int i = 0; i < 8; ++i) { const int v = lane + 64 * i, row = v >> 5, cv = v & 31; gg[i] = __builtin_nontemporal_load((const u32x4*)(Z + (size_t)(m0 + row) * DIN + ZC_GX + h * 256 + cv * 8)); }
    u32x2 ov[16];
#pragma unroll
    for (int dt = 0; dt < 16; ++dt) { f32x4 a = (f32x4){0.f, 0.f, 0.f, 0.f};
#pragma unroll
        for (int s = 0; s < 8; ++s) { const LAS unsigned char* rp = lds + (16 * dt + fr) * 512 + 8 * (fq & 1);
            const u32x2 lo = *(const LAS u32x2*)(rp + (((4 * s + (fq >> 1)) ^ fr) << 4)), hi = *(const LAS u32x2*)(rp + (((4 * s + 2 + (fq >> 1)) ^ fr) << 4));
            const u32x4 w = (u32x4){lo.x, lo.y, hi.x, hi.y};
            a = __builtin_amdgcn_mfma_f32_16x16x32_bf16(__builtin_bit_cast(bf16x8, w), pf[s], a, 0, 0, 0); }
        ov[dt].x = pk2(a[0] * inv, a[1] * inv); ov[dt].y = pk2(a[2] * inv, a[3] * inv); }
    __syncthreads();
#pragma unroll
    for (int dt = 0; dt < 16; ++dt) *(LAS u32x2*)(lds + (16 * wid + fr) * 528 + (16 * dt + 4 * fq) * 2) = ov[dt];
    asm volatile("s_waitcnt lgkmcnt(0)" ::: "memory");
    {
#pragma unroll
      for (int i = 0; i < 8; ++i) { const int v = lane + 64 * i, row = v >> 5, cv = v & 31;
          const u32x4 ho = *(const LAS u32x4*)(lds + (16 * wid + row) * 528 + cv * 16);
          *(u32x4*)(OALL + (size_t)(m0 + row) * DMIX + 2048 + h * 256 + cv * 8) = mul_bf16x8(ho, gg[i]); } }
}

__device__ __forceinline__ void sattn_unit(const Params& P, LAS unsigned char* lds, int s, int h) {
    int tid_ = threadIdx.x; asm volatile("" : "+v"(tid_));
    const int tid = tid_, wid = __builtin_amdgcn_readfirstlane(tid >> 6), lane = tid & 63;
    const bf16_t* Z = (const bf16_t*)(P.ws + WS_Z); bf16_t* OALL = (bf16_t*)(P.ws + WS_OALL);
    LAS float* SC = (LAS float*)lds; LAS float* PS = SC + 256; LAS float* PO = PS + 256;
    __syncthreads();
    f32x4 q4;
    { const u32x2 qq = *(const u32x2*)(Z + (size_t)(MP + s) * DIN + ZC_Q + h * 256 + 4 * lane); q4 = (f32x4){bf_lo(qq.x), bf_hi(qq.x), bf_lo(qq.y), bf_hi(qq.y)}; }
    const float* kb = P.cache_k + ((size_t)(s * 256 + 32 * wid) * 4 + h) * 256 + 4 * lane;
    const float* vb = P.cache_v + ((size_t)(s * 256 + 32 * wid) * 4 + h) * 256 + 4 * lane;
    float mysc = 0.f;
    f32x4 v4[32];
    { f32x4 k4[32];
#pragma unroll
      for (int i = 0; i < 32; ++i) k4[i] = __builtin_nontemporal_load((const f32x4*)(kb + (size_t)i * 1024));
#pragma unroll
      for (int i = 0; i < 16; ++i) v4[i] = __builtin_nontemporal_load((const f32x4*)(vb + (size_t)i * 1024));
      float p[32];
#pragma unroll
      for (int i = 0; i < 32; ++i) p[i] = (k4[i].x * q4.x + k4[i].y * q4.y) + (k4[i].z * q4.z + k4[i].w * q4.w);
      float q16[16], q8[8], q4v[4], q2[2];
      { const bool hi = (lane & 32) != 0;
#pragma unroll
        for (int j = 0; j < 16; ++j) { const float send = hi ? p[j] : p[j + 16], keep = hi ? p[j + 16] : p[j]; q16[j] = keep + __shfl_xor(send, 32); } }
      { const bool hi = (lane & 16) != 0;
#pragma unroll
        for (int j = 0; j < 8; ++j) { const float send = hi ? q16[j] : q16[j + 8], keep = hi ? q16[j + 8] : q16[j]; q8[j] = keep + __shfl_xor(send, 16); } }
      { const bool hi = (lane & 8) != 0;
#pragma unroll
        for (int j = 0; j < 4; ++j) { const float send = hi ? q8[j] : q8[j + 4], keep = hi ? q8[j + 4] : q8[j]; q4v[j] = keep + __shfl_xor(send, 8); } }
      { const bool hi = (lane & 4) != 0;
#pragma unroll
        for (int j = 0; j < 2; ++j) { const float send = hi ? q4v[j] : q4v[j + 2], keep = hi ? q4v[j + 2] : q4v[j]; q2[j] = keep + __shfl_xor(send, 4); } }
      { const bool hi = (lane & 2) != 0; const float send = hi ? q2[0] : q2[1], keep = hi ? q2[1] : q2[0]; mysc = keep + __shfl_xor(send, 2); }
      mysc += __shfl_xor(mysc, 1); }
#pragma unroll
    for (int i = 16; i < 32; ++i) v4[i] = __builtin_nontemporal_load((const f32x4*)(vb + (size_t)i * 1024));
    if ((lane & 1) == 0) SC[32 * wid + (lane >> 1)] = mysc;
    __syncthreads();
    { float v[4]; float mx = -3.0e38f;
#pragma unroll
      for (int k = 0; k < 4; ++k) { v[k] = SC[lane + 64 * k]; mx = fmaxf(mx, v[k]); }
      mx = wave_max(mx); float sum = 0.f; const float sc = LOG2E * 0.0625f;
#pragma unroll
      for (int k = 0; k < 4; ++k) { v[k] = __builtin_amdgcn_exp2f((v[k] - mx) * sc); sum += v[k]; }
      sum = wave_sum(sum); const float inv = 1.0f / sum;
      if (wid == 0) {
#pragma unroll
          for (int k = 0; k < 4; ++k) PS[lane + 64 * k] = v[k] * inv; } }
    __syncthreads();
    { f32x4 a = (f32x4){0.f, 0.f, 0.f, 0.f};
#pragma unroll
      for (int i = 0; i < 32; ++i) { const float p = PS[32 * wid + i]; a += v4[i] * p; }
      *(LAS f32x4*)(PO + wid * 256 + 4 * lane) = a; }
    __syncthreads();
    if (tid < 256) { float o = 0.f;
#pragma unroll
        for (int w = 0; w < 8; ++w) o += PO[w * 256 + tid];
        const float gx = bf2f(Z[(size_t)(MP + s) * DIN + ZC_GX + h * 256 + tid]);
        OALL[(size_t)(MP + s) * DMIX + 2048 + h * 256 + tid] = (bf16_t)f2bf(o * gx); }
}

__device__ __forceinline__ void p5_rows(const Params& P, int m0, int mstep, int mend, int lane) {
    const bf16_t* OUTB = (const bf16_t*)(P.ws + WS_OUTB);
    for (int m = m0; m < mend; m += mstep) {
        const u32x4* orow = (const u32x4*)(OUTB + (size_t)m * DM) + lane;
        const f32x4* xrow = (const f32x4*)(m < MP ? P.x_prompt + (size_t)m * DM : P.x_sample + (size_t)(m - MP) * DM) + 2 * lane;
        const f32x4* gr = (const f32x4*)P.g_post + 2 * lane;
        u32x4 v[4]; f32x4 xa[4], xb[4]; float s = 0.f;
#pragma unroll
        for (int j = 0; j < 4; ++j) { v[j] = orow[64 * j]; xa[j] = xrow[128 * j]; xb[j] = xrow[128 * j + 1]; }
#pragma unroll
        for (int j = 0; j < 4; ++j) { const float a0 = bf_lo(v[j].x), a1 = bf_hi(v[j].x), a2 = bf_lo(v[j].y), a3 = bf_hi(v[j].y), a4 = bf_lo(v[j].z), a5 = bf_hi(v[j].z), a6 = bf_lo(v[j].w), a7 = bf_hi(v[j].w);
            s += ((a0 * a0 + a1 * a1) + (a2 * a2 + a3 * a3)) + ((a4 * a4 + a5 * a5) + (a6 * a6 + a7 * a7)); }
        const float rs = 1.0f / sqrtf(wave_sum(s) * (1.0f / DM) + EPS);
        f32x4* yrow = (f32x4*)(P.out + OFF_Y + (size_t)m * DM) + 2 * lane;
#pragma unroll
        for (int j = 0; j < 4; ++j) { const f32x4 g0 = gr[128 * j], g1 = gr[128 * j + 1];
            const f32x4 o0 = (f32x4){bf_lo(v[j].x), bf_hi(v[j].x), bf_lo(v[j].y), bf_hi(v[j].y)}, o1 = (f32x4){bf_lo(v[j].z), bf_hi(v[j].z), bf_lo(v[j].w), bf_hi(v[j].w)};
            yrow[128 * j] = xa[j] + o0 * rs * g0; yrow[128 * j + 1] = xb[j] + o1 * rs * g1; }
    }
}

__global__ void __launch_bounds__(512, 2) fwd_kernel(Params P) {
    extern __shared__ __attribute__((aligned(16))) unsigned char lds_raw[];
    LAS unsigned char* lds = (LAS unsigned char*)lds_raw;
    cg::grid_group grid = cg::this_grid();
    const int tid = threadIdx.x, lane = tid & 63, wave = __builtin_amdgcn_readfirstlane(tid >> 6);
    const int G = gridDim.x;
    const int lo = P.ph_lo, hi = P.ph_hi;
    volatile LAS unsigned* MISC = (volatile LAS unsigned*)(lds + LDS_MISC_OFF);
    if (tid < 16) MISC[tid] = 0u;
    __syncthreads();
    const XcdBarrier xbar = xcd_barrier_post((unsigned*)(P.ws + WS_CTL), MISC);
#define GSYNC(k) do { if (USE_CG_SEAM(k)) grid.sync(); else xcd_barrier(xbar); } while (0)
#define IN(k) (lo <= (k) && (k) < hi)
#define BOTH(k) (IN(k) && IN((k) + 1))
    if (IN(0)) { if (PROBE_REPEAT == 0) { p0_prologue(P, lds, G, wave, lane); GSYNC(9); } p0_prologue(P, lds, G, wave, lane); if (BOTH(0)) GSYNC(0); }
    if (IN(1)) {
        SchedP1 S; S.mode = 0; S.G = G; S.c = blockIdx.x; S.to.init(32, 48); S.U = (const char*)(P.ws + WS_U); S.WinT = (const char*)(P.ws + WS_WINT); S.MEMN = (const char*)(P.ws + WS_MEMN); S.WkvT = (const char*)(P.ws + WS_WKVT);
        EpiP1T<false> E; E.Z = (bf16_t*)(P.ws + WS_Z); E.out = P.out; E.KB = (bf16_t*)(P.ws + WS_KB); E.VT = (bf16_t*)(P.ws + WS_VT); E.slabs = (float*)(P.ws + WS_OALL); E.cnt = (unsigned*)(P.ws + WS_CTL) + CW_CNT + 64 * CNT_P1S; E.misc = MISC; E.done = (unsigned*)(P.ws + WS_CTL) + CW_DONE; E.ldsx = lds;
        if (PROBE_REPEAT == 1) { pg8::gemm_phase<EpiP1T<false>, SchedP1>(lds, 2048, 2048, S, E); GSYNC(9); }
        pg8::gemm_phase<EpiP1T<false>, SchedP1>(lds, 2048, 2048, S, E);
        if (BOTH(1)) GSYNC(9);
    }
    if (IN(2)) {
        constexpr int U_RGP = 256, U_RGS = 32, U_ATT = 256, U_PP = 256, U_PS = 32, U_SA = 512;
        constexpr int NU = U_RGP + U_RGS + U_ATT + U_PP + U_PS + U_SA;
        unsigned* done = (unsigned*)(P.ws + WS_CTL) + CW_DONE;
        { SchedP1 S; S.mode = 1; S.G = G; S.c = blockIdx.x; S.to.init(32, 48); S.U = (const char*)(P.ws + WS_U); S.WinT = (const char*)(P.ws + WS_WINT); S.MEMN = (const char*)(P.ws + WS_MEMN); S.WkvT = (const char*)(P.ws + WS_WKVT);
          EpiP1T<true> E; E.Z = (bf16_t*)(P.ws + WS_Z); E.out = P.out; E.KB = (bf16_t*)(P.ws + WS_KB); E.VT = (bf16_t*)(P.ws + WS_VT); E.slabs = (float*)(P.ws + WS_PART); E.cnt = (unsigned*)(P.ws + WS_CTL) + CW_CNT + 64 * CNT_P1S; E.misc = MISC; E.done = done; E.ldsx = lds;
          pg8::gemm_phase<EpiP1T<true>, SchedP1>(lds, 2048, 2048, S, E); }
        if (G == 256) {
            const int c = blockIdx.x;
            deferred_prep(P, lds, G, wave, lane);
            pool_unit<false>(P, lds, c >> 6, (c >> 4) & 3, c & 15);
            rglru_unit<false>(P, lds, c >> 6, (c >> 3) & 7, c & 7);
            wait_done(done);
            attn_unit(P, lds, c >> 6, (c >> 4) & 3, c & 15);
            {
              const int s0 = c < 80 ? c : (c < 160 ? 80 + 3 * (c - 80) : 320 + 2 * (c - 160)), ns = c < 80 ? 1 : (c < 160 ? 3 : 2);
              for (int k = 0; k < ns; ++k) sattn_unit(P, lds, (s0 + k) >> 2, (s0 + k) & 3); }
            if (c >= 224) rglru_unit<true>(P, lds, 0, (c - 224) >> 2, (c - 224) & 3);
            else if (c >= 192) pool_unit<true>(P, lds, 0, (c - 192) >> 3, (c - 192) & 7);
        } else {
        deferred_prep(P, lds, G, wave, lane);
        wait_done(done);
        for (int u = blockIdx.x; u < NU; u += G) {
            int r = u;
            if (r < U_RGP) { rglru_unit<false>(P, lds, r >> 6, (r >> 3) & 7, r & 7); continue; } r -= U_RGP;
            if (r < U_RGS) { rglru_unit<true>(P, lds, 0, r >> 2, r & 3); continue; } r -= U_RGS;
            if (r < U_ATT) { attn_unit(P, lds, r >> 6, (r >> 4) & 3, r & 15); continue; } r -= U_ATT;
            if (r < U_PP) { pool_unit<false>(P, lds, r >> 6, (r >> 4) & 3, r & 15); continue; } r -= U_PP;
            if (r < U_PS) { pool_unit<true>(P, lds, 0, r >> 3, r & 7); continue; } r -= U_PS;
            sattn_unit(P, lds, r >> 2, r & 3);
        }
        }
        __syncthreads();
        if (BOTH(2)) GSYNC(9);
    }
    if (IN(3)) {
        SchedP3 S; S.G = G; S.c = blockIdx.x; S.to.init(32, 8); S.OALL = (const char*)(P.ws + WS_OALL); S.WbT = (const char*)(P.ws + WS_WBT);
        EpiP3 E; E.Z = (const bf16_t*)(P.ws + WS_Z); E.PART = (bf16_t*)(P.ws + WS_PART); E.MERGED = (bf16_t*)(P.ws + WS_MERGED); E.slabs = (float*)(P.ws + WS_U); E.cnt = (unsigned*)(P.ws + WS_CTL) + CW_CNT + 64 * CNT_P3S; E.misc = MISC; E.done3 = (unsigned*)(P.ws + WS_CTL) + CW_DONE + 128;
        pg8::gemm_phase<EpiP3, SchedP3>(lds, DMIX, DMIX, S, E);
        if (BOTH(3) && !IN(4)) GSYNC(9);
    }
    if (IN(4)) {
        SchedP4 S; S.G = G; S.c = blockIdx.x; S.to.init(32, 8); S.MERGED = (const char*)(P.ws + WS_MERGED); S.WoT = (const char*)(P.ws + WS_WOT); S.done3 = (unsigned*)(P.ws + WS_CTL) + CW_DONE + 128;
        { pg8::Unit u0; if (S.next(0, u0)) { if (tid == 0) poll_count(S.done3 + 64 * u0.pm, u0.kind == 0 ? 8u : 48u); } __syncthreads(); }
        EpiP4 E; E.OUTF = (bf16_t*)(P.ws + WS_OUTB); E.slabs = (float*)(P.ws + WS_U + 16 * MiB); E.cnt = (unsigned*)(P.ws + WS_CTL) + CW_CNT + 64 * CNT_P4S; E.misc = MISC; E.done4 = (unsigned*)(P.ws + WS_CTL) + CW_DONE4;
        pg8::gemm_phase<EpiP4, SchedP4>(lds, DM, DM, S, E);
        if (BOTH(4) && G != 256) GSYNC(9);
    }
    if (IN(5)) {
        if (G == 256 && IN(4)) {
            unsigned* done4 = (unsigned*)(P.ws + WS_CTL) + CW_DONE4;
            pg8::TileOrder to; to.init(32, 8); int pm, pn; to.map(blockIdx.x, pm, pn);
            if (tid == 0) poll_count(done4 + 64 * pm, 8u);
            __syncthreads();
            p5_rows(P, pm * 256 + pn * 32 + wave, 8, pm * 256 + pn * 32 + 32, lane);
            if (blockIdx.x >= 80 && blockIdx.x < 96) {
                if (tid == 0) poll_count(done4 + 64 * 32, 32u);
                __syncthreads();
                p5_rows(P, MP + ((int)blockIdx.x - 80) * 8 + wave, 8, MP + ((int)blockIdx.x - 80) * 8 + 8, lane);
            }
        } else p5_rows(P, blockIdx.x * 8 + wave, G * 8, MTOT, lane);
    }
#undef IN
#undef BOTH
}

extern "C" void kernel_launch(void* const* d_in, const int* in_sizes, int n_in, void* d_out, int out_size, void* d_ws, size_t ws_size, hipStream_t stream) {
    static int grid = 0;
    if (grid == 0) {
        if (n_in != 24 || (size_t)out_size != OUT_TOTAL || ws_size < WS_END) { fprintf(stderr, "kernel_launch: unexpected problem (n_in %d, out %d, ws %zu); nothing launched\n", n_in, out_size, ws_size); grid = -1; return; }
        int dev = 0, cus = 0, per_cu = 0;
        if (hipGetDevice(&dev) != hipSuccess || hipDeviceGetAttribute(&cus, hipDeviceAttributeMultiprocessorCount, dev) != hipSuccess) { grid = -1; return; }
        if (hipFuncSetAttribute((const void*)fwd_kernel, hipFuncAttributeMaxDynamicSharedMemorySize, LDS_BYTES) != hipSuccess) { fprintf(stderr, "kernel_launch: hipFuncSetAttribute failed\n"); grid = -1; return; }
        if (hipOccupancyMaxActiveBlocksPerMultiprocessor(&per_cu, (const void*)fwd_kernel, 512, LDS_BYTES) != hipSuccess || per_cu < 1) { fprintf(stderr, "kernel_launch: occupancy query failed (%d)\n", per_cu); (void)hipGetLastError(); grid = -1; return; }
        grid = cus * per_cu;
    }
    if (grid < 0) return;
    Params p{};
    p.x_prompt = (const float*)d_in[0]; p.x_sample = (const float*)d_in[1]; p.mem = (const float*)d_in[2]; p.st_h = (const float*)d_in[3]; p.st_conv = (const float*)d_in[4]; p.st_pool = (const float*)d_in[5];
    p.cache_k = (const float*)d_in[6]; p.cache_v = (const float*)d_in[7]; p.g_pre = (const float*)d_in[8]; p.w_in = (const float*)d_in[9]; p.conv_w = (const float*)d_in[10]; p.conv_b = (const float*)d_in[11];
    p.w_rg_a = (const float*)d_in[12]; p.b_rg_a = (const float*)d_in[13]; p.w_rg_x = (const float*)d_in[14]; p.b_rg_x = (const float*)d_in[15]; p.lam = (const float*)d_in[16]; p.w_pool = (const float*)d_in[17];
    p.pool_scale = (const float*)d_in[18]; p.g_mem = (const float*)d_in[19]; p.w_kv = (const float*)d_in[20]; p.w_branch = (const float*)d_in[21]; p.w_out = (const float*)d_in[22]; p.g_post = (const float*)d_in[23];
    p.out = (float*)d_out; p.ws = (unsigned char*)d_ws;
    if (hipMemsetAsync((char*)d_ws + WS_CTL, 0, CTL_ZERO_BYTES, stream) != hipSuccess) { fprintf(stderr, "kernel_launch: memset failed\n"); return; }
#if MK_N_LAUNCHES == 1
    p.ph_lo = 0; p.ph_hi = 6;
    void* args[] = {&p};
    hipError_t e = hipLaunchCooperativeKernel((const void*)fwd_kernel, dim3(grid), dim3(512), args, LDS_BYTES, stream);
    if (e != hipSuccess) fprintf(stderr, "kernel_launch: cooperative launch failed: %s (grid %d)\n", hipGetErrorString(e), grid);
#else
    for (int ph = 0; ph < 6; ++ph) { p.ph_lo = ph; p.ph_hi = ph + 1; hipLaunchKernelGGL(fwd_kernel, dim3(grid), dim3(512), LDS_BYTES, stream, p); }
#endif
}
```

```cpp
#include <hip/hip_runtime.h>
#include <hip/hip_cooperative_groups.h>
#include <cstdio>
#include <cstdint>
namespace cg = cooperative_groups;

#define LAS __attribute__((address_space(3)))
typedef unsigned short bf16_t;
typedef short bf16x8 __attribute__((ext_vector_type(8)));
typedef short bf16x4 __attribute__((ext_vector_type(4)));
typedef float f32x4 __attribute__((ext_vector_type(4)));
typedef float f32x2 __attribute__((ext_vector_type(2)));
typedef unsigned u32x4 __attribute__((ext_vector_type(4)));
typedef unsigned u32x2 __attribute__((ext_vector_type(2)));

#ifndef MK_N_LAUNCHES
#define MK_N_LAUNCHES 1
#endif
#ifndef CG_SEAM_MASK
#define CG_SEAM_MASK 0
#endif
#define USE_CG_SEAM(k) (((CG_SEAM_MASK) >> (k)) & 1)
#ifndef PROBE_REPEAT
#define PROBE_REPEAT -1
#endif

constexpr int DM = 2048, NBATCH = 4, SEQ = 2048, NS = 128;
constexpr int MP = NBATCH * SEQ;
constexpr int MTOT = MP + NS;
constexpr int MPAD = 8448;
constexpr int DIN = 12288, DMIX = 3072, NMEM = 256;
constexpr int ZC_XR = 0, ZC_GR = 1024, ZC_XP = 2048, ZC_GP = 3072, ZC_Q = 4096, ZC_GX = 5120, ZC_GT = 6144;
constexpr float EPS = 1e-6f;
constexpr float LOG2E = 1.4426950408889634f;

constexpr size_t OFF_Y = 0;
constexpr size_t OFF_NHP = 17039360, OFF_NCP = 17043456, OFF_NPP = 17055744, OFF_MEMK = 17117184, OFF_MEMV = 18165760;
constexpr size_t OFF_NHS = 19214336, OFF_NCS = 19345408, OFF_NPS = 19738624, OUT_TOTAL = 21704704;

constexpr size_t MiB = 1u << 20;
constexpr size_t WS_CTL = 0, WS_WINT = 1 * MiB, WS_WKVT = 49 * MiB, WS_WBT = 57 * MiB, WS_WOT = 69 * MiB, WS_WRGT = 77 * MiB, WS_WPT = 77 * MiB + 512 * 1024;
constexpr size_t WS_U = 78 * MiB, WS_MEMN = 111 * MiB, WS_KB = 115 * MiB, WS_VT = 117 * MiB, WS_Z = 119 * MiB, WS_OALL = 317 * MiB, WS_PART = 367 * MiB;
constexpr size_t WS_MERGED = 433 * MiB, WS_OUTB = 466 * MiB, WS_END = 500 * MiB;
constexpr size_t WS_GR = WS_CTL + 256 * 1024;
constexpr size_t CTL_ZERO_BYTES = 65536;
constexpr int LDS_BYTES = 147456;
constexpr int LDS_MISC_OFF = 147200;

struct Params {
    const float* x_prompt; const float* x_sample; const float* mem; const float* st_h; const float* st_conv; const float* st_pool;
    const float* cache_k; const float* cache_v; const float* g_pre; const float* w_in; const float* conv_w; const float* conv_b;
    const float* w_rg_a; const float* b_rg_a; const float* w_rg_x; const float* b_rg_x; const float* lam; const float* w_pool;
    const float* pool_scale; const float* g_mem; const float* w_kv; const float* w_branch; const float* w_out; const float* g_post;
    float* out; unsigned char* ws; int ph_lo, ph_hi;
};

__device__ __forceinline__ unsigned f2bf(float f) { unsigned u = __builtin_bit_cast(unsigned, f); return (u + 0x7fffu + ((u >> 16) & 1u)) >> 16; }
__device__ __forceinline__ unsigned pk2(float lo, float hi) { unsigned r; asm volatile("v_cvt_pk_bf16_f32 %0, %1, %2" : "=v"(r) : "v"(lo), "v"(hi)); return r; }
__device__ __forceinline__ float bf_lo(unsigned u) { return __builtin_bit_cast(float, u << 16); }
__device__ __forceinline__ float bf_hi(unsigned u) { return __builtin_bit_cast(float, u & 0xffff0000u); }
__device__ __forceinline__ float bf2f(bf16_t b) { return __builtin_bit_cast(float, ((unsigned)b) << 16); }
__device__ __forceinline__ unsigned cvt_pk_bf16(float lo, float hi) { unsigned r; asm volatile("v_cvt_pk_bf16_f32 %0, %1, %2" : "=v"(r) : "v"(lo), "v"(hi)); return r; }
__device__ __forceinline__ float wave_sum(float v) {
#pragma unroll
    for (int o = 1; o < 64; o <<= 1) v += __shfl_xor(v, o);
    return v;
}
__device__ __forceinline__ float wave_max(float v) {
#pragma unroll
    for (int o = 1; o < 64; o <<= 1) v = fmaxf(v, __shfl_xor(v, o));
    return v;
}
__device__ __forceinline__ float sigmoid_f(float x) { return __builtin_amdgcn_rcpf(1.0f + __builtin_amdgcn_exp2f(-x * LOG2E)); }
__device__ __forceinline__ float silu_f(float x) { return x * sigmoid_f(x); }


#define XB_TMO      128
#define XB_XCNT(j)  (256  + 64 * (j))
#define XB_XSUB(j)  (1280 + 64 * (j))
#define XB_XGEN(j)  (2304 + 64 * (j))
#define XB_TOP      3328
#define XB_TOPGEN   3392
#define XCD_BAR_WORDS 3456
#define XB_SPIN_CAP (1u << 18)
__device__ __forceinline__ unsigned xb_ld(unsigned* p)              { return __hip_atomic_load(p, __ATOMIC_RELAXED, __HIP_MEMORY_SCOPE_AGENT); }
__device__ __forceinline__ unsigned xb_add(unsigned* p, unsigned v) { return __hip_atomic_fetch_add(p, v, __ATOMIC_RELAXED, __HIP_MEMORY_SCOPE_AGENT); }
__device__ __forceinline__ unsigned xb_xcc_id() { return (unsigned)__builtin_amdgcn_s_getreg((3 << 11) | 20) & 0xFu; }
#define XB_SPIN(cond, bar) do { unsigned _sp = 0; while (cond) { __builtin_amdgcn_s_sleep(1); \
    if ((++_sp & 255u) == 0u) { if (xb_ld(&(bar)[XB_TMO])) break; if (_sp > XB_SPIN_CAP) { atomicAdd(&(bar)[XB_TMO], 1u); break; } } } } while (0)
struct XcdBarrier { unsigned* bar; unsigned x; volatile LAS unsigned* st; };
__device__ __forceinline__ XcdBarrier xcd_barrier_post(unsigned* bar, volatile LAS unsigned* st) {
    XcdBarrier b; b.bar = bar; b.x = xb_xcc_id(); b.st = st;
    if (threadIdx.x == 0) (void)xb_add(&bar[XB_XCNT(b.x)], 1u);
    return b;
}
__device__ __forceinline__ void xcd_barrier_complete(unsigned* bar, unsigned x, unsigned& nloc, unsigned& nx) {
    const unsigned G = gridDim.x * gridDim.y * gridDim.z;
    unsigned sum, cnt, mine, sp = 0u;
    for (;;) {
        sum = 0u; cnt = 0u; mine = 0u;
#pragma unroll
        for (unsigned j = 0; j < 16; ++j) { const unsigned c = xb_ld(&bar[XB_XCNT(j)]); sum += c; cnt += (c > 0u) ? 1u : 0u; mine = (j == x) ? c : mine; }
        if (sum == G) break;
        __builtin_amdgcn_s_sleep(1);
        if ((++sp & 255u) == 0u) { if (xb_ld(&bar[XB_TMO])) break; if (sp > XB_SPIN_CAP) { atomicAdd(&bar[XB_TMO], 1u); break; } }
    }
    nloc = mine > 0u ? mine : 1u; nx = cnt > 0u ? cnt : 1u;
}
__device__ __forceinline__ void xcd_barrier(const XcdBarrier& b) {
    asm volatile("s_waitcnt vmcnt(0)" ::: "memory");
    __syncthreads();
    if (threadIdx.x == 0) {
        unsigned* bar = b.bar;
        __builtin_amdgcn_s_waitcnt(0);
        unsigned nloc = b.st[0], nx = b.st[1];
        if (nloc == 0u) { xcd_barrier_complete(bar, b.x, nloc, nx); b.st[0] = nloc; b.st[1] = nx; }
        const unsigned old = xb_add(&bar[XB_XSUB(b.x)], 1u);
        const unsigned gen = old / nloc;
        if (old + 1u == (gen + 1u) * nloc) {
            __builtin_amdgcn_fence(__ATOMIC_RELEASE, "agent");
            asm volatile("s_waitcnt vmcnt(0)" ::: "memory");
            const unsigned og = xb_add(&bar[XB_TOP], 1u);
            const unsigned tg = og / nx;
            if (og + 1u == (tg + 1u) * nx) xb_add(&bar[XB_TOPGEN], 1u);
            else XB_SPIN(xb_ld(&bar[XB_TOPGEN]) == tg, bar);
            __builtin_amdgcn_fence(__ATOMIC_ACQUIRE, "agent");
            xb_add(&bar[XB_XGEN(b.x)], 1u);
            asm volatile("s_waitcnt vmcnt(0)" ::: "memory");
        } else {
            XB_SPIN(xb_ld(&bar[XB_XGEN(b.x)]) == gen, bar);
            __builtin_amdgcn_fence(__ATOMIC_ACQUIRE, "agent");
            asm volatile("s_waitcnt vmcnt(0)" ::: "memory");
        }
    }
    __syncthreads();
}

namespace pg8 {
constexpr int BM = 256, BK = 64, HALF = 128, HTB = HALF * BK * 2, STAGE_BYTES = 8 * HTB, NXCD = 8, WGM = 4;
__device__ __forceinline__ int lds_byte(int r, int c) { const int st = (r >> 4) * 2 + (c >> 5), rr = r & 15, cc = c & 31, ob = rr * 64 + cc * 2; return st * 1024 + (ob ^ (((ob >> 9) & 1) << 5)); }
__device__ __forceinline__ void stage_rc(int b, int& R, int& C) { const int st = b / 1024, sb = b % 1024, swz = sb ^ (((sb >> 9) & 1) << 5); R = (st >> 1) * 16 + swz / 64; C = (st & 1) * 32 + (swz % 64) / 2; }
__device__ __forceinline__ int perm32(int rho) { const int n = rho >> 4, i = rho & 15; return 8 * (i >> 2) + 4 * n + (i & 3); }

struct Unit { const char* A; const char* B; int pm, pn, kind, aux, nt, half, ks, grp; };
struct TileOrder {
    int nM, nN, nwg;
    __device__ __forceinline__ void init(int nM_, int nN_) { nM = nM_; nN = nN_; nwg = nM_ * nN_; }
    __device__ __forceinline__ void map(int L, int& pm, int& pn) const {
        int wgid = L; { const int q = nwg / NXCD, r = nwg % NXCD, xcd = wgid % NXCD, off = wgid / NXCD; wgid = (xcd < r ? xcd * (q + 1) : r * (q + 1) + (xcd - r) * q) + off; }
        const int nig = WGM * nN, gid = wgid / nig, fm = gid * WGM, gsz = (nM - fm) < WGM ? (nM - fm) : WGM;
        pm = fm + ((wgid % nig) % gsz); pn = (wgid % nig) / gsz;
    }
};

template <class Epi, class Sched>
__device__ __forceinline__ void gemm_phase(LAS unsigned char* lds, const int lda, const int ldb, const Sched& S, const Epi& E) {
    const int tid = threadIdx.x, wid = __builtin_amdgcn_readfirstlane(tid >> 6), lane = tid & 63, wr = wid >> 2, wc = wid & 3, fr = lane & 15, fq = lane >> 4;
    unsigned voffA[2], voffB[2];
#pragma unroll
    for (int i = 0; i < 2; ++i) { int R, C; stage_rc(tid * 16 + i * 8192, R, C); const int Rb = (R & ~31) + perm32(R & 31);
        voffA[i] = (unsigned)(R * lda + C) * 2u; voffB[i] = (unsigned)(Rb * ldb + C) * 2u; }
    const size_t kstep = (size_t)(BK * 2);
    const size_t hstepA = (size_t)HALF * lda * 2, hstepB = (size_t)HALF * ldb * 2;
    const unsigned ldsw = (unsigned)wid * 1024u;
    const int aoff = lds_byte(wr * 64 + fr, fq * 8), boff = lds_byte(wc * 32 + fr, fq * 8);
#define PG8_SA(b, h) (((b) * 2 + (h)) * HTB)
#define PG8_SB(b, h) ((4 + (b) * 2 + (h)) * HTB)
#define PG8_STAGE(bufoff, gbase, voff) do { _Pragma("unroll") for (int _i = 0; _i < 2; ++_i) \
        __builtin_amdgcn_global_load_lds((const unsigned*)((const char*)(gbase) + (voff)[_i]), (LAS unsigned*)(lds + (bufoff) + ldsw + _i * 8192), 16, 0, 0); } while (0)
#define PG8_LDA(dst, b, h) do { _Pragma("unroll") for (int m = 0; m < 4; ++m) _Pragma("unroll") for (int k = 0; k < 2; ++k) dst[m][k] = *(const LAS bf16x8*)(lds + PG8_SA(b, h) + aoff + m * 2048 + k * 1024); } while (0)
#define PG8_LDB(dst, b, h) do { _Pragma("unroll") for (int n = 0; n < 2; ++n) _Pragma("unroll") for (int k = 0; k < 2; ++k) dst[n][k] = *(const LAS bf16x8*)(lds + PG8_SB(b, h) + boff + n * 2048 + k * 1024); } while (0)
#define PG8_MMA(ai, bj, At, Bt) do { __builtin_amdgcn_s_setprio(1); _Pragma("unroll") for (int m = 0; m < 4; ++m) _Pragma("unroll") for (int n = 0; n < 2; ++n) _Pragma("unroll") for (int k = 0; k < 2; ++k) \
        acc[ai][bj][m][n] = __builtin_amdgcn_mfma_f32_16x16x32_bf16(Bt[n][k], At[m][k], acc[ai][bj][m][n], 0, 0, 0); __builtin_amdgcn_s_setprio(0); } while (0)
#define PG8_WAIT_V(n) asm volatile("s_waitcnt vmcnt(" #n ")" ::: "memory")
#define PG8_WAIT_L(n) asm volatile("s_waitcnt lgkmcnt(" #n ")" ::: "memory")
#define PG8_BAR __builtin_amdgcn_s_barrier()
#define PG8_SCHED __builtin_amdgcn_sched_barrier(0)
    Unit cur, nxt; int ui = 0;
    if (!S.next(0, cur)) return;
    f32x4 acc[2][2][4][2];
#pragma unroll
    for (int a = 0; a < 2; ++a)
#pragma unroll
        for (int b = 0; b < 2; ++b)
#pragma unroll
            for (int m = 0; m < 4; ++m)
#pragma unroll
                for (int n = 0; n < 2; ++n) acc[a][b][m][n] = (f32x4){0.f, 0.f, 0.f, 0.f};
    bf16x8 At[4][2], B0[2][2], B1[2][2];
    const char* cA = cur.A; const char* cB = cur.B;
    PG8_STAGE(PG8_SB(0, 0), cB, voffB); PG8_STAGE(PG8_SB(0, 1), cB + hstepB, voffB); PG8_STAGE(PG8_SA(0, 0), cA, voffA); PG8_STAGE(PG8_SA(0, 1), cA + hstepA, voffA);
    if (wr == 1) PG8_BAR;
    PG8_WAIT_V(2); PG8_BAR;
    PG8_STAGE(PG8_SB(1, 0), cB + kstep, voffB); PG8_STAGE(PG8_SA(1, 0), cA + kstep, voffA); PG8_STAGE(PG8_SB(1, 1), cB + hstepB + kstep, voffB);
    PG8_WAIT_V(6); PG8_BAR;
    for (;;) {
        const bool has_next = S.next(ui + 1, nxt);
        const char* nA = has_next ? nxt.A : cA; const char* nB = has_next ? nxt.B : cB;
        const int nt = cur.nt; const bool full = (cur.half == 0);
        for (int t = 0; t < nt; t += 2) {
            const bool last = (t == nt - 2);
            if (last && has_next) S.a_ready(nxt);
            const char* a1 = cA + (size_t)(t + 1) * kstep;
            const char* a2 = last ? nA : cA + (size_t)(t + 2) * kstep; const char* b2 = last ? nB : cB + (size_t)(t + 2) * kstep;
            const char* a3 = a2 + kstep; const char* b3 = b2 + kstep;
            PG8_LDB(B0, 0, 0); PG8_LDB(B1, 0, 1); PG8_SCHED; PG8_LDA(At, 0, 0); PG8_STAGE(PG8_SA(1, 1), a1 + hstepA, voffA);
            PG8_WAIT_V(8); PG8_WAIT_L(0); PG8_BAR; PG8_MMA(0, 0, At, B0); PG8_MMA(0, 1, At, B1); PG8_BAR; PG8_SCHED;
            PG8_LDA(At, 0, 1); PG8_STAGE(PG8_SB(0, 0), b2, voffB); PG8_STAGE(PG8_SB(0, 1), b2 + hstepB, voffB); PG8_STAGE(PG8_SA(0, 0), a2, voffA);
            PG8_WAIT_V(8); PG8_WAIT_L(0); PG8_BAR; if (full) { PG8_MMA(1, 0, At, B0); PG8_MMA(1, 1, At, B1); } PG8_BAR; PG8_SCHED;
            PG8_LDB(B0, 1, 0); PG8_LDB(B1, 1, 1); PG8_SCHED; PG8_LDA(At, 1, 0); PG8_STAGE(PG8_SA(0, 1), a2 + hstepA, voffA);
            PG8_WAIT_V(8); PG8_WAIT_L(0); PG8_BAR; PG8_MMA(0, 0, At, B0); PG8_MMA(0, 1, At, B1); PG8_BAR; PG8_SCHED;
            PG8_LDA(At, 1, 1); PG8_STAGE(PG8_SB(1, 0), b3, voffB); PG8_STAGE(PG8_SB(1, 1), b3 + hstepB, voffB); PG8_STAGE(PG8_SA(1, 0), a3, voffA);
            PG8_WAIT_V(8); PG8_WAIT_L(0); PG8_BAR; if (full) { PG8_MMA(1, 0, At, B0); PG8_MMA(1, 1, At, B1); } PG8_BAR; PG8_SCHED;
        }
        if (wr == 0) PG8_BAR;
        E(acc, cur, wr, wc, fr, fq);
        if (!has_next) break;
#pragma unroll
        for (int a = 0; a < 2; ++a)
#pragma unroll
            for (int b = 0; b < 2; ++b)
#pragma unroll
                for (int m = 0; m < 4; ++m)
#pragma unroll
                    for (int n = 0; n < 2; ++n) acc[a][b][m][n] = (f32x4){0.f, 0.f, 0.f, 0.f};
        cur = nxt; cA = nA; cB = nB; ++ui;
        if (wr == 1) PG8_BAR;
    }
    PG8_WAIT_V(0);
    PG8_BAR;
#undef PG8_SA
#undef PG8_SB
#undef PG8_STAGE
#undef PG8_LDA
#undef PG8_LDB
#undef PG8_MMA
#undef PG8_WAIT_V
#undef PG8_WAIT_L
#undef PG8_BAR
#undef PG8_SCHED
}
}

constexpr int SLAB_FLOATS = 32 * 512 * 4;
constexpr int CW_CNT = 4096;
constexpr int CNT_P1S = 0, CNT_P1KV = 48, CNT_P3S = 80, CNT_P4S = 88;
constexpr int CW_DONE4 = 10240;
constexpr int CW_DONE = 13312;
template <int NSL, bool HALF, int KS>
__device__ __forceinline__ unsigned share_body(f32x4 (&acc)[2][2][4][2], const float* slabs, int tid) {
    unsigned mask = 0;
    const f32x4* p0 = (const f32x4*)slabs + tid;
#pragma unroll
    for (int c = 0; c < (HALF ? 8 : 16); ++c) { if (c % NSL != KS) continue;
        const int ai = c >> 3, bj = (c >> 2) & 1, m = c & 3; mask |= 1u << c;
#pragma unroll
        for (int s = 0; s < NSL; ++s) { if (s == KS) continue;
            acc[ai][bj][m][0] += p0[(size_t)s * (SLAB_FLOATS / 4) + (size_t)(c * 2 + 0) * 512]; acc[ai][bj][m][1] += p0[(size_t)s * (SLAB_FLOATS / 4) + (size_t)(c * 2 + 1) * 512]; }
        asm volatile("" ::: "memory"); }
    return mask;
}
template <int NSL, bool HALF>
__device__ __forceinline__ unsigned splitk_share(f32x4 (&acc)[2][2][4][2], float* slabs, int ks, unsigned* cnt, volatile LAS unsigned* misc) {
    int tid_ = threadIdx.x; asm volatile("" : "+v"(tid_));
    const int tid = tid_;
    {
      const unsigned long long pa = (unsigned long long)(slabs + (size_t)ks * SLAB_FLOATS);
      const unsigned plo = __builtin_amdgcn_readfirstlane((unsigned)pa), phi = __builtin_amdgcn_readfirstlane((unsigned)(pa >> 32));
      const __amdgpu_buffer_rsrc_t rs = __builtin_amdgcn_make_buffer_rsrc((void*)(((unsigned long long)phi << 32) | plo), (short)0, SLAB_FLOATS * 4, 0x00020000);
#pragma unroll
      for (int ai = 0; ai < (HALF ? 1 : 2); ++ai)
#pragma unroll
          for (int bj = 0; bj < 2; ++bj)
#pragma unroll
              for (int m = 0; m < 4; ++m)
#pragma unroll
                  for (int n = 0; n < 2; ++n) __builtin_amdgcn_raw_buffer_store_b128(__builtin_bit_cast(u32x4, acc[ai][bj][m][n]), rs, (unsigned)tid * 16u, ((((ai * 2 + bj) * 4 + m) * 2 + n) * 512) * 16, 16); }
    asm volatile("s_waitcnt vmcnt(0)" ::: "memory");
    __syncthreads();
    if (tid == 0) {
        (void)__hip_atomic_fetch_add(cnt, 1u, __ATOMIC_RELAXED, __HIP_MEMORY_SCOPE_AGENT);
        unsigned spins = 0;
        while (__hip_atomic_load(cnt, __ATOMIC_RELAXED, __HIP_MEMORY_SCOPE_AGENT) < (unsigned)NSL) { __builtin_amdgcn_s_sleep(2); if (++spins > (1u << 21)) break; }
        __builtin_amdgcn_fence(__ATOMIC_ACQUIRE, "agent"); asm volatile("s_waitcnt vmcnt(0)" ::: "memory");
    }
    __syncthreads();
    unsigned mask = 0;
    if (NSL >= 1 && ks == 0) mask = share_body<NSL, HALF, 0>(acc, slabs, tid);
    if (NSL >= 2 && ks == 1) mask = share_body<NSL, HALF, (NSL >= 2 ? 1 : 0)>(acc, slabs, tid);
    if (NSL >= 3 && ks == 2) mask = share_body<NSL, HALF, (NSL >= 3 ? 2 : 0)>(acc, slabs, tid);
    if (NSL >= 4 && ks == 3) mask = share_body<NSL, HALF, (NSL >= 4 ? 3 : 0)>(acc, slabs, tid);
    if (NSL >= 5 && ks == 4) mask = share_body<NSL, HALF, (NSL >= 5 ? 4 : 0)>(acc, slabs, tid);
    if (NSL >= 6 && ks == 5) mask = share_body<NSL, HALF, (NSL >= 6 ? 5 : 0)>(acc, slabs, tid);
    return mask;
}

__device__ __forceinline__ void publish_count(unsigned* ctr) {
    asm volatile("s_waitcnt vmcnt(0)" ::: "memory"); __syncthreads();
    if (threadIdx.x == 0) { __builtin_amdgcn_fence(__ATOMIC_RELEASE, "agent"); asm volatile("s_waitcnt vmcnt(0)" ::: "memory"); __hip_atomic_fetch_add(ctr, 1u, __ATOMIC_RELAXED, __HIP_MEMORY_SCOPE_AGENT); }
}
__device__ __forceinline__ void publish_count_wt(unsigned* ctr) {
    asm volatile("s_waitcnt vmcnt(0)" ::: "memory"); __syncthreads();
    if (threadIdx.x == 0) __hip_atomic_fetch_add(ctr, 1u, __ATOMIC_RELAXED, __HIP_MEMORY_SCOPE_AGENT);
}
__device__ __forceinline__ void poll_count(unsigned* ctr, unsigned need) {
    unsigned spins = 0;
    while (__hip_atomic_load(ctr, __ATOMIC_RELAXED, __HIP_MEMORY_SCOPE_AGENT) < need) { __builtin_amdgcn_s_sleep(4); if (++spins > (1u << 21)) break; }
    __builtin_amdgcn_fence(__ATOMIC_ACQUIRE, "agent"); asm volatile("s_waitcnt vmcnt(0)" ::: "memory");
}

struct SchedP1 {
    int mode; int G, c; pg8::TileOrder to; const char* U; const char* WinT; const char* MEMN; const char* WkvT;
    __device__ __forceinline__ void a_ready(const pg8::Unit&) const {}
    __device__ __forceinline__ bool next(int i, pg8::Unit& u) const {
        const int L = i * G + c;
        int e;
        if (mode == 1) e = L;
        else { if (L < 32 * 48) { int pm, pn; to.map(L, pm, pn); u.A = U + (size_t)pm * 256 * 2048 * 2; u.B = WinT + (size_t)pn * 256 * 2048 * 2; u.pm = pm; u.pn = pn; u.kind = 0; u.nt = 32; u.half = 0; u.ks = 0; u.grp = 0; return true; }
            if (mode == 0) return false;
            e = L - 32 * 48; }
        if (e >= 80) return false;
        u.nt = 32; u.ks = 0; u.grp = 0;
        if (e < 32) { const int pm = e & 3, pn = e >> 2;
            u.A = MEMN + (size_t)pm * 256 * 2048 * 2; u.B = WkvT + (size_t)pn * 256 * 2048 * 2; u.pm = pm; u.pn = pn; u.kind = 2; u.half = 0; }
        else { const int t = e - 32;
            u.A = U + (size_t)32 * 256 * 2048 * 2; u.B = WinT + (size_t)t * 256 * 2048 * 2; u.pm = 32; u.pn = t; u.kind = 1; u.half = 1; }
        return true;
    }
};
template <bool EXTRA>
struct EpiP1T {
    bf16_t* Z; float* out; bf16_t* KB; bf16_t* VT; float* slabs; unsigned* cnt; volatile LAS unsigned* misc; unsigned* done;
    __device__ __forceinline__ void publish(int which) const {
        asm volatile("s_waitcnt vmcnt(0)" ::: "memory"); __syncthreads();
        if (threadIdx.x == 0) { __builtin_amdgcn_fence(__ATOMIC_RELEASE, "agent"); asm volatile("s_waitcnt vmcnt(0)" ::: "memory"); __hip_atomic_fetch_add(done + 64 * which, 1u, __ATOMIC_RELAXED, __HIP_MEMORY_SCOPE_AGENT); }
    }
    __device__ __forceinline__ void operator()(f32x4 (&acc)[2][2][4][2], const pg8::Unit& u, int wr, int wc, int fr, int fq) const {
        const int row0 = u.pm * 256 + wr * 64 + fr, col0 = u.pn * 256 + wc * 32 + 8 * fq;
        unsigned cm = 0xffffu;

        if (!EXTRA || u.kind != 2) {
            const int seg = u.pn >> 2;
            const int act = (seg >= 6) ? 2 : ((seg & 1) ? 1 : 0);
#pragma unroll
            for (int ai = 0; ai < 2; ++ai) { if (ai == 1 && u.half) break;
#pragma unroll
                for (int m = 0; m < 4; ++m) { bf16_t* rowp = Z + (size_t)(row0 + ai * 128 + m * 16) * DIN + col0;
#pragma unroll
                    for (int bj = 0; bj < 2; ++bj) { if (EXTRA && !((cm >> ((ai * 2 + bj) * 4 + m)) & 1u)) continue;
                        f32x4 v0 = acc[ai][bj][m][0], v1 = acc[ai][bj][m][1];
                        if (act == 1) {
#pragma unroll
                            for (int j = 0; j < 4; ++j) { v0[j] = silu_f(v0[j]); v1[j] = silu_f(v1[j]); } }
                        else if (act == 2) {
#pragma unroll
                            for (int j = 0; j < 4; ++j) { v0[j] = sigmoid_f(v0[j]); v1[j] = sigmoid_f(v1[j]); } }
                        u32x4 w; w.x = cvt_pk_bf16(v0[0], v0[1]); w.y = cvt_pk_bf16(v0[2], v0[3]); w.z = cvt_pk_bf16(v1[0], v1[1]); w.w = cvt_pk_bf16(v1[2], v1[3]);
                        __builtin_nontemporal_store(w, (u32x4*)(rowp + bj * 128)); } } }
            if (EXTRA) publish(1);
        } else {
            const bool isV = u.pn >= 4;
            const int c0 = isV ? col0 - 1024 : col0;
            float* ob = out + (isV ? OFF_MEMV : OFF_MEMK);
#pragma unroll
            for (int ai = 0; ai < 2; ++ai)
#pragma unroll
                for (int m = 0; m < 4; ++m) { const int row = row0 + ai * 128 + m * 16;
#pragma unroll
                    for (int bj = 0; bj < 2; ++bj) { if (!((cm >> ((ai * 2 + bj) * 4 + m)) & 1u)) continue;
                        const f32x4 v0 = acc[ai][bj][m][0], v1 = acc[ai][bj][m][1]; const int col = c0 + bj * 128;
                        __builtin_nontemporal_store(v0, (f32x4*)(ob + (size_t)row * 1024 + col)); __builtin_nontemporal_store(v1, (f32x4*)(ob + (size_t)row * 1024 + col + 4));
                        if (!isV) { u32x4 w; w.x = cvt_pk_bf16(v0[0], v0[1]); w.y = cvt_pk_bf16(v0[2], v0[3]); w.z = cvt_pk_bf16(v1[0], v1[1]); w.w = cvt_pk_bf16(v1[2], v1[3]);
                            *(u32x4*)(KB + (size_t)row * 1024 + col) = w; }
                        else {
#pragma unroll
                            for (int j = 0; j < 4; ++j) { VT[(size_t)(col + j) * 1024 + row] = (bf16_t)f2bf(v0[j]); VT[(size_t)(col + 4 + j) * 1024 + row] = (bf16_t)f2bf(v1[j]); } } } }
            publish(0);
        }
    }
};
__device__ __forceinline__ void wait_done(unsigned* done) {
    if (threadIdx.x == 0) { unsigned spins = 0;
        while (__hip_atomic_load(done, __ATOMIC_RELAXED, __HIP_MEMORY_SCOPE_AGENT) < 32u || __hip_atomic_load(done + 64, __ATOMIC_RELAXED, __HIP_MEMORY_SCOPE_AGENT) < 48u) { __builtin_amdgcn_s_sleep(8); if (++spins > (1u << 21)) break; }
        __builtin_amdgcn_fence(__ATOMIC_ACQUIRE, "agent"); asm volatile("s_waitcnt vmcnt(0)" ::: "memory"); }
    __syncthreads();
}
struct SchedP3 {
    int G, c; pg8::TileOrder to; const char* OALL; const char* WbT;
    __device__ __forceinline__ void a_ready(const pg8::Unit&) const {}
    __device__ __forceinline__ bool next(int i, pg8::Unit& u) const {
        const int nmine = (32 * 8 - c + G - 1) / G;
        int e = 48;
        if (G == 256) {
            int qm, qn; to.map(c, qm, qn);
            if (qm < 6) { if (i == 0) e = qm * 8 + qn; else i -= 1; }
        }
        if (e >= 48 && i < 3 * nmine) { const int ti = i / 3, j = i - 3 * ti; const int L = ti * G + c;
            int pm, pn; to.map(L, pm, pn);
            u.A = OALL + ((size_t)pm * 256 * DMIX + (size_t)j * 1024) * 2; u.B = WbT + ((size_t)pn * 256 * DMIX + (size_t)j * 1024) * 2; u.pm = pm; u.pn = pn; u.kind = 0; u.aux = j; u.nt = 16; u.half = 0; u.ks = 0; u.grp = 0; return true; }
        if (G != 256) e = (i - 3 * nmine) * G + c;
        if (e >= 48) return false;
        const int pn = e / 6, r = e - 6 * pn, j = r >> 1, k2 = r & 1;
        u.A = OALL + ((size_t)32 * 256 * DMIX + (size_t)j * 1024 + (size_t)k2 * 512) * 2; u.B = WbT + ((size_t)pn * 256 * DMIX + (size_t)j * 1024 + (size_t)k2 * 512) * 2;
        u.pm = 32; u.pn = pn; u.kind = 1; u.aux = j; u.nt = 8; u.half = 1; u.ks = r; u.grp = pn; return true;
    }
};
struct EpiP3 {
    const bf16_t* Z; bf16_t* PART; bf16_t* MERGED; float* slabs; unsigned* cnt; volatile LAS unsigned* misc; unsigned* done3;
    __device__ __forceinline__ void operator()(f32x4 (&acc)[2][2][4][2], const pg8::Unit& u, int wr, int wc, int fr, int fq) const {
        const int row0 = u.pm * 256 + wr * 64 + fr, col0 = u.pn * 256 + wc * 32 + 8 * fq, j = u.aux;
        if (u.kind == 0) {
            const __amdgpu_buffer_rsrc_t mrs = __builtin_amdgcn_make_buffer_rsrc((void*)MERGED, (short)0, (int)((size_t)MPAD * DM * 2), 0x00020000);
#pragma unroll
            for (int ai = 0; ai < 2; ++ai) {
                u32x4 g[4][2], pp[4][2];
#pragma unroll
                for (int m = 0; m < 4; ++m)
#pragma unroll
                    for (int bj = 0; bj < 2; ++bj) g[m][bj] = __builtin_nontemporal_load((const u32x4*)(Z + (size_t)(row0 + ai * 128 + m * 16) * DIN + ZC_GT + j * DM + col0 + bj * 128));
#pragma unroll
                for (int m = 0; m < 4; ++m)
#pragma unroll
                    for (int bj = 0; bj < 2; ++bj) { pp[m][bj] = (u32x4){0u, 0u, 0u, 0u}; if (j > 0) pp[m][bj] = *(const u32x4*)(PART + (size_t)(row0 + ai * 128 + m * 16) * DM + col0 + bj * 128); }
#pragma unroll
                for (int m = 0; m < 4; ++m) { const size_t row = (size_t)(row0 + ai * 128 + m * 16);
#pragma unroll
                    for (int bj = 0; bj < 2; ++bj) { const int col = col0 + bj * 128;
                        const u32x4 gg = g[m][bj], q = pp[m][bj];
                        f32x4 p0 = (f32x4){bf_lo(q.x), bf_hi(q.x), bf_lo(q.y), bf_hi(q.y)}, p1 = (f32x4){bf_lo(q.z), bf_hi(q.z), bf_lo(q.w), bf_hi(q.w)};
                        const f32x4 a0 = acc[ai][bj][m][0], a1 = acc[ai][bj][m][1];
                        p0[0] += bf_lo(gg.x) * a0[0]; p0[1] += bf_hi(gg.x) * a0[1]; p0[2] += bf_lo(gg.y) * a0[2]; p0[3] += bf_hi(gg.y) * a0[3];
                        p1[0] += bf_lo(gg.z) * a1[0]; p1[1] += bf_hi(gg.z) * a1[1]; p1[2] += bf_lo(gg.w) * a1[2]; p1[3] += bf_hi(gg.w) * a1[3];
                        u32x4 w; w.x = cvt_pk_bf16(p0[0], p0[1]); w.y = cvt_pk_bf16(p0[2], p0[3]); w.z = cvt_pk_bf16(p1[0], p1[1]); w.w = cvt_pk_bf16(p1[2], p1[3]);
                        if (j < 2) *(u32x4*)(PART + row * DM + col) = w;
                        else __builtin_amdgcn_raw_buffer_store_b128(w, mrs, (unsigned)(row * DM + col) * 2u, 0, 16); } }
            }
            if (j == 2) publish_count_wt(done3 + 64 * u.pm);
        } else {
#pragma unroll
            for (int m = 0; m < 4; ++m) { const size_t row = (size_t)(row0 + m * 16);
#pragma unroll
                for (int bj = 0; bj < 2; ++bj) { const int col = col0 + bj * 128;
                    const u32x4 g = __builtin_nontemporal_load((const u32x4*)(Z + row * DIN + ZC_GT + j * DM + col));
                    f32x4& a0 = acc[0][bj][m][0]; f32x4& a1 = acc[0][bj][m][1];
                    a0[0] *= bf_lo(g.x); a0[1] *= bf_hi(g.x); a0[2] *= bf_lo(g.y); a0[3] *= bf_hi(g.y);
                    a1[0] *= bf_lo(g.z); a1[1] *= bf_hi(g.z); a1[2] *= bf_lo(g.w); a1[3] *= bf_hi(g.w); } }
            const __amdgpu_buffer_rsrc_t mrs2 = __builtin_amdgcn_make_buffer_rsrc((void*)MERGED, (short)0, (int)((size_t)MPAD * DM * 2), 0x00020000);
            const unsigned cm = splitk_share<6, true>(acc, slabs + (size_t)u.grp * 6 * SLAB_FLOATS, u.ks, cnt + 64 * u.grp, misc);
#pragma unroll
            for (int m = 0; m < 4; ++m) { const size_t row = (size_t)(row0 + m * 16);
#pragma unroll
                for (int bj = 0; bj < 2; ++bj) { if (!((cm >> (bj * 4 + m)) & 1u)) continue;
                    const int col = col0 + bj * 128; const f32x4 p0 = acc[0][bj][m][0], p1 = acc[0][bj][m][1];
                    u32x4 w; w.x = cvt_pk_bf16(p0[0], p0[1]); w.y = cvt_pk_bf16(p0[2], p0[3]); w.z = cvt_pk_bf16(p1[0], p1[1]); w.w = cvt_pk_bf16(p1[2], p1[3]);
                    __builtin_amdgcn_raw_buffer_store_b128(w, mrs2, (unsigned)(row * DM + col) * 2u, 0, 16); } }
            publish_count_wt(done3 + 64 * 32);
        }
    }
};
struct SchedP4 {
    int G, c; pg8::TileOrder to; const char* MERGED; const char* WoT; unsigned* done3;
    __device__ __forceinline__ bool next(int i, pg8::Unit& u) const {
        const int L = i * G + c;
        if (L < 32 * 8) { int pm, pn; to.map(L, pm, pn);
            u.A = MERGED + (size_t)pm * 256 * DM * 2; u.B = WoT + (size_t)pn * 256 * DM * 2; u.pm = pm; u.pn = pn; u.kind = 0; u.aux = 0; u.nt = 32; u.half = 0; u.ks = 0; u.grp = 0; return true; }
        int e = L - 32 * 8 - 48;
        if (G == 256) {
            if (i != 1) return false;
            int qm, qn; to.map(c, qm, qn); e = (qm >= 8 && qm < 12) ? (qm - 8) * 8 + qn : -1; }
        if (e < 0 || e >= 32) return false;
        const int pn = e >> 2, ks = e & 3;
        u.A = MERGED + ((size_t)32 * 256 * DM + (size_t)ks * 512) * 2; u.B = WoT + ((size_t)pn * 256 * DM + (size_t)ks * 512) * 2; u.pm = 32; u.pn = pn; u.kind = 1; u.aux = 0; u.nt = 8; u.half = 1; u.ks = ks; u.grp = pn; return true;
    }
    __device__ __forceinline__ void a_ready(const pg8::Unit& n) const {
        if (threadIdx.x == 0) poll_count(done3 + 64 * n.pm, n.kind == 0 ? 8u : 48u);
        asm volatile("" ::: "memory"); __builtin_amdgcn_s_barrier(); asm volatile("" ::: "memory");
    }
};
struct EpiP4 {
    bf16_t* OUTF; float* slabs; unsigned* cnt; volatile LAS unsigned* misc; unsigned* done4;
    __device__ __forceinline__ void operator()(f32x4 (&acc)[2][2][4][2], const pg8::Unit& u, int wr, int wc, int fr, int fq) const {
        const int row0 = u.pm * 256 + wr * 64 + fr, col0 = u.pn * 256 + wc * 32 + 8 * fq;
        const __amdgpu_buffer_rsrc_t ors = __builtin_amdgcn_make_buffer_rsrc((void*)OUTF, (short)0, (int)((size_t)MPAD * DM * 2), 0x00020000);
        unsigned cm = 0xffffu;
        if (u.kind != 0) cm = splitk_share<4, true>(acc, slabs + (size_t)u.grp * 4 * SLAB_FLOATS, u.ks, cnt + 64 * u.grp, misc);
#pragma unroll
        for (int ai = 0; ai < 2; ++ai) { if (ai == 1 && u.half) break;
#pragma unroll
            for (int m = 0; m < 4; ++m) { const unsigned ooff = (unsigned)((row0 + ai * 128 + m * 16) * DM + col0) * 2u;
#pragma unroll
                for (int bj = 0; bj < 2; ++bj) { if (!((cm >> ((ai * 2 + bj) * 4 + m)) & 1u)) continue;
                    const f32x4 v0 = acc[ai][bj][m][0], v1 = acc[ai][bj][m][1];
                    u32x4 w; w.x = cvt_pk_bf16(v0[0], v0[1]); w.y = cvt_pk_bf16(v0[2], v0[3]); w.z = cvt_pk_bf16(v1[0], v1[1]); w.w = cvt_pk_bf16(v1[2], v1[3]);
                    __builtin_amdgcn_raw_buffer_store_b128(w, ors, ooff, bj * 256, 16); } } }
        publish_count_wt(done4 + 64 * u.pm);
    }
};

__device__ __forceinline__ void p0_transpose_item(const float* W, int N, bf16_t* WT, int ldt, LAS float* scr, int kb, int nb, int lane) {
    const int k0 = 64 * kb, n0 = 64 * nb;
    f32x4 v[16];
#pragma unroll
    for (int i = 0; i < 16; ++i) { const int idx = lane + 64 * i; v[i] = __builtin_nontemporal_load((const f32x4*)(W + (size_t)(k0 + (idx >> 4)) * N + n0 + 4 * (idx & 15))); }
#pragma unroll
    for (int i = 0; i < 16; ++i) { const int idx = lane + 64 * i, kr = idx >> 4; *(LAS f32x4*)(scr + kr * 68 + ((4 * (idx & 15)) ^ (((kr >> 3) & 3) << 3))) = v[i]; }
    asm volatile("s_waitcnt lgkmcnt(0)" ::: "memory");
    const int c = lane & 7;
#pragma unroll
    for (int j = 0; j < 8; ++j) { const int n = (lane >> 3) + 8 * j; const LAS float* s = scr + (8 * c) * 68 + (n ^ ((c & 3) << 3));
        u32x4 o; o.x = pk2(s[0 * 68], s[1 * 68]); o.y = pk2(s[2 * 68], s[3 * 68]); o.z = pk2(s[4 * 68], s[5 * 68]); o.w = pk2(s[6 * 68], s[7 * 68]);
        *(u32x4*)(WT + (size_t)(n0 + n) * ldt + k0 + 8 * c) = o; }
    asm volatile("s_waitcnt lgkmcnt(0)" ::: "memory");
}
__device__ __forceinline__ void rms_row_to_bf16(const float* xrow, const float* g, bf16_t* orow, int lane) {
    const f32x4* xr = (const f32x4*)xrow + lane; const f32x4* gr = (const f32x4*)g + lane;
    f32x4 v[8]; float s = 0.f;
#pragma unroll
    for (int j = 0; j < 8; ++j) { v[j] = __builtin_nontemporal_load(xr + 64 * j); s += (v[j].x * v[j].x + v[j].y * v[j].y) + (v[j].z * v[j].z + v[j].w * v[j].w); }
    const float rs = 1.0f / sqrtf(wave_sum(s) * (1.0f / DM) + EPS);
    u32x2* o8 = (u32x2*)orow + lane;
#pragma unroll
    for (int j = 0; j < 8; ++j) { const f32x4 gg = gr[64 * j]; u32x2 w; w.x = pk2(v[j].x * rs * gg.x, v[j].y * rs * gg.y); w.y = pk2(v[j].z * rs * gg.z, v[j].w * rs * gg.w); o8[64 * j] = w; }
}
__device__ __forceinline__ void p0_prologue(const Params& P, LAS unsigned char* lds, int G, int wave, int lane) {
    LAS float* scr = (LAS float*)(lds + wave * 17408);
    const int gw = blockIdx.x * 8 + wave, NGW = G * 8;
    bf16_t* WinT = (bf16_t*)(P.ws + WS_WINT); bf16_t* WkvT = (bf16_t*)(P.ws + WS_WKVT);
    bf16_t* WrgT = (bf16_t*)(P.ws + WS_WRGT); bf16_t* WpT = (bf16_t*)(P.ws + WS_WPT);
    constexpr int I_WIN = 32 * 192, I_WKV = 32 * 32, I_RG = 2 * 8 * 4, I_WP = 4 * 16;
    constexpr int NITEMS = I_WIN + I_WKV + I_RG + I_WP;
    for (int it = gw; it < NITEMS; it += NGW) {
        int r = it;
        if (r < I_WIN) { p0_transpose_item(P.w_in, DIN, WinT, 2048, scr, r / 192, r % 192, lane); continue; } r -= I_WIN;
        if (r < I_WKV) { p0_transpose_item(P.w_kv, 2048, WkvT, 2048, scr, r / 32, r % 32, lane); continue; } r -= I_WKV;
        if (r < I_RG) { const int gate = r >> 5, blk = (r >> 2) & 7, sub = r & 3;
            p0_transpose_item((gate ? P.w_rg_x : P.w_rg_a) + blk * 16384, 128, WrgT + (size_t)(gate * 8 + blk) * 16384, 128, scr, sub >> 1, sub & 1, lane); continue; } r -= I_RG;
        { const int grp = r >> 4, sub = r & 15;
            p0_transpose_item(P.w_pool + grp * 65536, 256, WpT + (size_t)grp * 65536, 256, scr, sub >> 2, sub & 3, lane); }
    }
    { unsigned long long* GR = (unsigned long long*)(P.ws + WS_GR); for (int i = blockIdx.x * 512 + threadIdx.x; i < 4 * 8 * 16 * 128; i += G * 512) GR[i] = ~0ull; }
    bf16_t* U = (bf16_t*)(P.ws + WS_U); bf16_t* MEMN = (bf16_t*)(P.ws + WS_MEMN);
    for (int m = gw; m < MPAD + 1024; m += NGW) {
        if (m < MP) rms_row_to_bf16(P.x_prompt + (size_t)m * DM, P.g_pre, U + (size_t)m * DM, lane);
        else if (m < MTOT) rms_row_to_bf16(P.x_sample + (size_t)(m - MP) * DM, P.g_pre, U + (size_t)m * DM, lane);
        else if (m < MPAD) { u32x2* o8 = (u32x2*)(U + (size_t)m * DM) + lane;
#pragma unroll
            for (int j = 0; j < 8; ++j) o8[64 * j] = (u32x2){0u, 0u}; }
        else rms_row_to_bf16(P.mem + (size_t)(m - MPAD) * DM, P.g_mem, MEMN + (size_t)(m - MPAD) * DM, lane);
    }
}

__device__ __forceinline__ void deferred_prep(const Params& P, LAS unsigned char* lds, int G, int wave, int lane) {
    const int first = (G == 256) ? 80 : 0, nw = G - first;
    if ((int)blockIdx.x < first) return;
    LAS float* scr = (LAS float*)(lds + wave * 17408);
    const int gw = ((int)blockIdx.x - first) * 8 + wave, NGW = nw * 8;
    bf16_t* WbT = (bf16_t*)(P.ws + WS_WBT); bf16_t* WoT = (bf16_t*)(P.ws + WS_WOT);
    constexpr int I_WB = 48 * 32, I_WO = 32 * 32;
    for (int it = gw; it < I_WB + I_WO; it += NGW) {
        if (it < I_WB) p0_transpose_item(P.w_branch, 2048, WbT, 3072, scr, it / 32, it % 32, lane);
        else { const int r = it - I_WB; p0_transpose_item(P.w_out, 2048, WoT, 2048, scr, r / 32, r % 32, lane); }
    }
    for (int r = gw; r < NS * 14 + NS * 2; r += NGW) {
        const float* src; float* dst;
        if (r < NS * 14) { const int s = r / 14, k = r - 14 * s; src = P.st_pool + ((size_t)s * 15 + k + 1) * 1024; dst = P.out + OFF_NPS + ((size_t)s * 15 + k) * 1024; }
        else { const int q = r - NS * 14, s = q >> 1, k = q & 1; src = P.st_conv + ((size_t)s * 3 + k + 1) * 1024; dst = P.out + OFF_NCS + ((size_t)s * 3 + k) * 1024; }
#pragma unroll
        for (int j = 0; j < 4; ++j) __builtin_nontemporal_store(__builtin_nontemporal_load((const f32x4*)src + 64 * j + lane), (f32x4*)dst + 64 * j + lane);
    }
}

__device__ __forceinline__ f32x2 ldz2(const bf16_t* p) { const unsigned u = *(const unsigned*)p; return (f32x2){bf_lo(u), bf_hi(u)}; }
__device__ __forceinline__ f32x2 lds2(const LAS unsigned char* p) { const unsigned u = *(const LAS unsigned*)p; return (f32x2){bf_lo(u), bf_hi(u)}; }
__device__ __forceinline__ u32x4 mul_bf16x8(u32x4 a, u32x4 b) {
    u32x4 o; o.x = pk2(bf_lo(a.x) * bf_lo(b.x), bf_hi(a.x) * bf_hi(b.x)); o.y = pk2(bf_lo(a.y) * bf_lo(b.y), bf_hi(a.y) * bf_hi(b.y));
    o.z = pk2(bf_lo(a.z) * bf_lo(b.z), bf_hi(a.z) * bf_hi(b.z)); o.w = pk2(bf_lo(a.w) * bf_lo(b.w), bf_hi(a.w) * bf_hi(b.w)); return o;
}
__device__ __forceinline__ float one_minus_exp(float x) {
    const float p = -x * (1.0f + x * (0.5f + x * (0.16666667f + x * (0.041666668f + x * (0.0083333338f + x * 0.0013888889f)))));
    const float d = 1.0f - __builtin_amdgcn_exp2f(x * LOG2E);
    return x > -0.25f ? p : d;
}
constexpr unsigned long long GR_EMPTY = ~0ull;

template <bool SAMPLE>
__device__ __forceinline__ void rglru_unit(const Params& P, LAS unsigned char* lds, int b, int n, int c) {
    constexpr int NMT = SAMPLE ? 2 : 16;
    constexpr int NROW = NMT * 16;
    int tid_ = threadIdx.x; asm volatile("" : "+v"(tid_));
    const int tid = tid_, wid = __builtin_amdgcn_readfirstlane(tid >> 6), lane = tid & 63, fr = lane & 15, fq = lane >> 4;
    const bf16_t* Z = (const bf16_t*)(P.ws + WS_Z); bf16_t* OALL = (bf16_t*)(P.ws + WS_OALL); const bf16_t* WrgT = (const bf16_t*)(P.ws + WS_WRGT);
    unsigned long long* GR = (unsigned long long*)(P.ws + WS_GR);
    constexpr int XS = 272;
    LAS unsigned char* XR = lds; LAS unsigned char* HO = lds; LAS unsigned char* XC = lds + 259 * XS;
    const int rowbase = SAMPLE ? MP + 32 * c : b * SEQ + c * 256;
    __syncthreads();
    if (!SAMPLE) {
        u32x4 xv[9];
#pragma unroll
        for (int i = 0; i < 9; ++i) { const int v = tid + 512 * i, row = v >> 4, cv = v & 15; int t = c * 256 - 3 + row; t = t < 0 ? 0 : (t > SEQ - 1 ? SEQ - 1 : t);
            xv[i] = __builtin_nontemporal_load((const u32x4*)(Z + (size_t)(b * SEQ + t) * DIN + ZC_XR + n * 128 + cv * 8)); }
#pragma unroll
        for (int i = 0; i < 9; ++i) { const int v = tid + 512 * i, row = v >> 4, cv = v & 15; const bool neg = (c * 256 - 3 + row) < 0;
            if (row < 259) *(LAS u32x4*)(XR + row * XS + cv * 16) = neg ? (u32x4){0u, 0u, 0u, 0u} : xv[i]; }
    }
    bf16x8 wa[4], wx[4];
    { const bf16_t* pa = WrgT + ((size_t)(0 * 8 + n) * 128 + 16 * wid + fr) * 128 + 8 * fq; const bf16_t* px = WrgT + ((size_t)(1 * 8 + n) * 128 + 16 * wid + fr) * 128 + 8 * fq;
#pragma unroll
      for (int ks = 0; ks < 4; ++ks) { wa[ks] = *(const bf16x8*)(pa + 32 * ks); wx[ks] = *(const bf16x8*)(px + 32 * ks); } }
    const int e = n * 128 + 16 * wid + fr;
    const float ba = P.b_rg_a[e], bx = P.b_rg_x[e];
    const float c8 = -8.0f * log1pf(expf(-P.lam[e]));
    {
      const int cp = tid & 63, seg = tid >> 6, ch = n * 128 + 2 * cp;
      const f32x2 w0 = *(const f32x2*)(P.conv_w + 0 * 1024 + ch), w1 = *(const f32x2*)(P.conv_w + 1 * 1024 + ch), w2 = *(const f32x2*)(P.conv_w + 2 * 1024 + ch), w3 = *(const f32x2*)(P.conv_w + 3 * 1024 + ch);
      const f32x2 cb = *(const f32x2*)(P.conv_b + ch);
      if (!SAMPLE) {
          __syncthreads();
          const int r0 = 32 * seg;
          f32x2 x3 = lds2(XR + (r0 + 0) * XS + 4 * cp), x2 = lds2(XR + (r0 + 1) * XS + 4 * cp), x1 = lds2(XR + (r0 + 2) * XS + 4 * cp);
#pragma unroll 8
          for (int i = 0; i < 32; ++i) { const int t = c * 256 + r0 + i;
              const f32x2 x0 = lds2(XR + (r0 + i + 3) * XS + 4 * cp);
              const f32x2 xc = cb + w0 * x3 + w1 * x2 + w2 * x1 + w3 * x0;
              *(LAS unsigned*)(XC + (r0 + i) * XS + 4 * cp) = pk2(xc.x, xc.y);
              if (t >= SEQ - 3) *(f32x2*)(P.out + OFF_NCP + (size_t)(b * 3 + (t - (SEQ - 3))) * 1024 + ch) = x0;
              x3 = x2; x2 = x1; x1 = x0; }
      } else {
#pragma unroll
          for (int i = 0; i < 4; ++i) { const int sl = 4 * seg + i, s = 32 * c + sl;
              const f32x2 x3 = *(const f32x2*)(P.st_conv + (size_t)(s * 3 + 0) * 1024 + ch), x2 = *(const f32x2*)(P.st_conv + (size_t)(s * 3 + 1) * 1024 + ch), x1 = *(const f32x2*)(P.st_conv + (size_t)(s * 3 + 2) * 1024 + ch);
              const f32x2 x0 = ldz2(Z + (size_t)(MP + s) * DIN + ZC_XR + ch);
              const f32x2 xc = cb + w0 * x3 + w1 * x2 + w2 * x1 + w3 * x0;
              *(LAS unsigned*)(XC + sl * XS + 4 * cp) = pk2(xc.x, xc.y);
              *(f32x2*)(P.out + OFF_NCS + (size_t)(s * 3 + 2) * 1024 + ch) = x0; }
      } }
    __syncthreads();
    unsigned cumA[NMT][2], hloc[NMT][2];
    float Ac = 1.f, Hc = 0.f;
#pragma unroll
    for (int mt = 0; mt < NMT; ++mt) {
        f32x4 racc = (f32x4){0.f, 0.f, 0.f, 0.f}, iacc = racc;
#pragma unroll
        for (int ks = 0; ks < 4; ++ks) { const bf16x8 a = *(const LAS bf16x8*)(XC + (16 * mt + fr) * XS + (32 * ks + 8 * fq) * 2);
            racc = __builtin_amdgcn_mfma_f32_16x16x32_bf16(a, wa[ks], racc, 0, 0, 0); iacc = __builtin_amdgcn_mfma_f32_16x16x32_bf16(a, wx[ks], iacc, 0, 0, 0); }
        float av[4], bv[4];
#pragma unroll
        for (int j = 0; j < 4; ++j) { const int row = 16 * mt + 4 * fq + j;
            const float r = sigmoid_f(racc[j] + ba), ig = sigmoid_f(iacc[j] + bx);
            const float la = c8 * r;
            av[j] = __builtin_amdgcn_exp2f(la * LOG2E); const float mult = __builtin_amdgcn_sqrtf(one_minus_exp(2.0f * la));
            const float xcv = bf2f(*(const LAS bf16_t*)(XC + row * XS + (16 * wid + fr) * 2));
            bv[j] = mult * ig * xcv; }
        if (!SAMPLE) {
            float Pj[4], Qj[4]; float pp = 1.f, qq = 0.f;
#pragma unroll
            for (int j = 0; j < 4; ++j) { qq = av[j] * qq + bv[j]; pp = av[j] * pp; Pj[j] = pp; Qj[j] = qq; }
            float Arun = Ac, Hrun = Hc, Ain = 1.f, Hin = 0.f;
#pragma unroll
            for (int g = 0; g < 4; ++g) { const float pg = __shfl(pp, fr + 16 * g), qg = __shfl(qq, fr + 16 * g); if (g == fq) { Ain = Arun; Hin = Hrun; } Hrun = pg * Hrun + qg; Arun = pg * Arun; }
            Ac = Arun; Hc = Hrun;
            cumA[mt][0] = cvt_pk_bf16(Pj[0] * Ain, Pj[1] * Ain); cumA[mt][1] = cvt_pk_bf16(Pj[2] * Ain, Pj[3] * Ain);
            hloc[mt][0] = cvt_pk_bf16(Pj[0] * Hin + Qj[0], Pj[1] * Hin + Qj[1]); hloc[mt][1] = cvt_pk_bf16(Pj[2] * Hin + Qj[2], Pj[3] * Hin + Qj[3]);
        } else {
            const int s0 = 32 * c + 16 * mt + 4 * fq;
            float hv[4];
#pragma unroll
            for (int j = 0; j < 4; ++j) { const float h0 = P.st_h[(size_t)(s0 + j) * 1024 + e]; hv[j] = av[j] * h0 + bv[j]; P.out[OFF_NHS + (size_t)(s0 + j) * 1024 + e] = hv[j]; }
            cumA[mt][0] = 0u; cumA[mt][1] = 0u; hloc[mt][0] = cvt_pk_bf16(hv[0], hv[1]); hloc[mt][1] = cvt_pk_bf16(hv[2], hv[3]);
        }
    }
    float carry = 0.f;
    if (!SAMPLE) {
        unsigned long long* gbase = GR + (size_t)((b * 8 + n) * 8) * 128 + 16 * wid + fr;
        if (fq == 0) __hip_atomic_store(gbase + (size_t)c * 128, ((unsigned long long)__builtin_bit_cast(unsigned, Hc) << 32) | (unsigned long long)__builtin_bit_cast(unsigned, Ac), __ATOMIC_RELAXED, __HIP_MEMORY_SCOPE_AGENT);
        if (c > 0) {
            unsigned long long g[7]; unsigned spins = 0;
            for (;;) { bool ok = true;
#pragma unroll
                for (int cc = 0; cc < 7; ++cc) { g[cc] = __hip_atomic_load(gbase + (size_t)cc * 128, __ATOMIC_RELAXED, __HIP_MEMORY_SCOPE_AGENT); }
#pragma unroll
                for (int cc = 0; cc < 7; ++cc) ok = ok && (cc >= c || g[cc] != GR_EMPTY);
                if (__all(ok) || ++spins > (1u << 20)) break;
                __builtin_amdgcn_s_sleep(2); }
#pragma unroll
            for (int cc = 0; cc < 7; ++cc) { const float ga = __builtin_bit_cast(float, (unsigned)g[cc]), gh = __builtin_bit_cast(float, (unsigned)(g[cc] >> 32)); const float nc = ga * carry + gh; carry = (cc < c) ? nc : carry; }
        }
        if (c == 7 && fq == 0) P.out[OFF_NHP + (size_t)b * 1024 + e] = Ac * carry + Hc;
    }
#pragma unroll
    for (int mt = 0; mt < NMT; ++mt)
#pragma unroll
        for (int j = 0; j < 4; ++j) { const int row = 16 * mt + 4 * fq + j;
            const unsigned ca = cumA[mt][j >> 1], hl = hloc[mt][j >> 1];
            const float h = ((j & 1) ? bf_hi(ca) : bf_lo(ca)) * carry + ((j & 1) ? bf_hi(hl) : bf_lo(hl));
            *(LAS bf16_t*)(HO + row * XS + (16 * wid + fr) * 2) = (bf16_t)f2bf(h); }
    __syncthreads();
    { u32x4 gg[NROW / 32];
#pragma unroll
      for (int i = 0; i < NROW / 32; ++i) { const int v = tid + 512 * i, row = v >> 4, cv = v & 15; gg[i] = __builtin_nontemporal_load((const u32x4*)(Z + (size_t)(rowbase + row) * DIN + ZC_GR + n * 128 + cv * 8)); }
#pragma unroll
      for (int i = 0; i < NROW / 32; ++i) { const int v = tid + 512 * i, row = v >> 4, cv = v & 15;
          const u32x4 ho = *(const LAS u32x4*)(HO + row * XS + cv * 16);
          *(u32x4*)(OALL + (size_t)(rowbase + row) * DMIX + n * 128 + cv * 8) = mul_bf16x8(ho, gg[i]); } }
}

template <bool SAMPLE>
__device__ __forceinline__ void pool_unit(const Params& P, LAS unsigned char* lds, int b, int g, int blk) {
    int tid_ = threadIdx.x; asm volatile("" : "+v"(tid_));
    const int tid = tid_, wid = __builtin_amdgcn_readfirstlane(tid >> 6), lane = tid & 63, fr = lane & 15, fq = lane >> 4;
    const bf16_t* Z = (const bf16_t*)(P.ws + WS_Z); bf16_t* OALL = (bf16_t*)(P.ws + WS_OALL); const bf16_t* WpT = (const bf16_t*)(P.ws + WS_WPT);
    constexpr int DS = 528;
    LAS unsigned char* XP = lds; LAS unsigned char* OUT = lds; LAS unsigned char* D = lds + 144 * DS;
    const int W = 2 << g;
    const int rowbase = SAMPLE ? MP + 16 * blk : b * SEQ + blk * 128;
    const int nmt = SAMPLE ? 1 : 8;
    __syncthreads();
    if (!SAMPLE) {
        u32x4 xv[9];
#pragma unroll
        for (int i = 0; i < 9; ++i) { const int v = tid + 512 * i, row = v >> 5, cv = v & 31; int t = blk * 128 - 15 + row; t = t < 0 ? 0 : (t > SEQ - 1 ? SEQ - 1 : t);
            xv[i] = __builtin_nontemporal_load((const u32x4*)(Z + (size_t)(b * SEQ + t) * DIN + ZC_XP + g * 256 + cv * 8)); }
#pragma unroll
        for (int i = 0; i < 9; ++i) { const int v = tid + 512 * i, row = v >> 5, cv = v & 31; const bool neg = (blk * 128 - 15 + row) < 0;
            *(LAS u32x4*)(XP + row * DS + cv * 16) = neg ? (u32x4){0u, 0u, 0u, 0u} : xv[i]; }
        __syncthreads();
    }
    { const int cp = tid & 127, seg = tid >> 7, ch = g * 256 + 2 * cp;
      if (!SAMPLE) {
          const int r0 = 15 + 32 * seg;
          f32x2 s = (f32x2){0.f, 0.f};
          for (int k = 1; k < W; ++k) s += lds2(XP + (r0 - k) * DS + 4 * cp);
#pragma unroll 8
          for (int i = 0; i < 32; ++i) { const int t = blk * 128 + 32 * seg + i;
              const f32x2 x0 = lds2(XP + (r0 + i) * DS + 4 * cp); s += x0;
              const float inv = 1.0f / (float)((t + 1) < W ? (t + 1) : W);
              const f32x2 d = s * inv - x0;
              *(LAS unsigned*)(D + (32 * seg + i) * DS + 4 * cp) = pk2(d.x, d.y);
              s -= lds2(XP + (r0 + i - W + 1) * DS + 4 * cp);
              if (t >= SEQ - 15) *(f32x2*)(P.out + OFF_NPP + (size_t)(b * 15 + (t - (SEQ - 15))) * 1024 + ch) = x0; }
      } else {
          const float inv = 1.0f / (float)W;
#pragma unroll
          for (int i = 0; i < 4; ++i) { const int sl = seg + 4 * i, s_ = 16 * blk + sl;
              const f32x2 x0 = ldz2(Z + (size_t)(MP + s_) * DIN + ZC_XP + ch);
              const float* hp = P.st_pool + (size_t)s_ * 15 * 1024 + ch;
              f32x2 hv[15];
#pragma unroll
              for (int k = 1; k < 16; ++k) hv[k - 1] = *(const f32x2*)(hp + (size_t)(15 - k) * 1024);
              f32x2 s = x0;
#pragma unroll
              for (int k = 1; k < 16; ++k) { const f32x2 a = s + hv[k - 1]; s = (k < W) ? a : s; }
              *(f32x2*)(P.out + OFF_NPS + ((size_t)s_ * 15 + 14) * 1024 + ch) = x0;
              const f32x2 d = s * inv - x0;
              *(LAS unsigned*)(D + sl * DS + 4 * cp) = pk2(d.x, d.y); }
      } }
    __syncthreads();
    {
      bf16x8 bw[2][8];
#pragma unroll
      for (int nt = 0; nt < 2; ++nt) { const bf16_t* pw = WpT + ((size_t)g * 256 + 32 * wid + 16 * nt + fr) * 256 + 8 * fq;
#pragma unroll
          for (int ks = 0; ks < 8; ++ks) bw[nt][ks] = *(const bf16x8*)(pw + 32 * ks); }
      const float ps0 = P.pool_scale[g * 256 + 32 * wid + fr], ps1 = P.pool_scale[g * 256 + 32 * wid + 16 + fr];
#pragma unroll 2
      for (int mt = 0; mt < nmt; ++mt) {
          f32x4 a0 = (f32x4){0.f, 0.f, 0.f, 0.f}, a1 = a0;
#pragma unroll
          for (int ks = 0; ks < 8; ++ks) { const bf16x8 a = *(const LAS bf16x8*)(D + (16 * mt + fr) * DS + (32 * ks + 8 * fq) * 2);
              a0 = __builtin_amdgcn_mfma_f32_16x16x32_bf16(a, bw[0][ks], a0, 0, 0, 0); a1 = __builtin_amdgcn_mfma_f32_16x16x32_bf16(a, bw[1][ks], a1, 0, 0, 0); }
#pragma unroll
          for (int j = 0; j < 4; ++j) { const int row = 16 * mt + 4 * fq + j;
              *(LAS bf16_t*)(OUT + row * DS + (32 * wid + fr) * 2) = (bf16_t)f2bf(a0[j] * ps0); *(LAS bf16_t*)(OUT + row * DS + (32 * wid + 16 + fr) * 2) = (bf16_t)f2bf(a1[j] * ps1); }
      } }
    __syncthreads();
    for (int i = 0; i < nmt; ++i) { const int v = tid + 512 * i, row = v >> 5, cv = v & 31;
        const u32x4 ho = *(const LAS u32x4*)(OUT + row * DS + cv * 16);
        const u32x4 gg = __builtin_nontemporal_load((const u32x4*)(Z + (size_t)(rowbase + row) * DIN + ZC_GP + g * 256 + cv * 8));
        *(u32x4*)(OALL + (size_t)(rowbase + row) * DMIX + 1024 + g * 256 + cv * 8) = mul_bf16x8(ho, gg); }
}

__device__ __forceinline__ void attn_stage(LAS unsigned char* lds, const bf16_t* src  , int wid, int lane) {
#pragma unroll
    for (int i = 0; i < 16; ++i) { const int piece = wid * 16 + i, row = 2 * piece + (lane >> 5), p = lane & 31;
        __builtin_amdgcn_global_load_lds((const unsigned*)(src + (size_t)row * 1024 + ((p ^ (row & 15)) << 3)), (LAS unsigned*)(lds + piece * 1024), 16, 0, 0); }
}
__device__ __forceinline__ void attn_unit(const Params& P, LAS unsigned char* lds, int b, int h, int blk) {
    int tid_ = threadIdx.x; asm volatile("" : "+v"(tid_));
    const int tid = tid_, wid = __builtin_amdgcn_readfirstlane(tid >> 6), lane = tid & 63, fr = lane & 15, fq = lane >> 4;
    const bf16_t* Z = (const bf16_t*)(P.ws + WS_Z); bf16_t* OALL = (bf16_t*)(P.ws + WS_OALL); const bf16_t* KB = (const bf16_t*)(P.ws + WS_KB); const bf16_t* VT = (const bf16_t*)(P.ws + WS_VT);
    const int m0 = b * SEQ + blk * 128 + 16 * wid;
    __syncthreads();
    attn_stage(lds, KB + (size_t)(b * 256) * 1024 + h * 256, wid, lane);
    bf16x8 qf[8];
    { const bf16_t* qp = Z + (size_t)(m0 + fr) * DIN + ZC_Q + h * 256 + 8 * fq;
#pragma unroll
      for (int ks = 0; ks < 8; ++ks) qf[ks] = *(const bf16x8*)(qp + 32 * ks); }
    asm volatile("s_waitcnt vmcnt(0)" ::: "memory");
    __syncthreads();
    f32x4 st[16];
#pragma unroll
    for (int t = 0; t < 16; ++t) { f32x4 a = (f32x4){0.f, 0.f, 0.f, 0.f};
#pragma unroll
        for (int ks = 0; ks < 8; ++ks) { const bf16x8 kf = *(const LAS bf16x8*)(lds + (16 * t + fr) * 512 + (((4 * ks + fq) ^ fr) << 4)); a = __builtin_amdgcn_mfma_f32_16x16x32_bf16(kf, qf[ks], a, 0, 0, 0); }
        st[t] = a; }
    __syncthreads();
    attn_stage(lds, VT + (size_t)(h * 256) * 1024 + b * 256, wid, lane);
    float mx = -3.0e38f;
#pragma unroll
    for (int t = 0; t < 16; ++t) mx = fmaxf(mx, fmaxf(fmaxf(st[t][0], st[t][1]), fmaxf(st[t][2], st[t][3])));
    mx = fmaxf(mx, __shfl_xor(mx, 16)); mx = fmaxf(mx, __shfl_xor(mx, 32));
    const float sc = LOG2E * 0.0625f; float sum = 0.f;
#pragma unroll
    for (int t = 0; t < 16; ++t)
#pragma unroll
        for (int j = 0; j < 4; ++j) { const float p = __builtin_amdgcn_exp2f((st[t][j] - mx) * sc); st[t][j] = p; sum += p; }
    sum += __shfl_xor(sum, 16); sum += __shfl_xor(sum, 32);
    const float inv = 1.0f / sum;
    bf16x8 pf[8];
#pragma unroll
    for (int s = 0; s < 8; ++s) { u32x4 w; w.x = cvt_pk_bf16(st[2 * s][0], st[2 * s][1]); w.y = cvt_pk_bf16(st[2 * s][2], st[2 * s][3]); w.z = cvt_pk_bf16(st[2 * s + 1][0], st[2 * s + 1][1]); w.w = cvt_pk_bf16(st[2 * s + 1][2], st[2 * s + 1][3]);
        pf[s] = __builtin_bit_cast(bf16x8, w); }
    asm volatile("s_waitcnt vmcnt(0)" ::: "memory");
    __syncthreads();
    u32x4 gg[8];
#pragma unroll
    for (int i = 0; i < 8; ++i) { const int v = lane + 64 * i, row = v >> 5, cv = v & 31; gg[i] = __builtin_nontemporal_load((const u32x4*)(Z + (size_t)(m0 + row) * DIN + ZC_GX + h * 256 + cv * 8)); }
    u32x2 ov[16];
#pragma unroll
    for (int dt = 0; dt < 16; ++dt) { f32x4 a = (f32x4){0.f, 0.f, 0.f, 0.f};
#pragma unroll
        for (int s = 0; s < 8; ++s) { const LAS unsigned char* rp = lds + (16 * dt + fr) * 512 + 8 * (fq & 1);
            const u32x2 lo = *(const LAS u32x2*)(rp + (((4 * s + (fq >> 1)) ^ fr) << 4)), hi = *(const LAS u32x2*)(rp + (((4 * s + 2 + (fq >> 1)) ^ fr) << 4));
            const u32x4 w = (u32x4){lo.x, lo.y, hi.x, hi.y};
            a = __builtin_amdgcn_mfma_f32_16x16x32_bf16(__builtin_bit_cast(bf16x8, w), pf[s], a, 0, 0, 0); }
        ov[dt].x = pk2(a[0] * inv, a[1] * inv); ov[dt].y = pk2(a[2] * inv, a[3] * inv); }
    __syncthreads();
#pragma unroll
    for (int dt = 0; dt < 16; ++dt) *(LAS u32x2*)(lds + (16 * wid + fr) * 528 + (16 * dt + 4 * fq) * 2) = ov[dt];
    asm volatile("s_waitcnt lgkmcnt(0)" ::: "memory");
    {
#pragma unroll
      for (int i = 0; i < 8; ++i) { const int v = lane + 64 * i, row = v >> 5, cv = v & 31;
          const u32x4 ho = *(const LAS u32x4*)(lds + (16 * wid + row) * 528 + cv * 16);
          *(u32x4*)(OALL + (size_t)(m0 + row) * DMIX + 2048 + h * 256 + cv * 8) = mul_bf16x8(ho, gg[i]); } }
}

__device__ __forceinline__ void sattn_unit(const Params& P, LAS unsigned char* lds, int s, int h) {
    int tid_ = threadIdx.x; asm volatile("" : "+v"(tid_));
    const int tid = tid_, wid = __builtin_amdgcn_readfirstlane(tid >> 6), lane = tid & 63;
    const bf16_t* Z = (const bf16_t*)(P.ws + WS_Z); bf16_t* OALL = (bf16_t*)(P.ws + WS_OALL);
    LAS float* SC = (LAS float*)lds; LAS float* PS = SC + 256; LAS float* PO = PS + 256;
    __syncthreads();
    f32x4 q4;
    { const u32x2 qq = *(const u32x2*)(Z + (size_t)(MP + s) * DIN + ZC_Q + h * 256 + 4 * lane); q4 = (f32x4){bf_lo(qq.x), bf_hi(qq.x), bf_lo(qq.y), bf_hi(qq.y)}; }
    const float* kb = P.cache_k + ((size_t)(s * 256 + 32 * wid) * 4 + h) * 256 + 4 * lane;
    const float* vb = P.cache_v + ((size_t)(s * 256 + 32 * wid) * 4 + h) * 256 + 4 * lane;
    float mysc = 0.f;
    f32x4 v4[32];
    { f32x4 k4[32];
#pragma unroll
      for (int i = 0; i < 32; ++i) k4[i] = __builtin_nontemporal_load((const f32x4*)(kb + (size_t)i * 1024));
#pragma unroll
      for (int i = 0; i < 16; ++i) v4[i] = __builtin_nontemporal_load((const f32x4*)(vb + (size_t)i * 1024));
      float p[32];
#pragma unroll
      for (int i = 0; i < 32; ++i) p[i] = (k4[i].x * q4.x + k4[i].y * q4.y) + (k4[i].z * q4.z + k4[i].w * q4.w);
      float q16[16], q8[8], q4v[4], q2[2];
      { const bool hi = (lane & 32) != 0;
#pragma unroll
        for (int j = 0; j < 16; ++j) { const float send = hi ? p[j] : p[j + 16], keep = hi ? p[j + 16] : p[j]; q16[j] = keep + __shfl_xor(send, 32); } }
      { const bool hi = (lane & 16) != 0;
#pragma unroll
        for (int j = 0; j < 8; ++j) { const float send = hi ? q16[j] : q16[j + 8], keep = hi ? q16[j + 8] : q16[j]; q8[j] = keep + __shfl_xor(send, 16); } }
      { const bool hi = (lane & 8) != 0;
#pragma unroll
        for (int j = 0; j < 4; ++j) { const float send = hi ? q8[j] : q8[j + 4], keep = hi ? q8[j + 4] : q8[j]; q4v[j] = keep + __shfl_xor(send, 8); } }
      { const bool hi = (lane & 4) != 0;
#pragma unroll
        for (int j = 0; j < 2; ++j) { const float send = hi ? q4v[j] : q4v[j + 2], keep = hi ? q4v[j + 2] : q4v[j]; q2[j] = keep + __shfl_xor(send, 4); } }
      { const bool hi = (lane & 2) != 0; const float send = hi ? q2[0] : q2[1], keep = hi ? q2[1] : q2[0]; mysc = keep + __shfl_xor(send, 2); }
      mysc += __shfl_xor(mysc, 1); }
#pragma unroll
    for (int i = 16; i < 32; ++i) v4[i] = __builtin_nontemporal_load((const f32x4*)(vb + (size_t)i * 1024));
    if ((lane & 1) == 0) SC[32 * wid + (lane >> 1)] = mysc;
    __syncthreads();
    { float v[4]; float mx = -3.0e38f;
#pragma unroll
      for (int k = 0; k < 4; ++k) { v[k] = SC[lane + 64 * k]; mx = fmaxf(mx, v[k]); }
      mx = wave_max(mx); float sum = 0.f; const float sc = LOG2E * 0.0625f;
#pragma unroll
      for (int k = 0; k < 4; ++k) { v[k] = __builtin_amdgcn_exp2f((v[k] - mx) * sc); sum += v[k]; }
      sum = wave_sum(sum); const float inv = 1.0f / sum;
      if (wid == 0) {
#pragma unroll
          for (int k = 0; k < 4; ++k) PS[lane + 64 * k] = v[k] * inv; } }
    __syncthreads();
    { f32x4 a = (f32x4){0.f, 0.f, 0.f, 0.f};
#pragma unroll
      for (int i = 0; i < 32; ++i) { const float p = PS[32 * wid + i]; a += v4[i] * p; }
      *(LAS f32x4*)(PO + wid * 256 + 4 * lane) = a; }
    __syncthreads();
    if (tid < 256) { float o = 0.f;
#pragma unroll
        for (int w = 0; w < 8; ++w) o += PO[w * 256 + tid];
        const float gx = bf2f(Z[(size_t)(MP + s) * DIN + ZC_GX + h * 256 + tid]);
        OALL[(size_t)(MP + s) * DMIX + 2048 + h * 256 + tid] = (bf16_t)f2bf(o * gx); }
}

__device__ __forceinline__ void p5_rows(const Params& P, int m0, int mstep, int mend, int lane) {
    const bf16_t* OUTB = (const bf16_t*)(P.ws + WS_OUTB);
    for (int m = m0; m < mend; m += mstep) {
        const u32x4* orow = (const u32x4*)(OUTB + (size_t)m * DM) + lane;
        const f32x4* xrow = (const f32x4*)(m < MP ? P.x_prompt + (size_t)m * DM : P.x_sample + (size_t)(m - MP) * DM) + 2 * lane;
        const f32x4* gr = (const f32x4*)P.g_post + 2 * lane;
        u32x4 v[4]; f32x4 xa[4], xb[4]; float s = 0.f;
#pragma unroll
        for (int j = 0; j < 4; ++j) { v[j] = orow[64 * j]; xa[j] = xrow[128 * j]; xb[j] = xrow[128 * j + 1]; }
#pragma unroll
        for (int j = 0; j < 4; ++j) { const float a0 = bf_lo(v[j].x), a1 = bf_hi(v[j].x), a2 = bf_lo(v[j].y), a3 = bf_hi(v[j].y), a4 = bf_lo(v[j].z), a5 = bf_hi(v[j].z), a6 = bf_lo(v[j].w), a7 = bf_hi(v[j].w);
            s += ((a0 * a0 + a1 * a1) + (a2 * a2 + a3 * a3)) + ((a4 * a4 + a5 * a5) + (a6 * a6 + a7 * a7)); }
        const float rs = 1.0f / sqrtf(wave_sum(s) * (1.0f / DM) + EPS);
        f32x4* yrow = (f32x4*)(P.out + OFF_Y + (size_t)m * DM) + 2 * lane;
#pragma unroll
        for (int j = 0; j < 4; ++j) { const f32x4 g0 = gr[128 * j], g1 = gr[128 * j + 1];
            const f32x4 o0 = (f32x4){bf_lo(v[j].x), bf_hi(v[j].x), bf_lo(v[j].y), bf_hi(v[j].y)}, o1 = (f32x4){bf_lo(v[j].z), bf_hi(v[j].z), bf_lo(v[j].w), bf_hi(v[j].w)};
            yrow[128 * j] = xa[j] + o0 * rs * g0; yrow[128 * j + 1] = xb[j] + o1 * rs * g1; }
    }
}

__global__ void __launch_bounds__(512, 2) fwd_kernel(Params P) {
    extern __shared__ __attribute__((aligned(16))) unsigned char lds_raw[];
    LAS unsigned char* lds = (LAS unsigned char*)lds_raw;
    cg::grid_group grid = cg::this_grid();
    const int tid = threadIdx.x, lane = tid & 63, wave = __builtin_amdgcn_readfirstlane(tid >> 6);
    const int G = gridDim.x;
    const int lo = P.ph_lo, hi = P.ph_hi;
    volatile LAS unsigned* MISC = (volatile LAS unsigned*)(lds + LDS_MISC_OFF);
    if (tid < 16) MISC[tid] = 0u;
    __syncthreads();
    const XcdBarrier xbar = xcd_barrier_post((unsigned*)(P.ws + WS_CTL), MISC);
#define GSYNC(k) do { if (USE_CG_SEAM(k)) grid.sync(); else xcd_barrier(xbar); } while (0)
#define IN(k) (lo <= (k) && (k) < hi)
#define BOTH(k) (IN(k) && IN((k) + 1))
    if (IN(0)) { if (PROBE_REPEAT == 0) { p0_prologue(P, lds, G, wave, lane); GSYNC(9); } p0_prologue(P, lds, G, wave, lane); if (BOTH(0)) GSYNC(0); }
    if (IN(1)) {
        SchedP1 S; S.mode = 0; S.G = G; S.c = blockIdx.x; S.to.init(32, 48); S.U = (const char*)(P.ws + WS_U); S.WinT = (const char*)(P.ws + WS_WINT); S.MEMN = (const char*)(P.ws + WS_MEMN); S.WkvT = (const char*)(P.ws + WS_WKVT);
        EpiP1T<false> E; E.Z = (bf16_t*)(P.ws + WS_Z); E.out = P.out; E.KB = (bf16_t*)(P.ws + WS_KB); E.VT = (bf16_t*)(P.ws + WS_VT); E.slabs = (float*)(P.ws + WS_OALL); E.cnt = (unsigned*)(P.ws + WS_CTL) + CW_CNT + 64 * CNT_P1S; E.misc = MISC; E.done = (unsigned*)(P.ws + WS_CTL) + CW_DONE;
        if (PROBE_REPEAT == 1) { pg8::gemm_phase<EpiP1T<false>, SchedP1>(lds, 2048, 2048, S, E); GSYNC(9); }
        pg8::gemm_phase<EpiP1T<false>, SchedP1>(lds, 2048, 2048, S, E);
        if (BOTH(1)) GSYNC(9);
    }
    if (IN(2)) {
        constexpr int U_RGP = 256, U_RGS = 32, U_ATT = 256, U_PP = 256, U_PS = 32, U_SA = 512;
        constexpr int NU = U_RGP + U_RGS + U_ATT + U_PP + U_PS + U_SA;
        unsigned* done = (unsigned*)(P.ws + WS_CTL) + CW_DONE;
        { SchedP1 S; S.mode = 1; S.G = G; S.c = blockIdx.x; S.to.init(32, 48); S.U = (const char*)(P.ws + WS_U); S.WinT = (const char*)(P.ws + WS_WINT); S.MEMN = (const char*)(P.ws + WS_MEMN); S.WkvT = (const char*)(P.ws + WS_WKVT);
          EpiP1T<true> E; E.Z = (bf16_t*)(P.ws + WS_Z); E.out = P.out; E.KB = (bf16_t*)(P.ws + WS_KB); E.VT = (bf16_t*)(P.ws + WS_VT); E.slabs = (float*)(P.ws + WS_PART); E.cnt = (unsigned*)(P.ws + WS_CTL) + CW_CNT + 64 * CNT_P1S; E.misc = MISC; E.done = done;
          pg8::gemm_phase<EpiP1T<true>, SchedP1>(lds, 2048, 2048, S, E); }
        if (G == 256) {
            const int c = blockIdx.x;
            deferred_prep(P, lds, G, wave, lane);
            pool_unit<false>(P, lds, c >> 6, (c >> 4) & 3, c & 15);
            rglru_unit<false>(P, lds, c >> 6, (c >> 3) & 7, c & 7);
            wait_done(done);
            attn_unit(P, lds, c >> 6, (c >> 4) & 3, c & 15);
            {
              const int s0 = c < 80 ? c : (c < 160 ? 80 + 3 * (c - 80) : 320 + 2 * (c - 160)), ns = c < 80 ? 1 : (c < 160 ? 3 : 2);
              for (int k = 0; k < ns; ++k) sattn_unit(P, lds, (s0 + k) >> 2, (s0 + k) & 3); }
            if (c >= 224) rglru_unit<true>(P, lds, 0, (c - 224) >> 2, (c - 224) & 3);
            else if (c >= 192) pool_unit<true>(P, lds, 0, (c - 192) >> 3, (c - 192) & 7);
        } else {
        deferred_prep(P, lds, G, wave, lane);
        wait_done(done);
        for (int u = blockIdx.x; u < NU; u += G) {
            int r = u;
            if (r < U_RGP) { rglru_unit<false>(P, lds, r >> 6, (r >> 3) & 7, r & 7); continue; } r -= U_RGP;
            if (r < U_RGS) { rglru_unit<true>(P, lds, 0, r >> 2, r & 3); continue; } r -= U_RGS;
            if (r < U_ATT) { attn_unit(P, lds, r >> 6, (r >> 4) & 3, r & 15); continue; } r -= U_ATT;
            if (r < U_PP) { pool_unit<false>(P, lds, r >> 6, (r >> 4) & 3, r & 15); continue; } r -= U_PP;
            if (r < U_PS) { pool_unit<true>(P, lds, 0, r >> 3, r & 7); continue; } r -= U_PS;
            sattn_unit(P, lds, r >> 2, r & 3);
        }
        }
        __syncthreads();
        if (BOTH(2)) GSYNC(9);
    }
    if (IN(3)) {
        SchedP3 S; S.G = G; S.c = blockIdx.x; S.to.init(32, 8); S.OALL = (const char*)(P.ws + WS_OALL); S.WbT = (const char*)(P.ws + WS_WBT);
        EpiP3 E; E.Z = (const bf16_t*)(P.ws + WS_Z); E.PART = (bf16_t*)(P.ws + WS_PART); E.MERGED = (bf16_t*)(P.ws + WS_MERGED); E.slabs = (float*)(P.ws + WS_U); E.cnt = (unsigned*)(P.ws + WS_CTL) + CW_CNT + 64 * CNT_P3S; E.misc = MISC; E.done3 = (unsigned*)(P.ws + WS_CTL) + CW_DONE + 128;
        pg8::gemm_phase<EpiP3, SchedP3>(lds, DMIX, DMIX, S, E);
        if (BOTH(3) && !IN(4)) GSYNC(9);
    }
    if (IN(4)) {
        SchedP4 S; S.G = G; S.c = blockIdx.x; S.to.init(32, 8); S.MERGED = (const char*)(P.ws + WS_MERGED); S.WoT = (const char*)(P.ws + WS_WOT); S.done3 = (unsigned*)(P.ws + WS_CTL) + CW_DONE + 128;
        { pg8::Unit u0; if (S.next(0, u0)) { if (tid == 0) poll_count(S.done3 + 64 * u0.pm, u0.kind == 0 ? 8u : 48u); } __syncthreads(); }
        EpiP4 E; E.OUTF = (bf16_t*)(P.ws + WS_OUTB); E.slabs = (float*)(P.ws + WS_U + 16 * MiB); E.cnt = (unsigned*)(P.ws + WS_CTL) + CW_CNT + 64 * CNT_P4S; E.misc = MISC; E.done4 = (unsigned*)(P.ws + WS_CTL) + CW_DONE4;
        pg8::gemm_phase<EpiP4, SchedP4>(lds, DM, DM, S, E);
        if (BOTH(4) && G != 256) GSYNC(9);
    }
    if (IN(5)) {
        if (G == 256 && IN(4)) {
            unsigned* done4 = (unsigned*)(P.ws + WS_CTL) + CW_DONE4;
            pg8::TileOrder to; to.init(32, 8); int pm, pn; to.map(blockIdx.x, pm, pn);
            if (tid == 0) poll_count(done4 + 64 * pm, 8u);
            __syncthreads();
            p5_rows(P, pm * 256 + pn * 32 + wave, 8, pm * 256 + pn * 32 + 32, lane);
            if (pm >= 12 && pm < 14) {
                const int sr = ((pm - 12) * 8 + pn) * 8;
                if (tid == 0) poll_count(done4 + 64 * 32, 32u);
                __syncthreads();
                p5_rows(P, MP + sr + wave, 8, MP + sr + 8, lane);
            }
        } else p5_rows(P, blockIdx.x * 8 + wave, G * 8, MTOT, lane);
    }
#undef IN
#undef BOTH
}

extern "C" void kernel_launch(void* const* d_in, const int* in_sizes, int n_in, void* d_out, int out_size, void* d_ws, size_t ws_size, hipStream_t stream) {
    static int grid = 0;
    if (grid == 0) {
        if (n_in != 24 || (size_t)out_size != OUT_TOTAL || ws_size < WS_END) { fprintf(stderr, "kernel_launch: unexpected problem (n_in %d, out %d, ws %zu); nothing launched\n", n_in, out_size, ws_size); grid = -1; return; }
        int dev = 0, cus = 0, per_cu = 0;
        if (hipGetDevice(&dev) != hipSuccess || hipDeviceGetAttribute(&cus, hipDeviceAttributeMultiprocessorCount, dev) != hipSuccess) { grid = -1; return; }
        if (hipFuncSetAttribute((const void*)fwd_kernel, hipFuncAttributeMaxDynamicSharedMemorySize, LDS_BYTES) != hipSuccess) { fprintf(stderr, "kernel_launch: hipFuncSetAttribute failed\n"); grid = -1; return; }
        if (hipOccupancyMaxActiveBlocksPerMultiprocessor(&per_cu, (const void*)fwd_kernel, 512, LDS_BYTES) != hipSuccess || per_cu < 1) { fprintf(stderr, "kernel_launch: occupancy query failed (%d)\n", per_cu); (void)hipGetLastError(); grid = -1; return; }
        grid = cus * per_cu;
    }
    if (grid < 0) return;
    Params p{};
    p.x_prompt = (const float*)d_in[0]; p.x_sample = (const float*)d_in[1]; p.mem = (const float*)d_in[2]; p.st_h = (const float*)d_in[3]; p.st_conv = (const float*)d_in[4]; p.st_pool = (const float*)d_in[5];
    p.cache_k = (const float*)d_in[6]; p.cache_v = (const float*)d_in[7]; p.g_pre = (const float*)d_in[8]; p.w_in = (const float*)d_in[9]; p.conv_w = (const float*)d_in[10]; p.conv_b = (const float*)d_in[11];
    p.w_rg_a = (const float*)d_in[12]; p.b_rg_a = (const float*)d_in[13]; p.w_rg_x = (const float*)d_in[14]; p.b_rg_x = (const float*)d_in[15]; p.lam = (const float*)d_in[16]; p.w_pool = (const float*)d_in[17];
    p.pool_scale = (const float*)d_in[18]; p.g_mem = (const float*)d_in[19]; p.w_kv = (const float*)d_in[20]; p.w_branch = (const float*)d_in[21]; p.w_out = (const float*)d_in[22]; p.g_post = (const float*)d_in[23];
    p.out = (float*)d_out; p.ws = (unsigned char*)d_ws;
    if (hipMemsetAsync((char*)d_ws + WS_CTL, 0, CTL_ZERO_BYTES, stream) != hipSuccess) { fprintf(stderr, "kernel_launch: memset failed\n"); return; }
#if MK_N_LAUNCHES == 1
    p.ph_lo = 0; p.ph_hi = 6;
    void* args[] = {&p};
    hipError_t e = hipLaunchCooperativeKernel((const void*)fwd_kernel, dim3(grid), dim3(512), args, LDS_BYTES, stream);
    if (e != hipSuccess) fprintf(stderr, "kernel_launch: cooperative launch failed: %s (grid %d)\n", hipGetErrorString(e), grid);
#else
    for (int ph = 0; ph < 6; ++ph) { p.ph_lo = ph; p.ph_hi = ph + 1; hipLaunchKernelGGL(fwd_kernel, dim3(grid), dim3(512), LDS_BYTES, stream, p); }
#endif
}
```

```cpp
#include <hip/hip_runtime.h>
#include <hip/hip_cooperative_groups.h>
#include <cstdio>
#include <cstdint>
namespace cg = cooperative_groups;

#define LAS __attribute__((address_space(3)))
typedef unsigned short bf16_t;
typedef short bf16x8 __attribute__((ext_vector_type(8)));
typedef short bf16x4 __attribute__((ext_vector_type(4)));
typedef float f32x4 __attribute__((ext_vector_type(4)));
typedef float f32x2 __attribute__((ext_vector_type(2)));
typedef unsigned u32x4 __attribute__((ext_vector_type(4)));
typedef unsigned u32x2 __attribute__((ext_vector_type(2)));

#ifndef MK_N_LAUNCHES
#define MK_N_LAUNCHES 1
#endif
#ifndef CG_SEAM_MASK
#define CG_SEAM_MASK 0
#endif
#define USE_CG_SEAM(k) (((CG_SEAM_MASK) >> (k)) & 1)
#ifndef PROBE_REPEAT
#define PROBE_REPEAT -1
#endif

constexpr int DM = 2048, NBATCH = 4, SEQ = 2048, NS = 128;
constexpr int MP = NBATCH * SEQ;
constexpr int MTOT = MP + NS;
constexpr int MPAD = 8448;
constexpr int DIN = 12288, DMIX = 3072, NMEM = 256;
constexpr int ZC_XR = 0, ZC_GR = 1024, ZC_XP = 2048, ZC_GP = 3072, ZC_Q = 4096, ZC_GX = 5120, ZC_GT = 6144;
constexpr float EPS = 1e-6f;
constexpr float LOG2E = 1.4426950408889634f;

constexpr size_t OFF_Y = 0;
constexpr size_t OFF_NHP = 17039360, OFF_NCP = 17043456, OFF_NPP = 17055744, OFF_MEMK = 17117184, OFF_MEMV = 18165760;
constexpr size_t OFF_NHS = 19214336, OFF_NCS = 19345408, OFF_NPS = 19738624, OUT_TOTAL = 21704704;

constexpr size_t MiB = 1u << 20;
constexpr size_t WS_CTL = 0, WS_WINT = 1 * MiB, WS_WKVT = 49 * MiB, WS_WBT = 57 * MiB, WS_WOT = 69 * MiB, WS_WRGT = 77 * MiB, WS_WPT = 77 * MiB + 512 * 1024;
constexpr size_t WS_U = 78 * MiB, WS_MEMN = 111 * MiB, WS_KB = 115 * MiB, WS_VT = 117 * MiB, WS_Z = 119 * MiB, WS_OALL = 317 * MiB, WS_PART = 367 * MiB;
constexpr size_t WS_MERGED = 433 * MiB, WS_OUTB = 466 * MiB, WS_END = 500 * MiB;
constexpr size_t WS_GR = WS_CTL + 256 * 1024;
constexpr size_t CTL_ZERO_BYTES = 65536;
constexpr int LDS_BYTES = 147456;
constexpr int LDS_MISC_OFF = 147200;

struct Params {
    const float* x_prompt; const float* x_sample; const float* mem; const float* st_h; const float* st_conv; const float* st_pool;
    const float* cache_k; const float* cache_v; const float* g_pre; const float* w_in; const float* conv_w; const float* conv_b;
    const float* w_rg_a; const float* b_rg_a; const float* w_rg_x; const float* b_rg_x; const float* lam; const float* w_pool;
    const float* pool_scale; const float* g_mem; const float* w_kv; const float* w_branch; const float* w_out; const float* g_post;
    float* out; unsigned char* ws; int ph_lo, ph_hi;
};

__device__ __forceinline__ unsigned f2bf(float f) { unsigned u = __builtin_bit_cast(unsigned, f); return (u + 0x7fffu + ((u >> 16) & 1u)) >> 16; }
__device__ __forceinline__ unsigned pk2(float lo, float hi) { unsigned r; asm volatile("v_cvt_pk_bf16_f32 %0, %1, %2" : "=v"(r) : "v"(lo), "v"(hi)); return r; }
__device__ __forceinline__ float bf_lo(unsigned u) { return __builtin_bit_cast(float, u << 16); }
__device__ __forceinline__ float bf_hi(unsigned u) { return __builtin_bit_cast(float, u & 0xffff0000u); }
__device__ __forceinline__ float bf2f(bf16_t b) { return __builtin_bit_cast(float, ((unsigned)b) << 16); }
__device__ __forceinline__ unsigned cvt_pk_bf16(float lo, float hi) { unsigned r; asm volatile("v_cvt_pk_bf16_f32 %0, %1, %2" : "=v"(r) : "v"(lo), "v"(hi)); return r; }
__device__ __forceinline__ float wave_sum(float v) {
#pragma unroll
    for (int o = 1; o < 64; o <<= 1) v += __shfl_xor(v, o);
    return v;
}
__device__ __forceinline__ float wave_max(float v) {
#pragma unroll
    for (int o = 1; o < 64; o <<= 1) v = fmaxf(v, __shfl_xor(v, o));
    return v;
}
__device__ __forceinline__ float sigmoid_f(float x) { return __builtin_amdgcn_rcpf(1.0f + __builtin_amdgcn_exp2f(-x * LOG2E)); }
__device__ __forceinline__ float silu_f(float x) { return x * sigmoid_f(x); }


#define XB_TMO      128
#define XB_XCNT(j)  (256  + 64 * (j))
#define XB_XSUB(j)  (1280 + 64 * (j))
#define XB_XGEN(j)  (2304 + 64 * (j))
#define XB_TOP      3328
#define XB_TOPGEN   3392
#define XCD_BAR_WORDS 3456
#define XB_SPIN_CAP (1u << 18)
__device__ __forceinline__ unsigned xb_ld(unsigned* p)              { return __hip_atomic_load(p, __ATOMIC_RELAXED, __HIP_MEMORY_SCOPE_AGENT); }
__device__ __forceinline__ unsigned xb_add(unsigned* p, unsigned v) { return __hip_atomic_fetch_add(p, v, __ATOMIC_RELAXED, __HIP_MEMORY_SCOPE_AGENT); }
__device__ __forceinline__ unsigned xb_xcc_id() { return (unsigned)__builtin_amdgcn_s_getreg((3 << 11) | 20) & 0xFu; }
#define XB_SPIN(cond, bar) do { unsigned _sp = 0; while (cond) { __builtin_amdgcn_s_sleep(1); \
    if ((++_sp & 255u) == 0u) { if (xb_ld(&(bar)[XB_TMO])) break; if (_sp > XB_SPIN_CAP) { atomicAdd(&(bar)[XB_TMO], 1u); break; } } } } while (0)
struct XcdBarrier { unsigned* bar; unsigned x; volatile LAS unsigned* st; };
__device__ __forceinline__ XcdBarrier xcd_barrier_post(unsigned* bar, volatile LAS unsigned* st) {
    XcdBarrier b; b.bar = bar; b.x = xb_xcc_id(); b.st = st;
    if (threadIdx.x == 0) (void)xb_add(&bar[XB_XCNT(b.x)], 1u);
    return b;
}
__device__ __forceinline__ void xcd_barrier_complete(unsigned* bar, unsigned x, unsigned& nloc, unsigned& nx) {
    const unsigned G = gridDim.x * gridDim.y * gridDim.z;
    unsigned sum, cnt, mine, sp = 0u;
    for (;;) {
        sum = 0u; cnt = 0u; mine = 0u;
#pragma unroll
        for (unsigned j = 0; j < 16; ++j) { const unsigned c = xb_ld(&bar[XB_XCNT(j)]); sum += c; cnt += (c > 0u) ? 1u : 0u; mine = (j == x) ? c : mine; }
        if (sum == G) break;
        __builtin_amdgcn_s_sleep(1);
        if ((++sp & 255u) == 0u) { if (xb_ld(&bar[XB_TMO])) break; if (sp > XB_SPIN_CAP) { atomicAdd(&bar[XB_TMO], 1u); break; } }
    }
    nloc = mine > 0u ? mine : 1u; nx = cnt > 0u ? cnt : 1u;
}
__device__ __forceinline__ void xcd_barrier(const XcdBarrier& b) {
    asm volatile("s_waitcnt vmcnt(0)" ::: "memory");
    __syncthreads();
    if (threadIdx.x == 0) {
        unsigned* bar = b.bar;
        __builtin_amdgcn_s_waitcnt(0);
        unsigned nloc = b.st[0], nx = b.st[1];
        if (nloc == 0u) { xcd_barrier_complete(bar, b.x, nloc, nx); b.st[0] = nloc; b.st[1] = nx; }
        const unsigned old = xb_add(&bar[XB_XSUB(b.x)], 1u);
        const unsigned gen = old / nloc;
        if (old + 1u == (gen + 1u) * nloc) {
            __builtin_amdgcn_fence(__ATOMIC_RELEASE, "agent");
            asm volatile("s_waitcnt vmcnt(0)" ::: "memory");
            const unsigned og = xb_add(&bar[XB_TOP], 1u);
            const unsigned tg = og / nx;
            if (og + 1u == (tg + 1u) * nx) xb_add(&bar[XB_TOPGEN], 1u);
            else XB_SPIN(xb_ld(&bar[XB_TOPGEN]) == tg, bar);
            __builtin_amdgcn_fence(__ATOMIC_ACQUIRE, "agent");
            xb_add(&bar[XB_XGEN(b.x)], 1u);
            asm volatile("s_waitcnt vmcnt(0)" ::: "memory");
        } else {
            XB_SPIN(xb_ld(&bar[XB_XGEN(b.x)]) == gen, bar);
            __builtin_amdgcn_fence(__ATOMIC_ACQUIRE, "agent");
            asm volatile("s_waitcnt vmcnt(0)" ::: "memory");
        }
    }
    __syncthreads();
}

namespace pg8 {
constexpr int BM = 256, BK = 64, HALF = 128, HTB = HALF * BK * 2, STAGE_BYTES = 8 * HTB, NXCD = 8, WGM = 4;
__device__ __forceinline__ int lds_byte(int r, int c) { const int st = (r >> 4) * 2 + (c >> 5), rr = r & 15, cc = c & 31, ob = rr * 64 + cc * 2; return st * 1024 + (ob ^ (((ob >> 9) & 1) << 5)); }
__device__ __forceinline__ void stage_rc(int b, int& R, int& C) { const int st = b / 1024, sb = b % 1024, swz = sb ^ (((sb >> 9) & 1) << 5); R = (st >> 1) * 16 + swz / 64; C = (st & 1) * 32 + (swz % 64) / 2; }
__device__ __forceinline__ int perm32(int rho) { const int n = rho >> 4, i = rho & 15; return 8 * (i >> 2) + 4 * n + (i & 3); }

struct Unit { const char* A; const char* B; int pm, pn, kind, aux, nt, half, ks, grp; };
struct TileOrder {
    int nM, nN, nwg;
    __device__ __forceinline__ void init(int nM_, int nN_) { nM = nM_; nN = nN_; nwg = nM_ * nN_; }
    __device__ __forceinline__ void map(int L, int& pm, int& pn) const {
        int wgid = L; { const int q = nwg / NXCD, r = nwg % NXCD, xcd = wgid % NXCD, off = wgid / NXCD; wgid = (xcd < r ? xcd * (q + 1) : r * (q + 1) + (xcd - r) * q) + off; }
        const int nig = WGM * nN, gid = wgid / nig, fm = gid * WGM, gsz = (nM - fm) < WGM ? (nM - fm) : WGM;
        pm = fm + ((wgid % nig) % gsz); pn = (wgid % nig) / gsz;
    }
};

template <class Epi, class Sched>
__device__ __forceinline__ void gemm_phase(LAS unsigned char* lds, const int lda, const int ldb, const Sched& S, const Epi& E) {
    const int tid = threadIdx.x, wid = __builtin_amdgcn_readfirstlane(tid >> 6), lane = tid & 63, wr = wid >> 2, wc = wid & 3, fr = lane & 15, fq = lane >> 4;
    unsigned voffA[2], voffB[2];
#pragma unroll
    for (int i = 0; i < 2; ++i) { int R, C; stage_rc(tid * 16 + i * 8192, R, C); const int Rb = (R & ~31) + perm32(R & 31);
        voffA[i] = (unsigned)(R * lda + C) * 2u; voffB[i] = (unsigned)(Rb * ldb + C) * 2u; }
    const size_t kstep = (size_t)(BK * 2);
    const size_t hstepA = (size_t)HALF * lda * 2, hstepB = (size_t)HALF * ldb * 2;
    const unsigned ldsw = (unsigned)wid * 1024u;
    const int aoff = lds_byte(wr * 64 + fr, fq * 8), boff = lds_byte(wc * 32 + fr, fq * 8);
#define PG8_SA(b, h) (((b) * 2 + (h)) * HTB)
#define PG8_SB(b, h) ((4 + (b) * 2 + (h)) * HTB)
#define PG8_STAGE(bufoff, gbase, voff) do { _Pragma("unroll") for (int _i = 0; _i < 2; ++_i) \
        __builtin_amdgcn_global_load_lds((const unsigned*)((const char*)(gbase) + (voff)[_i]), (LAS unsigned*)(lds + (bufoff) + ldsw + _i * 8192), 16, 0, 0); } while (0)
#define PG8_LDA(dst, b, h) do { _Pragma("unroll") for (int m = 0; m < 4; ++m) _Pragma("unroll") for (int k = 0; k < 2; ++k) dst[m][k] = *(const LAS bf16x8*)(lds + PG8_SA(b, h) + aoff + m * 2048 + k * 1024); } while (0)
#define PG8_LDB(dst, b, h) do { _Pragma("unroll") for (int n = 0; n < 2; ++n) _Pragma("unroll") for (int k = 0; k < 2; ++k) dst[n][k] = *(const LAS bf16x8*)(lds + PG8_SB(b, h) + boff + n * 2048 + k * 1024); } while (0)
#define PG8_MMA(ai, bj, At, Bt) do { __builtin_amdgcn_s_setprio(1); _Pragma("unroll") for (int m = 0; m < 4; ++m) _Pragma("unroll") for (int n = 0; n < 2; ++n) _Pragma("unroll") for (int k = 0; k < 2; ++k) \
        acc[ai][bj][m][n] = __builtin_amdgcn_mfma_f32_16x16x32_bf16(Bt[n][k], At[m][k], acc[ai][bj][m][n], 0, 0, 0); __builtin_amdgcn_s_setprio(0); } while (0)
#define PG8_WAIT_V(n) asm volatile("s_waitcnt vmcnt(" #n ")" ::: "memory")
#define PG8_WAIT_L(n) asm volatile("s_waitcnt lgkmcnt(" #n ")" ::: "memory")
#define PG8_BAR __builtin_amdgcn_s_barrier()
#define PG8_SCHED __builtin_amdgcn_sched_barrier(0)
    Unit cur, nxt; int ui = 0;
    if (!S.next(0, cur)) return;
    f32x4 acc[2][2][4][2];
#pragma unroll
    for (int a = 0; a < 2; ++a)
#pragma unroll
        for (int b = 0; b < 2; ++b)
#pragma unroll
            for (int m = 0; m < 4; ++m)
#pragma unroll
                for (int n = 0; n < 2; ++n) acc[a][b][m][n] = (f32x4){0.f, 0.f, 0.f, 0.f};
    bf16x8 At[4][2], B0[2][2], B1[2][2];
    const char* cA = cur.A; const char* cB = cur.B;
    PG8_STAGE(PG8_SB(0, 0), cB, voffB); PG8_STAGE(PG8_SB(0, 1), cB + hstepB, voffB); PG8_STAGE(PG8_SA(0, 0), cA, voffA); PG8_STAGE(PG8_SA(0, 1), cA + hstepA, voffA);
    if (wr == 1) PG8_BAR;
    PG8_WAIT_V(2); PG8_BAR;
    PG8_STAGE(PG8_SB(1, 0), cB + kstep, voffB); PG8_STAGE(PG8_SA(1, 0), cA + kstep, voffA); PG8_STAGE(PG8_SB(1, 1), cB + hstepB + kstep, voffB);
    PG8_WAIT_V(6); PG8_BAR;
    for (;;) {
        const bool has_next = S.next(ui + 1, nxt);
        const char* nA = has_next ? nxt.A : cA; const char* nB = has_next ? nxt.B : cB;
        const int nt = cur.nt; const bool full = (cur.half == 0);
        for (int t = 0; t < nt; t += 2) {
            const bool last = (t == nt - 2);
            if (last && has_next) S.a_ready(nxt);
            const char* a1 = cA + (size_t)(t + 1) * kstep;
            const char* a2 = last ? nA : cA + (size_t)(t + 2) * kstep; const char* b2 = last ? nB : cB + (size_t)(t + 2) * kstep;
            const char* a3 = a2 + kstep; const char* b3 = b2 + kstep;
            PG8_LDB(B0, 0, 0); PG8_LDB(B1, 0, 1); PG8_SCHED; PG8_LDA(At, 0, 0); PG8_STAGE(PG8_SA(1, 1), a1 + hstepA, voffA);
            PG8_WAIT_V(8); PG8_WAIT_L(0); PG8_BAR; PG8_MMA(0, 0, At, B0); PG8_MMA(0, 1, At, B1); PG8_BAR; PG8_SCHED;
            PG8_LDA(At, 0, 1); PG8_STAGE(PG8_SB(0, 0), b2, voffB); PG8_STAGE(PG8_SB(0, 1), b2 + hstepB, voffB); PG8_STAGE(PG8_SA(0, 0), a2, voffA);
            PG8_WAIT_V(8); PG8_WAIT_L(0); PG8_BAR; if (full) { PG8_MMA(1, 0, At, B0); PG8_MMA(1, 1, At, B1); } PG8_BAR; PG8_SCHED;
            PG8_LDB(B0, 1, 0); PG8_LDB(B1, 1, 1); PG8_SCHED; PG8_LDA(At, 1, 0); PG8_STAGE(PG8_SA(0, 1), a2 + hstepA, voffA);
            PG8_WAIT_V(8); PG8_WAIT_L(0); PG8_BAR; PG8_MMA(0, 0, At, B0); PG8_MMA(0, 1, At, B1); PG8_BAR; PG8_SCHED;
            PG8_LDA(At, 1, 1); PG8_STAGE(PG8_SB(1, 0), b3, voffB); PG8_STAGE(PG8_SB(1, 1), b3 + hstepB, voffB); PG8_STAGE(PG8_SA(1, 0), a3, voffA);
            PG8_WAIT_V(8); PG8_WAIT_L(0); PG8_BAR; if (full) { PG8_MMA(1, 0, At, B0); PG8_MMA(1, 1, At, B1); } PG8_BAR; PG8_SCHED;
        }
        if (wr == 0) PG8_BAR;
        E(acc, cur, wr, wc, fr, fq);
        if (!has_next) break;
#pragma unroll
        for (int a = 0; a < 2; ++a)
#pragma unroll
            for (int b = 0; b < 2; ++b)
#pragma unroll
                for (int m = 0; m < 4; ++m)
#pragma unroll
                    for (int n = 0; n < 2; ++n) acc[a][b][m][n] = (f32x4){0.f, 0.f, 0.f, 0.f};
        cur = nxt; cA = nA; cB = nB; ++ui;
        if (wr == 1) PG8_BAR;
    }
    PG8_WAIT_V(0);
    PG8_BAR;
#undef PG8_SA
#undef PG8_SB
#undef PG8_STAGE
#undef PG8_LDA
#undef PG8_LDB
#undef PG8_MMA
#undef PG8_WAIT_V
#undef PG8_WAIT_L
#undef PG8_BAR
#undef PG8_SCHED
}
}

constexpr int SLAB_FLOATS = 32 * 512 * 4;
constexpr int CW_CNT = 4096;
constexpr int CNT_P1S = 0, CNT_P1KV = 48, CNT_P3S = 80, CNT_P4S = 88;
constexpr int CW_DONE4 = 10240;
constexpr int CW_DONE = 13312;
template <int NSL, bool HALF, int KS>
__device__ __forceinline__ unsigned share_body(f32x4 (&acc)[2][2][4][2], const float* slabs, int tid) {
    unsigned mask = 0;
    const f32x4* p0 = (const f32x4*)slabs + tid;
#pragma unroll
    for (int c = 0; c < (HALF ? 8 : 16); ++c) { if (c % NSL != KS) continue;
        const int ai = c >> 3, bj = (c >> 2) & 1, m = c & 3; mask |= 1u << c;
#pragma unroll
        for (int s = 0; s < NSL; ++s) { if (s == KS) continue;
            acc[ai][bj][m][0] += p0[(size_t)s * (SLAB_FLOATS / 4) + (size_t)(c * 2 + 0) * 512]; acc[ai][bj][m][1] += p0[(size_t)s * (SLAB_FLOATS / 4) + (size_t)(c * 2 + 1) * 512]; }
        asm volatile("" ::: "memory"); }
    return mask;
}
template <int NSL, bool HALF>
__device__ __forceinline__ unsigned splitk_share(f32x4 (&acc)[2][2][4][2], float* slabs, int ks, unsigned* cnt, volatile LAS unsigned* misc) {
    int tid_ = threadIdx.x; asm volatile("" : "+v"(tid_));
    const int tid = tid_;
    {
      const unsigned long long pa = (unsigned long long)(slabs + (size_t)ks * SLAB_FLOATS);
      const unsigned plo = __builtin_amdgcn_readfirstlane((unsigned)pa), phi = __builtin_amdgcn_readfirstlane((unsigned)(pa >> 32));
      const __amdgpu_buffer_rsrc_t rs = __builtin_amdgcn_make_buffer_rsrc((void*)(((unsigned long long)phi << 32) | plo), (short)0, SLAB_FLOATS * 4, 0x00020000);
#pragma unroll
      for (int ai = 0; ai < (HALF ? 1 : 2); ++ai)
#pragma unroll
          for (int bj = 0; bj < 2; ++bj)
#pragma unroll
              for (int m = 0; m < 4; ++m)
#pragma unroll
                  for (int n = 0; n < 2; ++n) __builtin_amdgcn_raw_buffer_store_b128(__builtin_bit_cast(u32x4, acc[ai][bj][m][n]), rs, (unsigned)tid * 16u, ((((ai * 2 + bj) * 4 + m) * 2 + n) * 512) * 16, 16); }
    asm volatile("s_waitcnt vmcnt(0)" ::: "memory");
    __syncthreads();
    if (tid == 0) {
        (void)__hip_atomic_fetch_add(cnt, 1u, __ATOMIC_RELAXED, __HIP_MEMORY_SCOPE_AGENT);
        unsigned spins = 0;
        if (ks < (HALF ? 8 : 16))
        while (__hip_atomic_load(cnt, __ATOMIC_RELAXED, __HIP_MEMORY_SCOPE_AGENT) < (unsigned)NSL) { __builtin_amdgcn_s_sleep(2); if (++spins > (1u << 21)) break; }
        __builtin_amdgcn_fence(__ATOMIC_ACQUIRE, "agent"); asm volatile("s_waitcnt vmcnt(0)" ::: "memory");
    }
    __syncthreads();
    unsigned mask = 0;
    if (NSL >= 1 && ks == 0) mask = share_body<NSL, HALF, 0>(acc, slabs, tid);
    if (NSL >= 2 && ks == 1) mask = share_body<NSL, HALF, (NSL >= 2 ? 1 : 0)>(acc, slabs, tid);
    if (NSL >= 3 && ks == 2) mask = share_body<NSL, HALF, (NSL >= 3 ? 2 : 0)>(acc, slabs, tid);
    if (NSL >= 4 && ks == 3) mask = share_body<NSL, HALF, (NSL >= 4 ? 3 : 0)>(acc, slabs, tid);
    if (NSL >= 5 && ks == 4) mask = share_body<NSL, HALF, (NSL >= 5 ? 4 : 0)>(acc, slabs, tid);
    if (NSL >= 6 && ks == 5) mask = share_body<NSL, HALF, (NSL >= 6 ? 5 : 0)>(acc, slabs, tid);
    if (NSL >= 7 && ks == 6) mask = share_body<NSL, HALF, (NSL >= 7 ? 6 : 0)>(acc, slabs, tid);
    if (NSL >= 8 && ks == 7) mask = share_body<NSL, HALF, (NSL >= 8 ? 7 : 0)>(acc, slabs, tid);
    return mask;
}

__device__ __forceinline__ void publish_count(unsigned* ctr) {
    asm volatile("s_waitcnt vmcnt(0)" ::: "memory"); __syncthreads();
    if (threadIdx.x == 0) { __builtin_amdgcn_fence(__ATOMIC_RELEASE, "agent"); asm volatile("s_waitcnt vmcnt(0)" ::: "memory"); __hip_atomic_fetch_add(ctr, 1u, __ATOMIC_RELAXED, __HIP_MEMORY_SCOPE_AGENT); }
}
__device__ __forceinline__ void publish_count_wt(unsigned* ctr) {
    asm volatile("s_waitcnt vmcnt(0)" ::: "memory"); __syncthreads();
    if (threadIdx.x == 0) __hip_atomic_fetch_add(ctr, 1u, __ATOMIC_RELAXED, __HIP_MEMORY_SCOPE_AGENT);
}
__device__ __forceinline__ void poll_count(unsigned* ctr, unsigned need) {
    unsigned spins = 0;
    while (__hip_atomic_load(ctr, __ATOMIC_RELAXED, __HIP_MEMORY_SCOPE_AGENT) < need) { __builtin_amdgcn_s_sleep(4); if (++spins > (1u << 21)) break; }
    __builtin_amdgcn_fence(__ATOMIC_ACQUIRE, "agent"); asm volatile("s_waitcnt vmcnt(0)" ::: "memory");
}

struct SchedP1 {
    int mode; int G, c; pg8::TileOrder to; const char* U; const char* WinT; const char* MEMN; const char* WkvT;
    __device__ __forceinline__ void a_ready(const pg8::Unit&) const {}
    __device__ __forceinline__ bool next(int i, pg8::Unit& u) const {
        const int L = i * G + c;
        int e;
        if (mode == 1) e = L;
        else { if (L < 32 * 48) { int pm, pn; to.map(L, pm, pn); u.A = U + (size_t)pm * 256 * 2048 * 2; u.B = WinT + (size_t)pn * 256 * 2048 * 2; u.pm = pm; u.pn = pn; u.kind = 0; u.nt = 32; u.half = 0; u.ks = 0; u.grp = 0; return true; }
            if (mode == 0) return false;
            e = L - 32 * 48; }
        if (e >= 80) return false;
        u.nt = 32; u.ks = 0; u.grp = 0;
        if (e < 32) { const int pm = e & 3, pn = e >> 2;
            u.A = MEMN + (size_t)pm * 256 * 2048 * 2; u.B = WkvT + (size_t)pn * 256 * 2048 * 2; u.pm = pm; u.pn = pn; u.kind = 2; u.half = 0; }
        else { const int t = e - 32;
            u.A = U + (size_t)32 * 256 * 2048 * 2; u.B = WinT + (size_t)t * 256 * 2048 * 2; u.pm = 32; u.pn = t; u.kind = 1; u.half = 1; }
        return true;
    }
};
template <bool EXTRA>
struct EpiP1T {
    bf16_t* Z; float* out; bf16_t* KB; bf16_t* VT; float* slabs; unsigned* cnt; volatile LAS unsigned* misc; unsigned* done;
    __device__ __forceinline__ void publish(int which) const {
        asm volatile("s_waitcnt vmcnt(0)" ::: "memory"); __syncthreads();
        if (threadIdx.x == 0) { __builtin_amdgcn_fence(__ATOMIC_RELEASE, "agent"); asm volatile("s_waitcnt vmcnt(0)" ::: "memory"); __hip_atomic_fetch_add(done + 64 * which, 1u, __ATOMIC_RELAXED, __HIP_MEMORY_SCOPE_AGENT); }
    }
    __device__ __forceinline__ void operator()(f32x4 (&acc)[2][2][4][2], const pg8::Unit& u, int wr, int wc, int fr, int fq) const {
        const int row0 = u.pm * 256 + wr * 64 + fr, col0 = u.pn * 256 + wc * 32 + 8 * fq;
        unsigned cm = 0xffffu;

        if (!EXTRA || u.kind != 2) {
            const int seg = u.pn >> 2;
            const int act = (seg >= 6) ? 2 : ((seg & 1) ? 1 : 0);
#pragma unroll
            for (int ai = 0; ai < 2; ++ai) { if (ai == 1 && u.half) break;
#pragma unroll
                for (int m = 0; m < 4; ++m) { bf16_t* rowp = Z + (size_t)(row0 + ai * 128 + m * 16) * DIN + col0;
#pragma unroll
                    for (int bj = 0; bj < 2; ++bj) { if (EXTRA && !((cm >> ((ai * 2 + bj) * 4 + m)) & 1u)) continue;
                        f32x4 v0 = acc[ai][bj][m][0], v1 = acc[ai][bj][m][1];
                        if (act == 1) {
#pragma unroll
                            for (int j = 0; j < 4; ++j) { v0[j] = silu_f(v0[j]); v1[j] = silu_f(v1[j]); } }
                        else if (act == 2) {
#pragma unroll
                            for (int j = 0; j < 4; ++j) { v0[j] = sigmoid_f(v0[j]); v1[j] = sigmoid_f(v1[j]); } }
                        u32x4 w; w.x = cvt_pk_bf16(v0[0], v0[1]); w.y = cvt_pk_bf16(v0[2], v0[3]); w.z = cvt_pk_bf16(v1[0], v1[1]); w.w = cvt_pk_bf16(v1[2], v1[3]);
                        __builtin_nontemporal_store(w, (u32x4*)(rowp + bj * 128)); } } }
            if (EXTRA) publish(1);
        } else {
            const bool isV = u.pn >= 4;
            const int c0 = isV ? col0 - 1024 : col0;
            float* ob = out + (isV ? OFF_MEMV : OFF_MEMK);
#pragma unroll
            for (int ai = 0; ai < 2; ++ai)
#pragma unroll
                for (int m = 0; m < 4; ++m) { const int row = row0 + ai * 128 + m * 16;
#pragma unroll
                    for (int bj = 0; bj < 2; ++bj) { if (!((cm >> ((ai * 2 + bj) * 4 + m)) & 1u)) continue;
                        const f32x4 v0 = acc[ai][bj][m][0], v1 = acc[ai][bj][m][1]; const int col = c0 + bj * 128;
                        __builtin_nontemporal_store(v0, (f32x4*)(ob + (size_t)row * 1024 + col)); __builtin_nontemporal_store(v1, (f32x4*)(ob + (size_t)row * 1024 + col + 4));
                        if (!isV) { u32x4 w; w.x = cvt_pk_bf16(v0[0], v0[1]); w.y = cvt_pk_bf16(v0[2], v0[3]); w.z = cvt_pk_bf16(v1[0], v1[1]); w.w = cvt_pk_bf16(v1[2], v1[3]);
                            *(u32x4*)(KB + (size_t)row * 1024 + col) = w; }
                        else {
#pragma unroll
                            for (int j = 0; j < 4; ++j) { VT[(size_t)(col + j) * 1024 + row] = (bf16_t)f2bf(v0[j]); VT[(size_t)(col + 4 + j) * 1024 + row] = (bf16_t)f2bf(v1[j]); } } } }
            publish(0);
        }
    }
};
__device__ __forceinline__ void wait_done(unsigned* done) {
    if (threadIdx.x == 0) { unsigned spins = 0;
        while (__hip_atomic_load(done, __ATOMIC_RELAXED, __HIP_MEMORY_SCOPE_AGENT) < 32u || __hip_atomic_load(done + 64, __ATOMIC_RELAXED, __HIP_MEMORY_SCOPE_AGENT) < 48u) { __builtin_amdgcn_s_sleep(8); if (++spins > (1u << 21)) break; }
        __builtin_amdgcn_fence(__ATOMIC_ACQUIRE, "agent"); asm volatile("s_waitcnt vmcnt(0)" ::: "memory"); }
    __syncthreads();
}
struct SchedP3 {
    int G, c; pg8::TileOrder to; const char* OALL; const char* WbT;
    __device__ __forceinline__ void a_ready(const pg8::Unit&) const {}
    __device__ __forceinline__ bool next(int i, pg8::Unit& u) const {
        const int nmine = (32 * 8 - c + G - 1) / G;
        int e = 96;
        if (G == 256) {
            int qm, qn; to.map(c, qm, qn);
            if (qm < 12) { if (i == 0) e = qm * 8 + qn; else i -= 1; }
        }
        if (e >= 96 && i < 3 * nmine) { const int ti = i / 3, j = i - 3 * ti; const int L = ti * G + c;
            int pm, pn; to.map(L, pm, pn);
            u.A = OALL + ((size_t)pm * 256 * DMIX + (size_t)j * 1024) * 2; u.B = WbT + ((size_t)pn * 256 * DMIX + (size_t)j * 1024) * 2; u.pm = pm; u.pn = pn; u.kind = 0; u.aux = j; u.nt = 16; u.half = 0; u.ks = 0; u.grp = 0; return true; }
        if (G != 256) e = (i - 3 * nmine) * G + c;
        if (e >= 96) return false;
        const int pn = e / 12, r = e - 12 * pn, j = r >> 2, k4 = r & 3;
        u.A = OALL + ((size_t)32 * 256 * DMIX + (size_t)j * 1024 + (size_t)k4 * 256) * 2; u.B = WbT + ((size_t)pn * 256 * DMIX + (size_t)j * 1024 + (size_t)k4 * 256) * 2;
        u.pm = 32; u.pn = pn; u.kind = 1; u.aux = j; u.nt = 4; u.half = 1; u.ks = r; u.grp = pn; return true;
    }
};
struct EpiP3 {
    const bf16_t* Z; bf16_t* PART; bf16_t* MERGED; float* slabs; unsigned* cnt; volatile LAS unsigned* misc; unsigned* done3;
    __device__ __forceinline__ void operator()(f32x4 (&acc)[2][2][4][2], const pg8::Unit& u, int wr, int wc, int fr, int fq) const {
        const int row0 = u.pm * 256 + wr * 64 + fr, col0 = u.pn * 256 + wc * 32 + 8 * fq, j = u.aux;
        if (u.kind == 0) {
            const __amdgpu_buffer_rsrc_t mrs = __builtin_amdgcn_make_buffer_rsrc((void*)MERGED, (short)0, (int)((size_t)MPAD * DM * 2), 0x00020000);
#pragma unroll
            for (int ai = 0; ai < 2; ++ai) {
                u32x4 g[4][2], pp[4][2];
#pragma unroll
                for (int m = 0; m < 4; ++m)
#pragma unroll
                    for (int bj = 0; bj < 2; ++bj) g[m][bj] = __builtin_nontemporal_load((const u32x4*)(Z + (size_t)(row0 + ai * 128 + m * 16) * DIN + ZC_GT + j * DM + col0 + bj * 128));
#pragma unroll
                for (int m = 0; m < 4; ++m)
#pragma unroll
                    for (int bj = 0; bj < 2; ++bj) { pp[m][bj] = (u32x4){0u, 0u, 0u, 0u}; if (j > 0) pp[m][bj] = *(const u32x4*)(PART + (size_t)(row0 + ai * 128 + m * 16) * DM + col0 + bj * 128); }
#pragma unroll
                for (int m = 0; m < 4; ++m) { const size_t row = (size_t)(row0 + ai * 128 + m * 16);
#pragma unroll
                    for (int bj = 0; bj < 2; ++bj) { const int col = col0 + bj * 128;
                        const u32x4 gg = g[m][bj], q = pp[m][bj];
                        f32x4 p0 = (f32x4){bf_lo(q.x), bf_hi(q.x), bf_lo(q.y), bf_hi(q.y)}, p1 = (f32x4){bf_lo(q.z), bf_hi(q.z), bf_lo(q.w), bf_hi(q.w)};
                        const f32x4 a0 = acc[ai][bj][m][0], a1 = acc[ai][bj][m][1];
                        p0[0] += bf_lo(gg.x) * a0[0]; p0[1] += bf_hi(gg.x) * a0[1]; p0[2] += bf_lo(gg.y) * a0[2]; p0[3] += bf_hi(gg.y) * a0[3];
                        p1[0] += bf_lo(gg.z) * a1[0]; p1[1] += bf_hi(gg.z) * a1[1]; p1[2] += bf_lo(gg.w) * a1[2]; p1[3] += bf_hi(gg.w) * a1[3];
                        u32x4 w; w.x = cvt_pk_bf16(p0[0], p0[1]); w.y = cvt_pk_bf16(p0[2], p0[3]); w.z = cvt_pk_bf16(p1[0], p1[1]); w.w = cvt_pk_bf16(p1[2], p1[3]);
                        if (j < 2) *(u32x4*)(PART + row * DM + col) = w;
                        else __builtin_amdgcn_raw_buffer_store_b128(w, mrs, (unsigned)(row * DM + col) * 2u, 0, 16); } }
            }
            if (j == 2) publish_count_wt(done3 + 64 * u.pm);
        } else {
#pragma unroll
            for (int m = 0; m < 4; ++m) { const size_t row = (size_t)(row0 + m * 16);
#pragma unroll
                for (int bj = 0; bj < 2; ++bj) { const int col = col0 + bj * 128;
                    const u32x4 g = __builtin_nontemporal_load((const u32x4*)(Z + row * DIN + ZC_GT + j * DM + col));
                    f32x4& a0 = acc[0][bj][m][0]; f32x4& a1 = acc[0][bj][m][1];
                    a0[0] *= bf_lo(g.x); a0[1] *= bf_hi(g.x); a0[2] *= bf_lo(g.y); a0[3] *= bf_hi(g.y);
                    a1[0] *= bf_lo(g.z); a1[1] *= bf_hi(g.z); a1[2] *= bf_lo(g.w); a1[3] *= bf_hi(g.w); } }
            const __amdgpu_buffer_rsrc_t mrs2 = __builtin_amdgcn_make_buffer_rsrc((void*)MERGED, (short)0, (int)((size_t)MPAD * DM * 2), 0x00020000);
            const unsigned cm = splitk_share<12, true>(acc, slabs + (size_t)u.grp * 12 * SLAB_FLOATS, u.ks, cnt + 64 * u.grp, misc);
#pragma unroll
            for (int m = 0; m < 4; ++m) { const size_t row = (size_t)(row0 + m * 16);
#pragma unroll
                for (int bj = 0; bj < 2; ++bj) { if (!((cm >> (bj * 4 + m)) & 1u)) continue;
                    const int col = col0 + bj * 128; const f32x4 p0 = acc[0][bj][m][0], p1 = acc[0][bj][m][1];
                    u32x4 w; w.x = cvt_pk_bf16(p0[0], p0[1]); w.y = cvt_pk_bf16(p0[2], p0[3]); w.z = cvt_pk_bf16(p1[0], p1[1]); w.w = cvt_pk_bf16(p1[2], p1[3]);
                    __builtin_amdgcn_raw_buffer_store_b128(w, mrs2, (unsigned)(row * DM + col) * 2u, 0, 16); } }
            publish_count_wt(done3 + 64 * 32);
        }
    }
};
struct SchedP4 {
    int G, c; pg8::TileOrder to; const char* MERGED; const char* WoT; unsigned* done3;
    __device__ __forceinline__ bool next(int i, pg8::Unit& u) const {
        int e = -1;
        if (G == 256) {
            int qm, qn; to.map(c, qm, qn);
            if (qm >= 12 && qm < 16) { if (i == 0) e = (qm - 12) * 8 + qn; else i -= 1; }
        }
        const int L = i * G + c;
        if (e < 0 && L < 32 * 8) { int pm, pn; to.map(L, pm, pn);
            u.A = MERGED + (size_t)pm * 256 * DM * 2; u.B = WoT + (size_t)pn * 256 * DM * 2; u.pm = pm; u.pn = pn; u.kind = 0; u.aux = 0; u.nt = 32; u.half = 0; u.ks = 0; u.grp = 0; return true; }
        if (G != 256) e = L - 32 * 8 - 48;
        if (e < 0 || e >= 32) return false;
        const int pn = e >> 2, ks = e & 3;
        u.A = MERGED + ((size_t)32 * 256 * DM + (size_t)ks * 512) * 2; u.B = WoT + ((size_t)pn * 256 * DM + (size_t)ks * 512) * 2; u.pm = 32; u.pn = pn; u.kind = 1; u.aux = 0; u.nt = 8; u.half = 1; u.ks = ks; u.grp = pn; return true;
    }
    __device__ __forceinline__ void a_ready(const pg8::Unit& n) const {
        if (threadIdx.x == 0) poll_count(done3 + 64 * n.pm, n.kind == 0 ? 8u : 96u);
        asm volatile("" ::: "memory"); __builtin_amdgcn_s_barrier(); asm volatile("" ::: "memory");
    }
};
struct EpiP4 {
    bf16_t* OUTF; float* slabs; unsigned* cnt; volatile LAS unsigned* misc; unsigned* done4;
    __device__ __forceinline__ void operator()(f32x4 (&acc)[2][2][4][2], const pg8::Unit& u, int wr, int wc, int fr, int fq) const {
        const int row0 = u.pm * 256 + wr * 64 + fr, col0 = u.pn * 256 + wc * 32 + 8 * fq;
        const __amdgpu_buffer_rsrc_t ors = __builtin_amdgcn_make_buffer_rsrc((void*)OUTF, (short)0, (int)((size_t)MPAD * DM * 2), 0x00020000);
        unsigned cm = 0xffffu;
        if (u.kind != 0) cm = splitk_share<4, true>(acc, slabs + (size_t)u.grp * 4 * SLAB_FLOATS, u.ks, cnt + 64 * u.grp, misc);
#pragma unroll
        for (int ai = 0; ai < 2; ++ai) { if (ai == 1 && u.half) break;
#pragma unroll
            for (int m = 0; m < 4; ++m) { const unsigned ooff = (unsigned)((row0 + ai * 128 + m * 16) * DM + col0) * 2u;
#pragma unroll
                for (int bj = 0; bj < 2; ++bj) { if (!((cm >> ((ai * 2 + bj) * 4 + m)) & 1u)) continue;
                    const f32x4 v0 = acc[ai][bj][m][0], v1 = acc[ai][bj][m][1];
                    u32x4 w; w.x = cvt_pk_bf16(v0[0], v0[1]); w.y = cvt_pk_bf16(v0[2], v0[3]); w.z = cvt_pk_bf16(v1[0], v1[1]); w.w = cvt_pk_bf16(v1[2], v1[3]);
                    __builtin_amdgcn_raw_buffer_store_b128(w, ors, ooff, bj * 256, 16); } } }
        publish_count_wt(done4 + 64 * u.pm);
    }
};

__device__ __forceinline__ void p0_transpose_item(const float* W, int N, bf16_t* WT, int ldt, LAS float* scr, int kb, int nb, int lane) {
    const int k0 = 64 * kb, n0 = 64 * nb;
    f32x4 v[16];
#pragma unroll
    for (int i = 0; i < 16; ++i) { const int idx = lane + 64 * i; v[i] = __builtin_nontemporal_load((const f32x4*)(W + (size_t)(k0 + (idx >> 4)) * N + n0 + 4 * (idx & 15))); }
#pragma unroll
    for (int i = 0; i < 16; ++i) { const int idx = lane + 64 * i, kr = idx >> 4; *(LAS f32x4*)(scr + kr * 68 + ((4 * (idx & 15)) ^ (((kr >> 3) & 3) << 3))) = v[i]; }
    asm volatile("s_waitcnt lgkmcnt(0)" ::: "memory");
    const int c = lane & 7;
#pragma unroll
    for (int j = 0; j < 8; ++j) { const int n = (lane >> 3) + 8 * j; const LAS float* s = scr + (8 * c) * 68 + (n ^ ((c & 3) << 3));
        u32x4 o; o.x = pk2(s[0 * 68], s[1 * 68]); o.y = pk2(s[2 * 68], s[3 * 68]); o.z = pk2(s[4 * 68], s[5 * 68]); o.w = pk2(s[6 * 68], s[7 * 68]);
        *(u32x4*)(WT + (size_t)(n0 + n) * ldt + k0 + 8 * c) = o; }
    asm volatile("s_waitcnt lgkmcnt(0)" ::: "memory");
}
__device__ __forceinline__ void rms_row_to_bf16(const float* xrow, const float* g, bf16_t* orow, int lane) {
    const f32x4* xr = (const f32x4*)xrow + lane; const f32x4* gr = (const f32x4*)g + lane;
    f32x4 v[8]; float s = 0.f;
#pragma unroll
    for (int j = 0; j < 8; ++j) { v[j] = __builtin_nontemporal_load(xr + 64 * j); s += (v[j].x * v[j].x + v[j].y * v[j].y) + (v[j].z * v[j].z + v[j].w * v[j].w); }
    const float rs = 1.0f / sqrtf(wave_sum(s) * (1.0f / DM) + EPS);
    u32x2* o8 = (u32x2*)orow + lane;
#pragma unroll
    for (int j = 0; j < 8; ++j) { const f32x4 gg = gr[64 * j]; u32x2 w; w.x = pk2(v[j].x * rs * gg.x, v[j].y * rs * gg.y); w.y = pk2(v[j].z * rs * gg.z, v[j].w * rs * gg.w); o8[64 * j] = w; }
}
__device__ __forceinline__ void p0_prologue(const Params& P, LAS unsigned char* lds, int G, int wave, int lane) {
    LAS float* scr = (LAS float*)(lds + wave * 17408);
    const int gw = blockIdx.x * 8 + wave, NGW = G * 8;
    bf16_t* WinT = (bf16_t*)(P.ws + WS_WINT); bf16_t* WkvT = (bf16_t*)(P.ws + WS_WKVT);
    bf16_t* WrgT = (bf16_t*)(P.ws + WS_WRGT); bf16_t* WpT = (bf16_t*)(P.ws + WS_WPT);
    constexpr int I_WIN = 32 * 192, I_WKV = 32 * 32, I_RG = 2 * 8 * 4, I_WP = 4 * 16;
    constexpr int NITEMS = I_WIN + I_WKV + I_RG + I_WP;
    for (int it = gw; it < NITEMS; it += NGW) {
        int r = it;
        if (r < I_WIN) { p0_transpose_item(P.w_in, DIN, WinT, 2048, scr, r / 192, r % 192, lane); continue; } r -= I_WIN;
        if (r < I_WKV) { p0_transpose_item(P.w_kv, 2048, WkvT, 2048, scr, r / 32, r % 32, lane); continue; } r -= I_WKV;
        if (r < I_RG) { const int gate = r >> 5, blk = (r >> 2) & 7, sub = r & 3;
            p0_transpose_item((gate ? P.w_rg_x : P.w_rg_a) + blk * 16384, 128, WrgT + (size_t)(gate * 8 + blk) * 16384, 128, scr, sub >> 1, sub & 1, lane); continue; } r -= I_RG;
        { const int grp = r >> 4, sub = r & 15;
            p0_transpose_item(P.w_pool + grp * 65536, 256, WpT + (size_t)grp * 65536, 256, scr, sub >> 2, sub & 3, lane); }
    }
    { unsigned long long* GR = (unsigned long long*)(P.ws + WS_GR); for (int i = blockIdx.x * 512 + threadIdx.x; i < 4 * 8 * 16 * 128; i += G * 512) GR[i] = ~0ull; }
    bf16_t* U = (bf16_t*)(P.ws + WS_U); bf16_t* MEMN = (bf16_t*)(P.ws + WS_MEMN);
    for (int m = gw; m < MPAD + 1024; m += NGW) {
        if (m < MP) rms_row_to_bf16(P.x_prompt + (size_t)m * DM, P.g_pre, U + (size_t)m * DM, lane);
        else if (m < MTOT) rms_row_to_bf16(P.x_sample + (size_t)(m - MP) * DM, P.g_pre, U + (size_t)m * DM, lane);
        else if (m < MPAD) { u32x2* o8 = (u32x2*)(U + (size_t)m * DM) + lane;
#pragma unroll
            for (int j = 0; j < 8; ++j) o8[64 * j] = (u32x2){0u, 0u}; }
        else rms_row_to_bf16(P.mem + (size_t)(m - MPAD) * DM, P.g_mem, MEMN + (size_t)(m - MPAD) * DM, lane);
    }
}

__device__ __forceinline__ void deferred_prep(const Params& P, LAS unsigned char* lds, int G, int wave, int lane) {
    const int first = (G == 256) ? 80 : 0, nw = G - first;
    if ((int)blockIdx.x < first) return;
    LAS float* scr = (LAS float*)(lds + wave * 17408);
    const int gw = ((int)blockIdx.x - first) * 8 + wave, NGW = nw * 8;
    bf16_t* WbT = (bf16_t*)(P.ws + WS_WBT); bf16_t* WoT = (bf16_t*)(P.ws + WS_WOT);
    constexpr int I_WB = 48 * 32, I_WO = 32 * 32;
    for (int it = gw; it < I_WB + I_WO; it += NGW) {
        if (it < I_WB) p0_transpose_item(P.w_branch, 2048, WbT, 3072, scr, it / 32, it % 32, lane);
        else { const int r = it - I_WB; p0_transpose_item(P.w_out, 2048, WoT, 2048, scr, r / 32, r % 32, lane); }
    }
    for (int r = gw; r < NS * 14 + NS * 2; r += NGW) {
        const float* src; float* dst;
        if (r < NS * 14) { const int s = r / 14, k = r - 14 * s; src = P.st_pool + ((size_t)s * 15 + k + 1) * 1024; dst = P.out + OFF_NPS + ((size_t)s * 15 + k) * 1024; }
        else { const int q = r - NS * 14, s = q >> 1, k = q & 1; src = P.st_conv + ((size_t)s * 3 + k + 1) * 1024; dst = P.out + OFF_NCS + ((size_t)s * 3 + k) * 1024; }
#pragma unroll
        for (int j = 0; j < 4; ++j) __builtin_nontemporal_store(__builtin_nontemporal_load((const f32x4*)src + 64 * j + lane), (f32x4*)dst + 64 * j + lane);
    }
}

__device__ __forceinline__ f32x2 ldz2(const bf16_t* p) { const unsigned u = *(const unsigned*)p; return (f32x2){bf_lo(u), bf_hi(u)}; }
__device__ __forceinline__ f32x2 lds2(const LAS unsigned char* p) { const unsigned u = *(const LAS unsigned*)p; return (f32x2){bf_lo(u), bf_hi(u)}; }
__device__ __forceinline__ u32x4 mul_bf16x8(u32x4 a, u32x4 b) {
    u32x4 o; o.x = pk2(bf_lo(a.x) * bf_lo(b.x), bf_hi(a.x) * bf_hi(b.x)); o.y = pk2(bf_lo(a.y) * bf_lo(b.y), bf_hi(a.y) * bf_hi(b.y));
    o.z = pk2(bf_lo(a.z) * bf_lo(b.z), bf_hi(a.z) * bf_hi(b.z)); o.w = pk2(bf_lo(a.w) * bf_lo(b.w), bf_hi(a.w) * bf_hi(b.w)); return o;
}
__device__ __forceinline__ float one_minus_exp(float x) {
    const float p = -x * (1.0f + x * (0.5f + x * (0.16666667f + x * (0.041666668f + x * (0.0083333338f + x * 0.0013888889f)))));
    const float d = 1.0f - __builtin_amdgcn_exp2f(x * LOG2E);
    return x > -0.25f ? p : d;
}
constexpr unsigned long long GR_EMPTY = ~0ull;

template <bool SAMPLE>
__device__ __forceinline__ void rglru_unit(const Params& P, LAS unsigned char* lds, int b, int n, int c) {
    constexpr int NMT = SAMPLE ? 2 : 16;
    constexpr int NROW = NMT * 16;
    int tid_ = threadIdx.x; asm volatile("" : "+v"(tid_));
    const int tid = tid_, wid = __builtin_amdgcn_readfirstlane(tid >> 6), lane = tid & 63, fr = lane & 15, fq = lane >> 4;
    const bf16_t* Z = (const bf16_t*)(P.ws + WS_Z); bf16_t* OALL = (bf16_t*)(P.ws + WS_OALL); const bf16_t* WrgT = (const bf16_t*)(P.ws + WS_WRGT);
    unsigned long long* GR = (unsigned long long*)(P.ws + WS_GR);
    constexpr int XS = 272;
    LAS unsigned char* XR = lds; LAS unsigned char* HO = lds; LAS unsigned char* XC = lds + 259 * XS;
    const int rowbase = SAMPLE ? MP + 32 * c : b * SEQ + c * 256;
    __syncthreads();
    if (!SAMPLE) {
        u32x4 xv[9];
#pragma unroll
        for (int i = 0; i < 9; ++i) { const int v = tid + 512 * i, row = v >> 4, cv = v & 15; int t = c * 256 - 3 + row; t = t < 0 ? 0 : (t > SEQ - 1 ? SEQ - 1 : t);
            xv[i] = __builtin_nontemporal_load((const u32x4*)(Z + (size_t)(b * SEQ + t) * DIN + ZC_XR + n * 128 + cv * 8)); }
#pragma unroll
        for (int i = 0; i < 9; ++i) { const int v = tid + 512 * i, row = v >> 4, cv = v & 15; const bool neg = (c * 256 - 3 + row) < 0;
            if (row < 259) *(LAS u32x4*)(XR + row * XS + cv * 16) = neg ? (u32x4){0u, 0u, 0u, 0u} : xv[i]; }
    }
    bf16x8 wa[4], wx[4];
    { const bf16_t* pa = WrgT + ((size_t)(0 * 8 + n) * 128 + 16 * wid + fr) * 128 + 8 * fq; const bf16_t* px = WrgT + ((size_t)(1 * 8 + n) * 128 + 16 * wid + fr) * 128 + 8 * fq;
#pragma unroll
      for (int ks = 0; ks < 4; ++ks) { wa[ks] = *(const bf16x8*)(pa + 32 * ks); wx[ks] = *(const bf16x8*)(px + 32 * ks); } }
    const int e = n * 128 + 16 * wid + fr;
    const float ba = P.b_rg_a[e], bx = P.b_rg_x[e];
    const float c8 = -8.0f * log1pf(expf(-P.lam[e]));
    {
      const int cp = tid & 63, seg = tid >> 6, ch = n * 128 + 2 * cp;
      const f32x2 w0 = *(const f32x2*)(P.conv_w + 0 * 1024 + ch), w1 = *(const f32x2*)(P.conv_w + 1 * 1024 + ch), w2 = *(const f32x2*)(P.conv_w + 2 * 1024 + ch), w3 = *(const f32x2*)(P.conv_w + 3 * 1024 + ch);
      const f32x2 cb = *(const f32x2*)(P.conv_b + ch);
      if (!SAMPLE) {
          __syncthreads();
          const int r0 = 32 * seg;
          f32x2 x3 = lds2(XR + (r0 + 0) * XS + 4 * cp), x2 = lds2(XR + (r0 + 1) * XS + 4 * cp), x1 = lds2(XR + (r0 + 2) * XS + 4 * cp);
#pragma unroll 8
          for (int i = 0; i < 32; ++i) { const int t = c * 256 + r0 + i;
              const f32x2 x0 = lds2(XR + (r0 + i + 3) * XS + 4 * cp);
              const f32x2 xc = cb + w0 * x3 + w1 * x2 + w2 * x1 + w3 * x0;
              *(LAS unsigned*)(XC + (r0 + i) * XS + 4 * cp) = pk2(xc.x, xc.y);
              if (t >= SEQ - 3) *(f32x2*)(P.out + OFF_NCP + (size_t)(b * 3 + (t - (SEQ - 3))) * 1024 + ch) = x0;
              x3 = x2; x2 = x1; x1 = x0; }
      } else {
#pragma unroll
          for (int i = 0; i < 4; ++i) { const int sl = 4 * seg + i, s = 32 * c + sl;
              const f32x2 x3 = *(const f32x2*)(P.st_conv + (size_t)(s * 3 + 0) * 1024 + ch), x2 = *(const f32x2*)(P.st_conv + (size_t)(s * 3 + 1) * 1024 + ch), x1 = *(const f32x2*)(P.st_conv + (size_t)(s * 3 + 2) * 1024 + ch);
              const f32x2 x0 = ldz2(Z + (size_t)(MP + s) * DIN + ZC_XR + ch);
              const f32x2 xc = cb + w0 * x3 + w1 * x2 + w2 * x1 + w3 * x0;
              *(LAS unsigned*)(XC + sl * XS + 4 * cp) = pk2(xc.x, xc.y);
              *(f32x2*)(P.out + OFF_NCS + (size_t)(s * 3 + 2) * 1024 + ch) = x0; }
      } }
    __syncthreads();
    unsigned cumA[NMT][2], hloc[NMT][2];
    float Ac = 1.f, Hc = 0.f;
#pragma unroll
    for (int mt = 0; mt < NMT; ++mt) {
        f32x4 racc = (f32x4){0.f, 0.f, 0.f, 0.f}, iacc = racc;
#pragma unroll
        for (int ks = 0; ks < 4; ++ks) { const bf16x8 a = *(const LAS bf16x8*)(XC + (16 * mt + fr) * XS + (32 * ks + 8 * fq) * 2);
            racc = __builtin_amdgcn_mfma_f32_16x16x32_bf16(a, wa[ks], racc, 0, 0, 0); iacc = __builtin_amdgcn_mfma_f32_16x16x32_bf16(a, wx[ks], iacc, 0, 0, 0); }
        float av[4], bv[4];
#pragma unroll
        for (int j = 0; j < 4; ++j) { const int row = 16 * mt + 4 * fq + j;
            const float r = sigmoid_f(racc[j] + ba), ig = sigmoid_f(iacc[j] + bx);
            const float la = c8 * r;
            av[j] = __builtin_amdgcn_exp2f(la * LOG2E); const float mult = __builtin_amdgcn_sqrtf(one_minus_exp(2.0f * la));
            const float xcv = bf2f(*(const LAS bf16_t*)(XC + row * XS + (16 * wid + fr) * 2));
            bv[j] = mult * ig * xcv; }
        if (!SAMPLE) {
            float Pj[4], Qj[4]; float pp = 1.f, qq = 0.f;
#pragma unroll
            for (int j = 0; j < 4; ++j) { qq = av[j] * qq + bv[j]; pp = av[j] * pp; Pj[j] = pp; Qj[j] = qq; }
            float Arun = Ac, Hrun = Hc, Ain = 1.f, Hin = 0.f;
#pragma unroll
            for (int g = 0; g < 4; ++g) { const float pg = __shfl(pp, fr + 16 * g), qg = __shfl(qq, fr + 16 * g); if (g == fq) { Ain = Arun; Hin = Hrun; } Hrun = pg * Hrun + qg; Arun = pg * Arun; }
            Ac = Arun; Hc = Hrun;
            cumA[mt][0] = cvt_pk_bf16(Pj[0] * Ain, Pj[1] * Ain); cumA[mt][1] = cvt_pk_bf16(Pj[2] * Ain, Pj[3] * Ain);
            hloc[mt][0] = cvt_pk_bf16(Pj[0] * Hin + Qj[0], Pj[1] * Hin + Qj[1]); hloc[mt][1] = cvt_pk_bf16(Pj[2] * Hin + Qj[2], Pj[3] * Hin + Qj[3]);
        } else {
            const int s0 = 32 * c + 16 * mt + 4 * fq;
            float hv[4];
#pragma unroll
            for (int j = 0; j < 4; ++j) { const float h0 = P.st_h[(size_t)(s0 + j) * 1024 + e]; hv[j] = av[j] * h0 + bv[j]; P.out[OFF_NHS + (size_t)(s0 + j) * 1024 + e] = hv[j]; }
            cumA[mt][0] = 0u; cumA[mt][1] = 0u; hloc[mt][0] = cvt_pk_bf16(hv[0], hv[1]); hloc[mt][1] = cvt_pk_bf16(hv[2], hv[3]);
        }
    }
    float carry = 0.f;
    if (!SAMPLE) {
        unsigned long long* gbase = GR + (size_t)((b * 8 + n) * 8) * 128 + 16 * wid + fr;
        if (fq == 0) __hip_atomic_store(gbase + (size_t)c * 128, ((unsigned long long)__builtin_bit_cast(unsigned, Hc) << 32) | (unsigned long long)__builtin_bit_cast(unsigned, Ac), __ATOMIC_RELAXED, __HIP_MEMORY_SCOPE_AGENT);
        if (c > 0) {
            unsigned long long g[7]; unsigned spins = 0;
            for (;;) { bool ok = true;
#pragma unroll
                for (int cc = 0; cc < 7; ++cc) { g[cc] = __hip_atomic_load(gbase + (size_t)cc * 128, __ATOMIC_RELAXED, __HIP_MEMORY_SCOPE_AGENT); }
#pragma unroll
                for (int cc = 0; cc < 7; ++cc) ok = ok && (cc >= c || g[cc] != GR_EMPTY);
                if (__all(ok) || ++spins > (1u << 20)) break;
                __builtin_amdgcn_s_sleep(2); }
#pragma unroll
            for (int cc = 0; cc < 7; ++cc) { const float ga = __builtin_bit_cast(float, (unsigned)g[cc]), gh = __builtin_bit_cast(float, (unsigned)(g[cc] >> 32)); const float nc = ga * carry + gh; carry = (cc < c) ? nc : carry; }
        }
        if (c == 7 && fq == 0) P.out[OFF_NHP + (size_t)b * 1024 + e] = Ac * carry + Hc;
    }
#pragma unroll
    for (int mt = 0; mt < NMT; ++mt)
#pragma unroll
        for (int j = 0; j < 4; ++j) { const int row = 16 * mt + 4 * fq + j;
            const unsigned ca = cumA[mt][j >> 1], hl = hloc[mt][j >> 1];
            const float h = ((j & 1) ? bf_hi(ca) : bf_lo(ca)) * carry + ((j & 1) ? bf_hi(hl) : bf_lo(hl));
            *(LAS bf16_t*)(HO + row * XS + (16 * wid + fr) * 2) = (bf16_t)f2bf(h); }
    __syncthreads();
    { u32x4 gg[NROW / 32];
#pragma unroll
      for (int i = 0; i < NROW / 32; ++i) { const int v = tid + 512 * i, row = v >> 4, cv = v & 15; gg[i] = __builtin_nontemporal_load((const u32x4*)(Z + (size_t)(rowbase + row) * DIN + ZC_GR + n * 128 + cv * 8)); }
#pragma unroll
      for (int i = 0; i < NROW / 32; ++i) { const int v = tid + 512 * i, row = v >> 4, cv = v & 15;
          const u32x4 ho = *(const LAS u32x4*)(HO + row * XS + cv * 16);
          *(u32x4*)(OALL + (size_t)(rowbase + row) * DMIX + n * 128 + cv * 8) = mul_bf16x8(ho, gg[i]); } }
}

template <bool SAMPLE>
__device__ __forceinline__ void pool_unit(const Params& P, LAS unsigned char* lds, int b, int g, int blk) {
    int tid_ = threadIdx.x; asm volatile("" : "+v"(tid_));
    const int tid = tid_, wid = __builtin_amdgcn_readfirstlane(tid >> 6), lane = tid & 63, fr = lane & 15, fq = lane >> 4;
    const bf16_t* Z = (const bf16_t*)(P.ws + WS_Z); bf16_t* OALL = (bf16_t*)(P.ws + WS_OALL); const bf16_t* WpT = (const bf16_t*)(P.ws + WS_WPT);
    constexpr int DS = 528;
    LAS unsigned char* XP = lds; LAS unsigned char* OUT = lds; LAS unsigned char* D = lds + 144 * DS;
    const int W = 2 << g;
    const int rowbase = SAMPLE ? MP + 16 * blk : b * SEQ + blk * 128;
    const int nmt = SAMPLE ? 1 : 8;
    __syncthreads();
    if (!SAMPLE) {
        u32x4 xv[9];
#pragma unroll
        for (int i = 0; i < 9; ++i) { const int v = tid + 512 * i, row = v >> 5, cv = v & 31; int t = blk * 128 - 15 + row; t = t < 0 ? 0 : (t > SEQ - 1 ? SEQ - 1 : t);
            xv[i] = __builtin_nontemporal_load((const u32x4*)(Z + (size_t)(b * SEQ + t) * DIN + ZC_XP + g * 256 + cv * 8)); }
#pragma unroll
        for (int i = 0; i < 9; ++i) { const int v = tid + 512 * i, row = v >> 5, cv = v & 31; const bool neg = (blk * 128 - 15 + row) < 0;
            *(LAS u32x4*)(XP + row * DS + cv * 16) = neg ? (u32x4){0u, 0u, 0u, 0u} : xv[i]; }
        __syncthreads();
    }
    { const int cp = tid & 127, seg = tid >> 7, ch = g * 256 + 2 * cp;
      if (!SAMPLE) {
          const int r0 = 15 + 32 * seg;
          f32x2 s = (f32x2){0.f, 0.f};
          for (int k = 1; k < W; ++k) s += lds2(XP + (r0 - k) * DS + 4 * cp);
#pragma unroll 8
          for (int i = 0; i < 32; ++i) { const int t = blk * 128 + 32 * seg + i;
              const f32x2 x0 = lds2(XP + (r0 + i) * DS + 4 * cp); s += x0;
              const float inv = 1.0f / (float)((t + 1) < W ? (t + 1) : W);
              const f32x2 d = s * inv - x0;
              *(LAS unsigned*)(D + (32 * seg + i) * DS + 4 * cp) = pk2(d.x, d.y);
              s -= lds2(XP + (r0 + i - W + 1) * DS + 4 * cp);
              if (t >= SEQ - 15) *(f32x2*)(P.out + OFF_NPP + (size_t)(b * 15 + (t - (SEQ - 15))) * 1024 + ch) = x0; }
      } else {
          const float inv = 1.0f / (float)W;
#pragma unroll
          for (int i = 0; i < 4; ++i) { const int sl = seg + 4 * i, s_ = 16 * blk + sl;
              const f32x2 x0 = ldz2(Z + (size_t)(MP + s_) * DIN + ZC_XP + ch);
              const float* hp = P.st_pool + (size_t)s_ * 15 * 1024 + ch;
              f32x2 hv[15];
#pragma unroll
              for (int k = 1; k < 16; ++k) hv[k - 1] = *(const f32x2*)(hp + (size_t)(15 - k) * 1024);
              f32x2 s = x0;
#pragma unroll
              for (int k = 1; k < 16; ++k) { const f32x2 a = s + hv[k - 1]; s = (k < W) ? a : s; }
              *(f32x2*)(P.out + OFF_NPS + ((size_t)s_ * 15 + 14) * 1024 + ch) = x0;
              const f32x2 d = s * inv - x0;
              *(LAS unsigned*)(D + sl * DS + 4 * cp) = pk2(d.x, d.y); }
      } }
    __syncthreads();
    {
      bf16x8 bw[2][8];
#pragma unroll
      for (int nt = 0; nt < 2; ++nt) { const bf16_t* pw = WpT + ((size_t)g * 256 + 32 * wid + 16 * nt + fr) * 256 + 8 * fq;
#pragma unroll
          for (int ks = 0; ks < 8; ++ks) bw[nt][ks] = *(const bf16x8*)(pw + 32 * ks); }
      const float ps0 = P.pool_scale[g * 256 + 32 * wid + fr], ps1 = P.pool_scale[g * 256 + 32 * wid + 16 + fr];
#pragma unroll 2
      for (int mt = 0; mt < nmt; ++mt) {
          f32x4 a0 = (f32x4){0.f, 0.f, 0.f, 0.f}, a1 = a0;
#pragma unroll
          for (int ks = 0; ks < 8; ++ks) { const bf16x8 a = *(const LAS bf16x8*)(D + (16 * mt + fr) * DS + (32 * ks + 8 * fq) * 2);
              a0 = __builtin_amdgcn_mfma_f32_16x16x32_bf16(a, bw[0][ks], a0, 0, 0, 0); a1 = __builtin_amdgcn_mfma_f32_16x16x32_bf16(a, bw[1][ks], a1, 0, 0, 0); }
#pragma unroll
          for (int j = 0; j < 4; ++j) { const int row = 16 * mt + 4 * fq + j;
              *(LAS bf16_t*)(OUT + row * DS + (32 * wid + fr) * 2) = (bf16_t)f2bf(a0[j] * ps0); *(LAS bf16_t*)(OUT + row * DS + (32 * wid + 16 + fr) * 2) = (bf16_t)f2bf(a1[j] * ps1); }
      } }
    __syncthreads();
    for (int i = 0; i < nmt; ++i) { const int v = tid + 512 * i, row = v >> 5, cv = v & 31;
        const u32x4 ho = *(const LAS u32x4*)(OUT + row * DS + cv * 16);
        const u32x4 gg = __builtin_nontemporal_load((const u32x4*)(Z + (size_t)(rowbase + row) * DIN + ZC_GP + g * 256 + cv * 8));
        *(u32x4*)(OALL + (size_t)(rowbase + row) * DMIX + 1024 + g * 256 + cv * 8) = mul_bf16x8(ho, gg); }
}

__device__ __forceinline__ void attn_stage(LAS unsigned char* lds, const bf16_t* src  , int wid, int lane) {
#pragma unroll
    for (int i = 0; i < 16; ++i) { const int piece = wid * 16 + i, row = 2 * piece + (lane >> 5), p = lane & 31;
        __builtin_amdgcn_global_load_lds((const unsigned*)(src + (size_t)row * 1024 + ((p ^ (row & 15)) << 3)), (LAS unsigned*)(lds + piece * 1024), 16, 0, 0); }
}
__device__ __forceinline__ void attn_unit(const Params& P, LAS unsigned char* lds, int b, int h, int blk) {
    int tid_ = threadIdx.x; asm volatile("" : "+v"(tid_));
    const int tid = tid_, wid = __builtin_amdgcn_readfirstlane(tid >> 6), lane = tid & 63, fr = lane & 15, fq = lane >> 4;
    const bf16_t* Z = (const bf16_t*)(P.ws + WS_Z); bf16_t* OALL = (bf16_t*)(P.ws + WS_OALL); const bf16_t* KB = (const bf16_t*)(P.ws + WS_KB); const bf16_t* VT = (const bf16_t*)(P.ws + WS_VT);
    const int m0 = b * SEQ + blk * 128 + 16 * wid;
    __syncthreads();
    attn_stage(lds, KB + (size_t)(b * 256) * 1024 + h * 256, wid, lane);
    bf16x8 qf[8];
    { const bf16_t* qp = Z + (size_t)(m0 + fr) * DIN + ZC_Q + h * 256 + 8 * fq;
#pragma unroll
      for (int ks = 0; ks < 8; ++ks) qf[ks] = *(const bf16x8*)(qp + 32 * ks); }
    asm volatile("s_waitcnt vmcnt(0)" ::: "memory");
    __syncthreads();
    f32x4 st[16];
#pragma unroll
    for (int t = 0; t < 16; ++t) { f32x4 a = (f32x4){0.f, 0.f, 0.f, 0.f};
#pragma unroll
        for (int ks = 0; ks < 8; ++ks) { const bf16x8 kf = *(const LAS bf16x8*)(lds + (16 * t + fr) * 512 + (((4 * ks + fq) ^ fr) << 4)); a = __builtin_amdgcn_mfma_f32_16x16x32_bf16(kf, qf[ks], a, 0, 0, 0); }
        st[t] = a; }
    __syncthreads();
    attn_stage(lds, VT + (size_t)(h * 256) * 1024 + b * 256, wid, lane);
    float mx = -3.0e38f;
#pragma unroll
    for (int t = 0; t < 16; ++t) mx = fmaxf(mx, fmaxf(fmaxf(st[t][0], st[t][1]), fmaxf(st[t][2], st[t][3])));
    mx = fmaxf(mx, __shfl_xor(mx, 16)); mx = fmaxf(mx, __shfl_xor(mx, 32));
    const float sc = LOG2E * 0.0625f; float sum = 0.f;
#pragma unroll
    for (int t = 0; t < 16; ++t)
#pragma unroll
        for (int j = 0; j < 4; ++j) { const float p = __builtin_amdgcn_exp2f((st[t][j] - mx) * sc); st[t][j] = p; sum += p; }
    sum += __shfl_xor(sum, 16); sum += __shfl_xor(sum, 32);
    const float inv = 1.0f / sum;
    bf16x8 pf[8];
#pragma unroll
    for (int s = 0; s < 8; ++s) { u32x4 w; w.x = cvt_pk_bf16(st[2 * s][0], st[2 * s][1]); w.y = cvt_pk_bf16(st[2 * s][2], st[2 * s][3]); w.z = cvt_pk_bf16(st[2 * s + 1][0], st[2 * s + 1][1]); w.w = cvt_pk_bf16(st[2 * s + 1][2], st[2 * s + 1][3]);
        pf[s] = __builtin_bit_cast(bf16x8, w); }
    asm volatile("s_waitcnt vmcnt(0)" ::: "memory");
    __syncthreads();
    u32x4 gg[8];
#pragma unroll
    for (int i = 0; i < 8; ++i) { const int v = lane + 64 * i, row = v >> 5, cv = v & 31; gg[i] = __builtin_nontemporal_load((const u32x4*)(Z + (size_t)(m0 + row) * DIN + ZC_GX + h * 256 + cv * 8)); }
    u32x2 ov[16];
#pragma unroll
    for (int dt = 0; dt < 16; ++dt) { f32x4 a = (f32x4){0.f, 0.f, 0.f, 0.f};
#pragma unroll
        for (int s = 0; s < 8; ++s) { const LAS unsigned char* rp = lds + (16 * dt + fr) * 512 + 8 * (fq & 1);
            const u32x2 lo = *(const LAS u32x2*)(rp + (((4 * s + (fq >> 1)) ^ fr) << 4)), hi = *(const LAS u32x2*)(rp + (((4 * s + 2 + (fq >> 1)) ^ fr) << 4));
            const u32x4 w = (u32x4){lo.x, lo.y, hi.x, hi.y};
            a = __builtin_amdgcn_mfma_f32_16x16x32_bf16(__builtin_bit_cast(bf16x8, w), pf[s], a, 0, 0, 0); }
        ov[dt].x = pk2(a[0] * inv, a[1] * inv); ov[dt].y = pk2(a[2] * inv, a[3] * inv); }
    __syncthreads();
#pragma unroll
    for (int dt = 0; dt < 16; ++dt) *(LAS u32x2*)(lds + (16 * wid + fr) * 528 + (16 * dt + 4 * fq) * 2) = ov[dt];
    asm volatile("s_waitcnt lgkmcnt(0)" ::: "memory");
    {
#pragma unroll
      for (int i = 0; i < 8; ++i) { const int v = lane + 64 * i, row = v >> 5, cv = v & 31;
          const u32x4 ho = *(const LAS u32x4*)(lds + (16 * wid + row) * 528 + cv * 16);
          *(u32x4*)(OALL + (size_t)(m0 + row) * DMIX + 2048 + h * 256 + cv * 8) = mul_bf16x8(ho, gg[i]); } }
}

__device__ __forceinline__ void sattn_unit(const Params& P, LAS unsigned char* lds, int s, int h) {
    int tid_ = threadIdx.x; asm volatile("" : "+v"(tid_));
    const int tid = tid_, wid = __builtin_amdgcn_readfirstlane(tid >> 6), lane = tid & 63;
    const bf16_t* Z = (const bf16_t*)(P.ws + WS_Z); bf16_t* OALL = (bf16_t*)(P.ws + WS_OALL);
    LAS float* SC = (LAS float*)lds; LAS float* PS = SC + 256; LAS float* PO = PS + 256;
    __syncthreads();
    f32x4 q4;
    { const u32x2 qq = *(const u32x2*)(Z + (size_t)(MP + s) * DIN + ZC_Q + h * 256 + 4 * lane); q4 = (f32x4){bf_lo(qq.x), bf_hi(qq.x), bf_lo(qq.y), bf_hi(qq.y)}; }
    const float* kb = P.cache_k + ((size_t)(s * 256 + 32 * wid) * 4 + h) * 256 + 4 * lane;
    const float* vb = P.cache_v + ((size_t)(s * 256 + 32 * wid) * 4 + h) * 256 + 4 * lane;
    float mysc = 0.f;
    f32x4 v4[32];
    { f32x4 k4[32];
#pragma unroll
      for (int i = 0; i < 32; ++i) k4[i] = __builtin_nontemporal_load((const f32x4*)(kb + (size_t)i * 1024));
#pragma unroll
      for (int i = 0; i < 16; ++i) v4[i] = __builtin_nontemporal_load((const f32x4*)(vb + (size_t)i * 1024));
      float p[32];
#pragma unroll
      for (int i = 0; i < 32; ++i) p[i] = (k4[i].x * q4.x + k4[i].y * q4.y) + (k4[i].z * q4.z + k4[i].w * q4.w);
      float q16[16], q8[8], q4v[4], q2[2];
      { const bool hi = (lane & 32) != 0;
#pragma unroll
        for (int j = 0; j < 16; ++j) { const float send = hi ? p[j] : p[j + 16], keep = hi ? p[j + 16] : p[j]; q16[j] = keep + __shfl_xor(send, 32); } }
      { const bool hi = (lane & 16) != 0;
#pragma unroll
        for (int j = 0; j < 8; ++j) { const float send = hi ? q16[j] : q16[j + 8], keep = hi ? q16[j + 8] : q16[j]; q8[j] = keep + __shfl_xor(send, 16); } }
      { const bool hi = (lane & 8) != 0;
#pragma unroll
        for (int j = 0; j < 4; ++j) { const float send = hi ? q8[j] : q8[j + 4], keep = hi ? q8[j + 4] : q8[j]; q4v[j] = keep + __shfl_xor(send, 8); } }
      { const bool hi = (lane & 4) != 0;
#pragma unroll
        for (int j = 0; j < 2; ++j) { const float send = hi ? q4v[j] : q4v[j + 2], keep = hi ? q4v[j + 2] : q4v[j]; q2[j] = keep + __shfl_xor(send, 4); } }
      { const bool hi = (lane & 2) != 0; const float send = hi ? q2[0] : q2[1], keep = hi ? q2[1] : q2[0]; mysc = keep + __shfl_xor(send, 2); }
      mysc += __shfl_xor(mysc, 1); }
#pragma unroll
    for (int i = 16; i < 32; ++i) v4[i] = __builtin_nontemporal_load((const f32x4*)(vb + (size_t)i * 1024));
    if ((lane & 1) == 0) SC[32 * wid + (lane >> 1)] = mysc;
    __syncthreads();
    { float v[4]; float mx = -3.0e38f;
#pragma unroll
      for (int k = 0; k < 4; ++k) { v[k] = SC[lane + 64 * k]; mx = fmaxf(mx, v[k]); }
      mx = wave_max(mx); float sum = 0.f; const float sc = LOG2E * 0.0625f;
#pragma unroll
      for (int k = 0; k < 4; ++k) { v[k] = __builtin_amdgcn_exp2f((v[k] - mx) * sc); sum += v[k]; }
      sum = wave_sum(sum); const float inv = 1.0f / sum;
      if (wid == 0) {
#pragma unroll
          for (int k = 0; k < 4; ++k) PS[lane + 64 * k] = v[k] * inv; } }
    __syncthreads();
    { f32x4 a = (f32x4){0.f, 0.f, 0.f, 0.f};
#pragma unroll
      for (int i = 0; i < 32; ++i) { const float p = PS[32 * wid + i]; a += v4[i] * p; }
      *(LAS f32x4*)(PO + wid * 256 + 4 * lane) = a; }
    __syncthreads();
    if (tid < 256) { float o = 0.f;
#pragma unroll
        for (int w = 0; w < 8; ++w) o += PO[w * 256 + tid];
        const float gx = bf2f(Z[(size_t)(MP + s) * DIN + ZC_GX + h * 256 + tid]);
        OALL[(size_t)(MP + s) * DMIX + 2048 + h * 256 + tid] = (bf16_t)f2bf(o * gx); }
}

__device__ __forceinline__ void p5_rows(const Params& P, int m0, int mstep, int mend, int lane) {
    const bf16_t* OUTB = (const bf16_t*)(P.ws + WS_OUTB);
    for (int m = m0; m < mend; m += mstep) {
        const u32x4* orow = (const u32x4*)(OUTB + (size_t)m * DM) + lane;
        const f32x4* xrow = (const f32x4*)(m < MP ? P.x_prompt + (size_t)m * DM : P.x_sample + (size_t)(m - MP) * DM) + 2 * lane;
        const f32x4* gr = (const f32x4*)P.g_post + 2 * lane;
        u32x4 v[4]; f32x4 xa[4], xb[4]; float s = 0.f;
#pragma unroll
        for (int j = 0; j < 4; ++j) { v[j] = orow[64 * j]; xa[j] = xrow[128 * j]; xb[j] = xrow[128 * j + 1]; }
#pragma unroll
        for (int j = 0; j < 4; ++j) { const float a0 = bf_lo(v[j].x), a1 = bf_hi(v[j].x), a2 = bf_lo(v[j].y), a3 = bf_hi(v[j].y), a4 = bf_lo(v[j].z), a5 = bf_hi(v[j].z), a6 = bf_lo(v[j].w), a7 = bf_hi(v[j].w);
            s += ((a0 * a0 + a1 * a1) + (a2 * a2 + a3 * a3)) + ((a4 * a4 + a5 * a5) + (a6 * a6 + a7 * a7)); }
        const float rs = 1.0f / sqrtf(wave_sum(s) * (1.0f / DM) + EPS);
        f32x4* yrow = (f32x4*)(P.out + OFF_Y + (size_t)m * DM) + 2 * lane;
#pragma unroll
        for (int j = 0; j < 4; ++j) { const f32x4 g0 = gr[128 * j], g1 = gr[128 * j + 1];
            const f32x4 o0 = (f32x4){bf_lo(v[j].x), bf_hi(v[j].x), bf_lo(v[j].y), bf_hi(v[j].y)}, o1 = (f32x4){bf_lo(v[j].z), bf_hi(v[j].z), bf_lo(v[j].w), bf_hi(v[j].w)};
            yrow[128 * j] = xa[j] + o0 * rs * g0; yrow[128 * j + 1] = xb[j] + o1 * rs * g1; }
    }
}

__global__ void __launch_bounds__(512, 2) fwd_kernel(Params P) {
    extern __shared__ __attribute__((aligned(16))) unsigned char lds_raw[];
    LAS unsigned char* lds = (LAS unsigned char*)lds_raw;
    cg::grid_group grid = cg::this_grid();
    const int tid = threadIdx.x, lane = tid & 63, wave = __builtin_amdgcn_readfirstlane(tid >> 6);
    const int G = gridDim.x;
    const int lo = P.ph_lo, hi = P.ph_hi;
    volatile LAS unsigned* MISC = (volatile LAS unsigned*)(lds + LDS_MISC_OFF);
    if (tid < 16) MISC[tid] = 0u;
    __syncthreads();
    const XcdBarrier xbar = xcd_barrier_post((unsigned*)(P.ws + WS_CTL), MISC);
#define GSYNC(k) do { if (USE_CG_SEAM(k)) grid.sync(); else xcd_barrier(xbar); } while (0)
#define IN(k) (lo <= (k) && (k) < hi)
#define BOTH(k) (IN(k) && IN((k) + 1))
    if (IN(0)) { if (PROBE_REPEAT == 0) { p0_prologue(P, lds, G, wave, lane); GSYNC(9); } p0_prologue(P, lds, G, wave, lane); if (BOTH(0)) GSYNC(0); }
    if (IN(1)) {
        SchedP1 S; S.mode = 0; S.G = G; S.c = blockIdx.x; S.to.init(32, 48); S.U = (const char*)(P.ws + WS_U); S.WinT = (const char*)(P.ws + WS_WINT); S.MEMN = (const char*)(P.ws + WS_MEMN); S.WkvT = (const char*)(P.ws + WS_WKVT);
        EpiP1T<false> E; E.Z = (bf16_t*)(P.ws + WS_Z); E.out = P.out; E.KB = (bf16_t*)(P.ws + WS_KB); E.VT = (bf16_t*)(P.ws + WS_VT); E.slabs = (float*)(P.ws + WS_OALL); E.cnt = (unsigned*)(P.ws + WS_CTL) + CW_CNT + 64 * CNT_P1S; E.misc = MISC; E.done = (unsigned*)(P.ws + WS_CTL) + CW_DONE;
        if (PROBE_REPEAT == 1) { pg8::gemm_phase<EpiP1T<false>, SchedP1>(lds, 2048, 2048, S, E); GSYNC(9); }
        pg8::gemm_phase<EpiP1T<false>, SchedP1>(lds, 2048, 2048, S, E);
        if (BOTH(1)) GSYNC(9);
    }
    if (IN(2)) {
        constexpr int U_RGP = 256, U_RGS = 32, U_ATT = 256, U_PP = 256, U_PS = 32, U_SA = 512;
        constexpr int NU = U_RGP + U_RGS + U_ATT + U_PP + U_PS + U_SA;
        unsigned* done = (unsigned*)(P.ws + WS_CTL) + CW_DONE;
        { SchedP1 S; S.mode = 1; S.G = G; S.c = blockIdx.x; S.to.init(32, 48); S.U = (const char*)(P.ws + WS_U); S.WinT = (const char*)(P.ws + WS_WINT); S.MEMN = (const char*)(P.ws + WS_MEMN); S.WkvT = (const char*)(P.ws + WS_WKVT);
          EpiP1T<true> E; E.Z = (bf16_t*)(P.ws + WS_Z); E.out = P.out; E.KB = (bf16_t*)(P.ws + WS_KB); E.VT = (bf16_t*)(P.ws + WS_VT); E.slabs = (float*)(P.ws + WS_PART); E.cnt = (unsigned*)(P.ws + WS_CTL) + CW_CNT + 64 * CNT_P1S; E.misc = MISC; E.done = done;
          pg8::gemm_phase<EpiP1T<true>, SchedP1>(lds, 2048, 2048, S, E); }
        if (G == 256) {
            const int c = blockIdx.x;
            deferred_prep(P, lds, G, wave, lane);
            pool_unit<false>(P, lds, c >> 6, (c >> 4) & 3, c & 15);
            rglru_unit<false>(P, lds, c >> 6, (c >> 3) & 7, c & 7);
            wait_done(done);
            attn_unit(P, lds, c >> 6, (c >> 4) & 3, c & 15);
            {
              const int s0 = c < 80 ? c : (c < 160 ? 80 + 3 * (c - 80) : 320 + 2 * (c - 160)), ns = c < 80 ? 1 : (c < 160 ? 3 : 2);
              for (int k = 0; k < ns; ++k) sattn_unit(P, lds, (s0 + k) >> 2, (s0 + k) & 3); }
            if (c >= 224) rglru_unit<true>(P, lds, 0, (c - 224) >> 2, (c - 224) & 3);
            else if (c >= 192) pool_unit<true>(P, lds, 0, (c - 192) >> 3, (c - 192) & 7);
        } else {
        deferred_prep(P, lds, G, wave, lane);
        wait_done(done);
        for (int u = blockIdx.x; u < NU; u += G) {
            int r = u;
            if (r < U_RGP) { rglru_unit<false>(P, lds, r >> 6, (r >> 3) & 7, r & 7); continue; } r -= U_RGP;
            if (r < U_RGS) { rglru_unit<true>(P, lds, 0, r >> 2, r & 3); continue; } r -= U_RGS;
            if (r < U_ATT) { attn_unit(P, lds, r >> 6, (r >> 4) & 3, r & 15); continue; } r -= U_ATT;
            if (r < U_PP) { pool_unit<false>(P, lds, r >> 6, (r >> 4) & 3, r & 15); continue; } r -= U_PP;
            if (r < U_PS) { pool_unit<true>(P, lds, 0, r >> 3, r & 7); continue; } r -= U_PS;
            sattn_unit(P, lds, r >> 2, r & 3);
        }
        }
        __syncthreads();
        if (BOTH(2)) GSYNC(9);
    }
    if (IN(3)) {
        SchedP3 S; S.G = G; S.c = blockIdx.x; S.to.init(32, 8); S.OALL = (const char*)(P.ws + WS_OALL); S.WbT = (const char*)(P.ws + WS_WBT);
        EpiP3 E; E.Z = (const bf16_t*)(P.ws + WS_Z); E.PART = (bf16_t*)(P.ws + WS_PART); E.MERGED = (bf16_t*)(P.ws + WS_MERGED); E.slabs = (float*)(P.ws + WS_U); E.cnt = (unsigned*)(P.ws + WS_CTL) + CW_CNT + 64 * CNT_P3S; E.misc = MISC; E.done3 = (unsigned*)(P.ws + WS_CTL) + CW_DONE + 128;
        pg8::gemm_phase<EpiP3, SchedP3>(lds, DMIX, DMIX, S, E);
        if (BOTH(3) && !IN(4)) GSYNC(9);
    }
    if (IN(4)) {
        SchedP4 S; S.G = G; S.c = blockIdx.x; S.to.init(32, 8); S.MERGED = (const char*)(P.ws + WS_MERGED); S.WoT = (const char*)(P.ws + WS_WOT); S.done3 = (unsigned*)(P.ws + WS_CTL) + CW_DONE + 128;
        { pg8::Unit u0; if (S.next(0, u0)) { if (tid == 0) poll_count(S.done3 + 64 * u0.pm, u0.kind == 0 ? 8u : 96u); } __syncthreads(); }
        EpiP4 E; E.OUTF = (bf16_t*)(P.ws + WS_OUTB); E.slabs = (float*)(P.ws + WS_U + 24 * MiB); E.cnt = (unsigned*)(P.ws + WS_CTL) + CW_CNT + 64 * CNT_P4S; E.misc = MISC; E.done4 = (unsigned*)(P.ws + WS_CTL) + CW_DONE4;
        pg8::gemm_phase<EpiP4, SchedP4>(lds, DM, DM, S, E);
        if (BOTH(4) && G != 256) GSYNC(9);
    }
    if (IN(5)) {
        if (G == 256 && IN(4)) {
            unsigned* done4 = (unsigned*)(P.ws + WS_CTL) + CW_DONE4;
            pg8::TileOrder to; to.init(32, 8); int pm, pn; to.map(blockIdx.x, pm, pn);
            if (tid == 0) poll_count(done4 + 64 * pm, 8u);
            __syncthreads();
            p5_rows(P, pm * 256 + pn * 32 + wave, 8, pm * 256 + pn * 32 + 32, lane);
            if (pm >= 16 && pm < 18) {
                const int sr = ((pm - 16) * 8 + pn) * 8;
                if (tid == 0) poll_count(done4 + 64 * 32, 32u);
                __syncthreads();
                p5_rows(P, MP + sr + wave, 8, MP + sr + 8, lane);
            }
        } else p5_rows(P, blockIdx.x * 8 + wave, G * 8, MTOT, lane);
    }
#undef IN
#undef BOTH
}

extern "C" void kernel_launch(void* const* d_in, const int* in_sizes, int n_in, void* d_out, int out_size, void* d_ws, size_t ws_size, hipStream_t stream) {
    static int grid = 0;
    if (grid == 0) {
        if (n_in != 24 || (size_t)out_size != OUT_TOTAL || ws_size < WS_END) { fprintf(stderr, "kernel_launch: unexpected problem (n_in %d, out %d, ws %zu); nothing launched\n", n_in, out_size, ws_size); grid = -1; return; }
        int dev = 0, cus = 0, per_cu = 0;
        if (hipGetDevice(&dev) != hipSuccess || hipDeviceGetAttribute(&cus, hipDeviceAttributeMultiprocessorCount, dev) != hipSuccess) { grid = -1; return; }
        if (hipFuncSetAttribute((const void*)fwd_kernel, hipFuncAttributeMaxDynamicSharedMemorySize, LDS_BYTES) != hipSuccess) { fprintf(stderr, "kernel_launch: hipFuncSetAttribute failed\n"); grid = -1; return; }
        if (hipOccupancyMaxActiveBlocksPerMultiprocessor(&per_cu, (const void*)fwd_kernel, 512, LDS_BYTES) != hipSuccess || per_cu < 1) { fprintf(stderr, "kernel_launch: occupancy query failed (%d)\n", per_cu); (void)hipGetLastError(); grid = -1; return; }
        grid = cus * per_cu;
    }
    if (grid < 0) return;
    Params p{};
    p.x_prompt = (const float*)d_in[0]; p.x_sample = (const float*)d_in[1]; p.mem = (const float*)d_in[2]; p.st_h = (const float*)d_in[3]; p.st_conv = (const float*)d_in[4]; p.st_pool = (const float*)d_in[5];
    p.cache_k = (const float*)d_in[6]; p.cache_v = (const float*)d_in[7]; p.g_pre = (const float*)d_in[8]; p.w_in = (const float*)d_in[9]; p.conv_w = (const float*)d_in[10]; p.conv_b = (const float*)d_in[11];
    p.w_rg_a = (const float*)d_in[12]; p.b_rg_a = (const float*)d_in[13]; p.w_rg_x = (const float*)d_in[14]; p.b_rg_x = (const float*)d_in[15]; p.lam = (const float*)d_in[16]; p.w_pool = (const float*)d_in[17];
    p.pool_scale = (const float*)d_in[18]; p.g_mem = (const float*)d_in[19]; p.w_kv = (const float*)d_in[20]; p.w_branch = (const float*)d_in[21]; p.w_out = (const float*)d_in[22]; p.g_post = (const float*)d_in[23];
    p.out = (float*)d_out; p.ws = (unsigned char*)d_ws;
    if (hipMemsetAsync((char*)d_ws + WS_CTL, 0, CTL_ZERO_BYTES, stream) != hipSuccess) { fprintf(stderr, "kernel_launch: memset failed\n"); return; }
#if MK_N_LAUNCHES == 1
    p.ph_lo = 0; p.ph_hi = 6;
    void* args[] = {&p};
    hipError_t e = hipLaunchCooperativeKernel((const void*)fwd_kernel, dim3(grid), dim3(512), args, LDS_BYTES, stream);
    if (e != hipSuccess) fprintf(stderr, "kernel_launch: cooperative launch failed: %s (grid %d)\n", hipGetErrorString(e), grid);
#else
    for (int ph = 0; ph < 6; ++ph) { p.ph_lo = ph; p.ph_hi = ph + 1; hipLaunchKernelGGL(fwd_kernel, dim3(grid), dim3(512), LDS_BYTES, stream, p); }
#endif
}
```

```cpp
#include <hip/hip_runtime.h>
#include <hip/hip_cooperative_groups.h>
#include <cstdio>
#include <cstdint>
namespace cg = cooperative_groups;

#define LAS __attribute__((address_space(3)))
typedef unsigned short bf16_t;
typedef short bf16x8 __attribute__((ext_vector_type(8)));
typedef short bf16x4 __attribute__((ext_vector_type(4)));
typedef float f32x4 __attribute__((ext_vector_type(4)));
typedef float f32x2 __attribute__((ext_vector_type(2)));
typedef unsigned u32x4 __attribute__((ext_vector_type(4)));
typedef unsigned u32x2 __attribute__((ext_vector_type(2)));

#ifndef MK_N_LAUNCHES
#define MK_N_LAUNCHES 1
#endif
#ifndef CG_SEAM_MASK
#define CG_SEAM_MASK 0
#endif
#define USE_CG_SEAM(k) (((CG_SEAM_MASK) >> (k)) & 1)
#ifndef PROBE_REPEAT
#define PROBE_REPEAT -1
#endif

constexpr int DM = 2048, NBATCH = 4, SEQ = 2048, NS = 128;
constexpr int MP = NBATCH * SEQ;
constexpr int MTOT = MP + NS;
constexpr int MPAD = 8448;
constexpr int DIN = 12288, DMIX = 3072, NMEM = 256;
constexpr int ZC_XR = 0, ZC_GR = 1024, ZC_XP = 2048, ZC_GP = 3072, ZC_Q = 4096, ZC_GX = 5120, ZC_GT = 6144;
constexpr float EPS = 1e-6f;
constexpr float LOG2E = 1.4426950408889634f;

constexpr size_t OFF_Y = 0;
constexpr size_t OFF_NHP = 17039360, OFF_NCP = 17043456, OFF_NPP = 17055744, OFF_MEMK = 17117184, OFF_MEMV = 18165760;
constexpr size_t OFF_NHS = 19214336, OFF_NCS = 19345408, OFF_NPS = 19738624, OUT_TOTAL = 21704704;

constexpr size_t MiB = 1u << 20;
constexpr size_t WS_CTL = 0, WS_WINT = 1 * MiB, WS_WKVT = 49 * MiB, WS_WBT = 57 * MiB, WS_WOT = 69 * MiB, WS_WRGT = 77 * MiB, WS_WPT = 77 * MiB + 512 * 1024;
constexpr size_t WS_U = 78 * MiB, WS_MEMN = 111 * MiB, WS_KB = 115 * MiB, WS_VT = 117 * MiB, WS_Z = 119 * MiB, WS_OALL = 317 * MiB, WS_PART = 367 * MiB;
constexpr size_t WS_MERGED = 433 * MiB, WS_OUTB = 466 * MiB, WS_END = 500 * MiB;
constexpr size_t WS_GR = WS_CTL + 256 * 1024;
constexpr size_t CTL_ZERO_BYTES = 65536;
constexpr int LDS_BYTES = 147456;
constexpr int LDS_MISC_OFF = 147200;

struct Params {
    const float* x_prompt; const float* x_sample; const float* mem; const float* st_h; const float* st_conv; const float* st_pool;
    const float* cache_k; const float* cache_v; const float* g_pre; const float* w_in; const float* conv_w; const float* conv_b;
    const float* w_rg_a; const float* b_rg_a; const float* w_rg_x; const float* b_rg_x; const float* lam; const float* w_pool;
    const float* pool_scale; const float* g_mem; const float* w_kv; const float* w_branch; const float* w_out; const float* g_post;
    float* out; unsigned char* ws; int ph_lo, ph_hi;
};

__device__ __forceinline__ unsigned f2bf(float f) { unsigned u = __builtin_bit_cast(unsigned, f); return (u + 0x7fffu + ((u >> 16) & 1u)) >> 16; }
__device__ __forceinline__ unsigned pk2(float lo, float hi) { unsigned r; asm volatile("v_cvt_pk_bf16_f32 %0, %1, %2" : "=v"(r) : "v"(lo), "v"(hi)); return r; }
__device__ __forceinline__ float bf_lo(unsigned u) { return __builtin_bit_cast(float, u << 16); }
__device__ __forceinline__ float bf_hi(unsigned u) { return __builtin_bit_cast(float, u & 0xffff0000u); }
__device__ __forceinline__ float bf2f(bf16_t b) { return __builtin_bit_cast(float, ((unsigned)b) << 16); }
__device__ __forceinline__ unsigned cvt_pk_bf16(float lo, float hi) { unsigned r; asm volatile("v_cvt_pk_bf16_f32 %0, %1, %2" : "=v"(r) : "v"(lo), "v"(hi)); return r; }
__device__ __forceinline__ float wave_sum(float v) {
#pragma unroll
    for (int o = 1; o < 64; o <<= 1) v += __shfl_xor(v, o);
    return v;
}
__device__ __forceinline__ float wave_max(float v) {
#pragma unroll
    for (int o = 1; o < 64; o <<= 1) v = fmaxf(v, __shfl_xor(v, o));
    return v;
}
__device__ __forceinline__ float sigmoid_f(float x) { return __builtin_amdgcn_rcpf(1.0f + __builtin_amdgcn_exp2f(-x * LOG2E)); }
__device__ __forceinline__ float silu_f(float x) { return x * sigmoid_f(x); }


#define XB_TMO      128
#define XB_XCNT(j)  (256  + 64 * (j))
#define XB_XSUB(j)  (1280 + 64 * (j))
#define XB_XGEN(j)  (2304 + 64 * (j))
#define XB_TOP      3328
#define XB_TOPGEN   3392
#define XCD_BAR_WORDS 3456
#define XB_SPIN_CAP (1u << 18)
__device__ __forceinline__ unsigned xb_ld(unsigned* p)              { return __hip_atomic_load(p, __ATOMIC_RELAXED, __HIP_MEMORY_SCOPE_AGENT); }
__device__ __forceinline__ unsigned xb_add(unsigned* p, unsigned v) { return __hip_atomic_fetch_add(p, v, __ATOMIC_RELAXED, __HIP_MEMORY_SCOPE_AGENT); }
__device__ __forceinline__ unsigned xb_xcc_id() { return (unsigned)__builtin_amdgcn_s_getreg((3 << 11) | 20) & 0xFu; }
#define XB_SPIN(cond, bar) do { unsigned _sp = 0; while (cond) { __builtin_amdgcn_s_sleep(1); \
    if ((++_sp & 255u) == 0u) { if (xb_ld(&(bar)[XB_TMO])) break; if (_sp > XB_SPIN_CAP) { atomicAdd(&(bar)[XB_TMO], 1u); break; } } } } while (0)
struct XcdBarrier { unsigned* bar; unsigned x; volatile LAS unsigned* st; };
__device__ __forceinline__ XcdBarrier xcd_barrier_post(unsigned* bar, volatile LAS unsigned* st) {
    XcdBarrier b; b.bar = bar; b.x = xb_xcc_id(); b.st = st;
    if (threadIdx.x == 0) (void)xb_add(&bar[XB_XCNT(b.x)], 1u);
    return b;
}
__device__ __forceinline__ void xcd_barrier_complete(unsigned* bar, unsigned x, unsigned& nloc, unsigned& nx) {
    const unsigned G = gridDim.x * gridDim.y * gridDim.z;
    unsigned sum, cnt, mine, sp = 0u;
    for (;;) {
        sum = 0u; cnt = 0u; mine = 0u;
#pragma unroll
        for (unsigned j = 0; j < 16; ++j) { const unsigned c = xb_ld(&bar[XB_XCNT(j)]); sum += c; cnt += (c > 0u) ? 1u : 0u; mine = (j == x) ? c : mine; }
        if (sum == G) break;
        __builtin_amdgcn_s_sleep(1);
        if ((++sp & 255u) == 0u) { if (xb_ld(&bar[XB_TMO])) break; if (sp > XB_SPIN_CAP) { atomicAdd(&bar[XB_TMO], 1u); break; } }
    }
    nloc = mine > 0u ? mine : 1u; nx = cnt > 0u ? cnt : 1u;
}
__device__ __forceinline__ void xcd_barrier(const XcdBarrier& b) {
    asm volatile("s_waitcnt vmcnt(0)" ::: "memory");
    __syncthreads();
    if (threadIdx.x == 0) {
        unsigned* bar = b.bar;
        __builtin_amdgcn_s_waitcnt(0);
        unsigned nloc = b.st[0], nx = b.st[1];
        if (nloc == 0u) { xcd_barrier_complete(bar, b.x, nloc, nx); b.st[0] = nloc; b.st[1] = nx; }
        const unsigned old = xb_add(&bar[XB_XSUB(b.x)], 1u);
        const unsigned gen = old / nloc;
        if (old + 1u == (gen + 1u) * nloc) {
            __builtin_amdgcn_fence(__ATOMIC_RELEASE, "agent");
            asm volatile("s_waitcnt vmcnt(0)" ::: "memory");
            const unsigned og = xb_add(&bar[XB_TOP], 1u);
            const unsigned tg = og / nx;
            if (og + 1u == (tg + 1u) * nx) xb_add(&bar[XB_TOPGEN], 1u);
            else XB_SPIN(xb_ld(&bar[XB_TOPGEN]) == tg, bar);
            __builtin_amdgcn_fence(__ATOMIC_ACQUIRE, "agent");
            xb_add(&bar[XB_XGEN(b.x)], 1u);
            asm volatile("s_waitcnt vmcnt(0)" ::: "memory");
        } else {
            XB_SPIN(xb_ld(&bar[XB_XGEN(b.x)]) == gen, bar);
            __builtin_amdgcn_fence(__ATOMIC_ACQUIRE, "agent");
            asm volatile("s_waitcnt vmcnt(0)" ::: "memory");
        }
    }
    __syncthreads();
}

namespace pg8 {
constexpr int BM = 256, BK = 64, HALF = 128, HTB = HALF * BK * 2, STAGE_BYTES = 8 * HTB, NXCD = 8, WGM = 4;
__device__ __forceinline__ int lds_byte(int r, int c) { const int st = (r >> 4) * 2 + (c >> 5), rr = r & 15, cc = c & 31, ob = rr * 64 + cc * 2; return st * 1024 + (ob ^ (((ob >> 9) & 1) << 5)); }
__device__ __forceinline__ void stage_rc(int b, int& R, int& C) { const int st = b / 1024, sb = b % 1024, swz = sb ^ (((sb >> 9) & 1) << 5); R = (st >> 1) * 16 + swz / 64; C = (st & 1) * 32 + (swz % 64) / 2; }
__device__ __forceinline__ int perm32(int rho) { const int n = rho >> 4, i = rho & 15; return 8 * (i >> 2) + 4 * n + (i & 3); }

struct Unit { const char* A; const char* B; int pm, pn, kind, aux, nt, half, ks, grp; };
struct TileOrder {
    int nM, nN, nwg;
    __device__ __forceinline__ void init(int nM_, int nN_) { nM = nM_; nN = nN_; nwg = nM_ * nN_; }
    __device__ __forceinline__ void map(int L, int& pm, int& pn) const {
        int wgid = L; { const int q = nwg / NXCD, r = nwg % NXCD, xcd = wgid % NXCD, off = wgid / NXCD; wgid = (xcd < r ? xcd * (q + 1) : r * (q + 1) + (xcd - r) * q) + off; }
        const int nig = WGM * nN, gid = wgid / nig, fm = gid * WGM, gsz = (nM - fm) < WGM ? (nM - fm) : WGM;
        pm = fm + ((wgid % nig) % gsz); pn = (wgid % nig) / gsz;
    }
};

template <class Epi, class Sched>
__device__ __forceinline__ void gemm_phase(LAS unsigned char* lds, const int lda, const int ldb, const Sched& S, const Epi& E) {
    const int tid = threadIdx.x, wid = __builtin_amdgcn_readfirstlane(tid >> 6), lane = tid & 63, wr = wid >> 2, wc = wid & 3, fr = lane & 15, fq = lane >> 4;
    unsigned voffA[2], voffB[2];
#pragma unroll
    for (int i = 0; i < 2; ++i) { int R, C; stage_rc(tid * 16 + i * 8192, R, C); const int Rb = (R & ~31) + perm32(R & 31);
        voffA[i] = (unsigned)(R * lda + C) * 2u; voffB[i] = (unsigned)(Rb * ldb + C) * 2u; }
    const size_t kstep = (size_t)(BK * 2);
    const size_t hstepA = (size_t)HALF * lda * 2, hstepB = (size_t)HALF * ldb * 2;
    const unsigned ldsw = (unsigned)wid * 1024u;
    const int aoff = lds_byte(wr * 64 + fr, fq * 8), boff = lds_byte(wc * 32 + fr, fq * 8);
#define PG8_SA(b, h) (((b) * 2 + (h)) * HTB)
#define PG8_SB(b, h) ((4 + (b) * 2 + (h)) * HTB)
#define PG8_STAGE(bufoff, gbase, voff) do { _Pragma("unroll") for (int _i = 0; _i < 2; ++_i) \
        __builtin_amdgcn_global_load_lds((const unsigned*)((const char*)(gbase) + (voff)[_i]), (LAS unsigned*)(lds + (bufoff) + ldsw + _i * 8192), 16, 0, 0); } while (0)
#define PG8_LDA(dst, b, h) do { _Pragma("unroll") for (int m = 0; m < 4; ++m) _Pragma("unroll") for (int k = 0; k < 2; ++k) dst[m][k] = *(const LAS bf16x8*)(lds + PG8_SA(b, h) + aoff + m * 2048 + k * 1024); } while (0)
#define PG8_LDB(dst, b, h) do { _Pragma("unroll") for (int n = 0; n < 2; ++n) _Pragma("unroll") for (int k = 0; k < 2; ++k) dst[n][k] = *(const LAS bf16x8*)(lds + PG8_SB(b, h) + boff + n * 2048 + k * 1024); } while (0)
#define PG8_MMA(ai, bj, At, Bt) do { __builtin_amdgcn_s_setprio(1); _Pragma("unroll") for (int m = 0; m < 4; ++m) _Pragma("unroll") for (int n = 0; n < 2; ++n) _Pragma("unroll") for (int k = 0; k < 2; ++k) \
        acc[ai][bj][m][n] = __builtin_amdgcn_mfma_f32_16x16x32_bf16(Bt[n][k], At[m][k], acc[ai][bj][m][n], 0, 0, 0); __builtin_amdgcn_s_setprio(0); } while (0)
#define PG8_WAIT_V(n) asm volatile("s_waitcnt vmcnt(" #n ")" ::: "memory")
#define PG8_WAIT_L(n) asm volatile("s_waitcnt lgkmcnt(" #n ")" ::: "memory")
#define PG8_BAR __builtin_amdgcn_s_barrier()
#define PG8_SCHED __builtin_amdgcn_sched_barrier(0)
    Unit cur, nxt; int ui = 0;
    if (!S.next(0, cur)) return;
    f32x4 acc[2][2][4][2];
#pragma unroll
    for (int a = 0; a < 2; ++a)
#pragma unroll
        for (int b = 0; b < 2; ++b)
#pragma unroll
            for (int m = 0; m < 4; ++m)
#pragma unroll
                for (int n = 0; n < 2; ++n) acc[a][b][m][n] = (f32x4){0.f, 0.f, 0.f, 0.f};
    bf16x8 At[4][2], B0[2][2], B1[2][2];
    const char* cA = cur.A; const char* cB = cur.B;
    PG8_STAGE(PG8_SB(0, 0), cB, voffB); PG8_STAGE(PG8_SB(0, 1), cB + hstepB, voffB); PG8_STAGE(PG8_SA(0, 0), cA, voffA); PG8_STAGE(PG8_SA(0, 1), cA + hstepA, voffA);
    if (wr == 1) PG8_BAR;
    PG8_WAIT_V(2); PG8_BAR;
    PG8_STAGE(PG8_SB(1, 0), cB + kstep, voffB); PG8_STAGE(PG8_SA(1, 0), cA + kstep, voffA); PG8_STAGE(PG8_SB(1, 1), cB + hstepB + kstep, voffB);
    PG8_WAIT_V(6); PG8_BAR;
    for (;;) {
        const bool has_next = S.next(ui + 1, nxt);
        const char* nA = has_next ? nxt.A : cA; const char* nB = has_next ? nxt.B : cB;
        const int nt = cur.nt; const bool full = (cur.half == 0);
        for (int t = 0; t < nt; t += 2) {
            const bool last = (t == nt - 2);
            if (last && has_next) S.a_ready(nxt);
            const char* a1 = cA + (size_t)(t + 1) * kstep;
            const char* a2 = last ? nA : cA + (size_t)(t + 2) * kstep; const char* b2 = last ? nB : cB + (size_t)(t + 2) * kstep;
            const char* a3 = a2 + kstep; const char* b3 = b2 + kstep;
            PG8_LDB(B0, 0, 0); PG8_LDB(B1, 0, 1); PG8_SCHED; PG8_LDA(At, 0, 0); PG8_STAGE(PG8_SA(1, 1), a1 + hstepA, voffA);
            PG8_WAIT_V(8); PG8_WAIT_L(0); PG8_BAR; PG8_MMA(0, 0, At, B0); PG8_MMA(0, 1, At, B1); PG8_BAR; PG8_SCHED;
            PG8_LDA(At, 0, 1); PG8_STAGE(PG8_SB(0, 0), b2, voffB); PG8_STAGE(PG8_SB(0, 1), b2 + hstepB, voffB); PG8_STAGE(PG8_SA(0, 0), a2, voffA);
            PG8_WAIT_V(8); PG8_WAIT_L(0); PG8_BAR; if (full) { PG8_MMA(1, 0, At, B0); PG8_MMA(1, 1, At, B1); } PG8_BAR; PG8_SCHED;
            PG8_LDB(B0, 1, 0); PG8_LDB(B1, 1, 1); PG8_SCHED; PG8_LDA(At, 1, 0); PG8_STAGE(PG8_SA(0, 1), a2 + hstepA, voffA);
            PG8_WAIT_V(8); PG8_WAIT_L(0); PG8_BAR; PG8_MMA(0, 0, At, B0); PG8_MMA(0, 1, At, B1); PG8_BAR; PG8_SCHED;
            PG8_LDA(At, 1, 1); PG8_STAGE(PG8_SB(1, 0), b3, voffB); PG8_STAGE(PG8_SB(1, 1), b3 + hstepB, voffB); PG8_STAGE(PG8_SA(1, 0), a3, voffA);
            PG8_WAIT_V(8); PG8_WAIT_L(0); PG8_BAR; if (full) { PG8_MMA(1, 0, At, B0); PG8_MMA(1, 1, At, B1); } PG8_BAR; PG8_SCHED;
        }
        if (wr == 0) PG8_BAR;
        E(acc, cur, wr, wc, fr, fq);
        if (!has_next) break;
#pragma unroll
        for (int a = 0; a < 2; ++a)
#pragma unroll
            for (int b = 0; b < 2; ++b)
#pragma unroll
                for (int m = 0; m < 4; ++m)
#pragma unroll
                    for (int n = 0; n < 2; ++n) acc[a][b][m][n] = (f32x4){0.f, 0.f, 0.f, 0.f};
        cur = nxt; cA = nA; cB = nB; ++ui;
        if (wr == 1) PG8_BAR;
    }
    PG8_WAIT_V(0);
    PG8_BAR;
#undef PG8_SA
#undef PG8_SB
#undef PG8_STAGE
#undef PG8_LDA
#undef PG8_LDB
#undef PG8_MMA
#undef PG8_WAIT_V
#undef PG8_WAIT_L
#undef PG8_BAR
#undef PG8_SCHED
}
}

constexpr int SLAB_FLOATS = 32 * 512 * 4;
constexpr int CW_CNT = 4096;
constexpr int CNT_P1S = 0, CNT_P1KV = 48, CNT_P3S = 80, CNT_P4S = 88;
constexpr int CW_DONE4 = 10240;
constexpr int CW_DONE = 13312;
template <int NSL, bool HALF, int KS>
__device__ __forceinline__ unsigned share_body(f32x4 (&acc)[2][2][4][2], const float* slabs, int tid) {
    unsigned mask = 0;
    const f32x4* p0 = (const f32x4*)slabs + tid;
#pragma unroll
    for (int c = 0; c < (HALF ? 8 : 16); ++c) { if (c % NSL != KS) continue;
        const int ai = c >> 3, bj = (c >> 2) & 1, m = c & 3; mask |= 1u << c;
#pragma unroll
        for (int s = 0; s < NSL; ++s) { if (s == KS) continue;
            acc[ai][bj][m][0] += p0[(size_t)s * (SLAB_FLOATS / 4) + (size_t)(c * 2 + 0) * 512]; acc[ai][bj][m][1] += p0[(size_t)s * (SLAB_FLOATS / 4) + (size_t)(c * 2 + 1) * 512]; }
        asm volatile("" ::: "memory"); }
    return mask;
}
template <int NSL, bool HALF>
__device__ __forceinline__ unsigned splitk_share(f32x4 (&acc)[2][2][4][2], float* slabs, int ks, unsigned* cnt, volatile LAS unsigned* misc) {
    int tid_ = threadIdx.x; asm volatile("" : "+v"(tid_));
    const int tid = tid_;
    {
      const unsigned long long pa = (unsigned long long)(slabs + (size_t)ks * SLAB_FLOATS);
      const unsigned plo = __builtin_amdgcn_readfirstlane((unsigned)pa), phi = __builtin_amdgcn_readfirstlane((unsigned)(pa >> 32));
      const __amdgpu_buffer_rsrc_t rs = __builtin_amdgcn_make_buffer_rsrc((void*)(((unsigned long long)phi << 32) | plo), (short)0, SLAB_FLOATS * 4, 0x00020000);
#pragma unroll
      for (int ai = 0; ai < (HALF ? 1 : 2); ++ai)
#pragma unroll
          for (int bj = 0; bj < 2; ++bj)
#pragma unroll
              for (int m = 0; m < 4; ++m)
#pragma unroll
                  for (int n = 0; n < 2; ++n) __builtin_amdgcn_raw_buffer_store_b128(__builtin_bit_cast(u32x4, acc[ai][bj][m][n]), rs, (unsigned)tid * 16u, ((((ai * 2 + bj) * 4 + m) * 2 + n) * 512) * 16, 16); }
    asm volatile("s_waitcnt vmcnt(0)" ::: "memory");
    __syncthreads();
    if (tid == 0) {
        (void)__hip_atomic_fetch_add(cnt, 1u, __ATOMIC_RELAXED, __HIP_MEMORY_SCOPE_AGENT);
        unsigned spins = 0;
        if (ks < (HALF ? 8 : 16))
        while (__hip_atomic_load(cnt, __ATOMIC_RELAXED, __HIP_MEMORY_SCOPE_AGENT) < (unsigned)NSL) { __builtin_amdgcn_s_sleep(2); if (++spins > (1u << 21)) break; }
        __builtin_amdgcn_fence(__ATOMIC_ACQUIRE, "agent"); asm volatile("s_waitcnt vmcnt(0)" ::: "memory");
    }
    __syncthreads();
    unsigned mask = 0;
    if (NSL >= 1 && ks == 0) mask = share_body<NSL, HALF, 0>(acc, slabs, tid);
    if (NSL >= 2 && ks == 1) mask = share_body<NSL, HALF, (NSL >= 2 ? 1 : 0)>(acc, slabs, tid);
    if (NSL >= 3 && ks == 2) mask = share_body<NSL, HALF, (NSL >= 3 ? 2 : 0)>(acc, slabs, tid);
    if (NSL >= 4 && ks == 3) mask = share_body<NSL, HALF, (NSL >= 4 ? 3 : 0)>(acc, slabs, tid);
    if (NSL >= 5 && ks == 4) mask = share_body<NSL, HALF, (NSL >= 5 ? 4 : 0)>(acc, slabs, tid);
    if (NSL >= 6 && ks == 5) mask = share_body<NSL, HALF, (NSL >= 6 ? 5 : 0)>(acc, slabs, tid);
    if (NSL >= 7 && ks == 6) mask = share_body<NSL, HALF, (NSL >= 7 ? 6 : 0)>(acc, slabs, tid);
    if (NSL >= 8 && ks == 7) mask = share_body<NSL, HALF, (NSL >= 8 ? 7 : 0)>(acc, slabs, tid);
    return mask;
}

__device__ __forceinline__ void publish_count(unsigned* ctr) {
    asm volatile("s_waitcnt vmcnt(0)" ::: "memory"); __syncthreads();
    if (threadIdx.x == 0) { __builtin_amdgcn_fence(__ATOMIC_RELEASE, "agent"); asm volatile("s_waitcnt vmcnt(0)" ::: "memory"); __hip_atomic_fetch_add(ctr, 1u, __ATOMIC_RELAXED, __HIP_MEMORY_SCOPE_AGENT); }
}
__device__ __forceinline__ void publish_count_wt(unsigned* ctr) {
    asm volatile("s_waitcnt vmcnt(0)" ::: "memory"); __syncthreads();
    if (threadIdx.x == 0) __hip_atomic_fetch_add(ctr, 1u, __ATOMIC_RELAXED, __HIP_MEMORY_SCOPE_AGENT);
}
__device__ __forceinline__ void poll_count(unsigned* ctr, unsigned need) {
    unsigned spins = 0;
    while (__hip_atomic_load(ctr, __ATOMIC_RELAXED, __HIP_MEMORY_SCOPE_AGENT) < need) { __builtin_amdgcn_s_sleep(4); if (++spins > (1u << 21)) break; }
    __builtin_amdgcn_fence(__ATOMIC_ACQUIRE, "agent"); asm volatile("s_waitcnt vmcnt(0)" ::: "memory");
}

struct SchedP1 {
    int mode; int G, c; pg8::TileOrder to; const char* U; const char* WinT; const char* MEMN; const char* WkvT;
    __device__ __forceinline__ void a_ready(const pg8::Unit&) const {}
    __device__ __forceinline__ bool next(int i, pg8::Unit& u) const {
        const int L = i * G + c;
        int e;
        if (mode == 1) e = L;
        else { if (L < 32 * 48) { int pm, pn; to.map(L, pm, pn); u.A = U + (size_t)pm * 256 * 2048 * 2; u.B = WinT + (size_t)pn * 256 * 2048 * 2; u.pm = pm; u.pn = pn; u.kind = 0; u.nt = 32; u.half = 0; u.ks = 0; u.grp = 0; return true; }
            if (mode == 0) return false;
            e = L - 32 * 48; }
        if (e >= 80) return false;
        u.nt = 32; u.ks = 0; u.grp = 0;
        if (e < 32) { const int pm = e & 3, pn = e >> 2;
            u.A = MEMN + (size_t)pm * 256 * 2048 * 2; u.B = WkvT + (size_t)pn * 256 * 2048 * 2; u.pm = pm; u.pn = pn; u.kind = 2; u.half = 0; }
        else { const int t = e - 32;
            u.A = U + (size_t)32 * 256 * 2048 * 2; u.B = WinT + (size_t)t * 256 * 2048 * 2; u.pm = 32; u.pn = t; u.kind = 1; u.half = 1; }
        return true;
    }
};
template <bool EXTRA>
struct EpiP1T {
    bf16_t* Z; float* out; bf16_t* KB; bf16_t* VT; float* slabs; unsigned* cnt; volatile LAS unsigned* misc; unsigned* done;
    __device__ __forceinline__ void publish(int which) const {
        asm volatile("s_waitcnt vmcnt(0)" ::: "memory"); __syncthreads();
        if (threadIdx.x == 0) { __builtin_amdgcn_fence(__ATOMIC_RELEASE, "agent"); asm volatile("s_waitcnt vmcnt(0)" ::: "memory"); __hip_atomic_fetch_add(done + 64 * which, 1u, __ATOMIC_RELAXED, __HIP_MEMORY_SCOPE_AGENT); }
    }
    __device__ __forceinline__ void operator()(f32x4 (&acc)[2][2][4][2], const pg8::Unit& u, int wr, int wc, int fr, int fq) const {
        const int row0 = u.pm * 256 + wr * 64 + fr, col0 = u.pn * 256 + wc * 32 + 8 * fq;
        unsigned cm = 0xffffu;

        if (!EXTRA || u.kind != 2) {
            const int seg = u.pn >> 2;
            const int act = (seg >= 6) ? 2 : ((seg & 1) ? 1 : 0);
#pragma unroll
            for (int ai = 0; ai < 2; ++ai) { if (ai == 1 && u.half) break;
#pragma unroll
                for (int m = 0; m < 4; ++m) { bf16_t* rowp = Z + (size_t)(row0 + ai * 128 + m * 16) * DIN + col0;
#pragma unroll
                    for (int bj = 0; bj < 2; ++bj) { if (EXTRA && !((cm >> ((ai * 2 + bj) * 4 + m)) & 1u)) continue;
                        f32x4 v0 = acc[ai][bj][m][0], v1 = acc[ai][bj][m][1];
                        if (act == 1) {
#pragma unroll
                            for (int j = 0; j < 4; ++j) { v0[j] = silu_f(v0[j]); v1[j] = silu_f(v1[j]); } }
                        else if (act == 2) {
#pragma unroll
                            for (int j = 0; j < 4; ++j) { v0[j] = sigmoid_f(v0[j]); v1[j] = sigmoid_f(v1[j]); } }
                        u32x4 w; w.x = cvt_pk_bf16(v0[0], v0[1]); w.y = cvt_pk_bf16(v0[2], v0[3]); w.z = cvt_pk_bf16(v1[0], v1[1]); w.w = cvt_pk_bf16(v1[2], v1[3]);
                        __builtin_nontemporal_store(w, (u32x4*)(rowp + bj * 128)); } } }
            if (EXTRA) publish(1);
        } else {
            const bool isV = u.pn >= 4;
            const int c0 = isV ? col0 - 1024 : col0;
            float* ob = out + (isV ? OFF_MEMV : OFF_MEMK);
#pragma unroll
            for (int ai = 0; ai < 2; ++ai)
#pragma unroll
                for (int m = 0; m < 4; ++m) { const int row = row0 + ai * 128 + m * 16;
#pragma unroll
                    for (int bj = 0; bj < 2; ++bj) { if (!((cm >> ((ai * 2 + bj) * 4 + m)) & 1u)) continue;
                        const f32x4 v0 = acc[ai][bj][m][0], v1 = acc[ai][bj][m][1]; const int col = c0 + bj * 128;
                        __builtin_nontemporal_store(v0, (f32x4*)(ob + (size_t)row * 1024 + col)); __builtin_nontemporal_store(v1, (f32x4*)(ob + (size_t)row * 1024 + col + 4));
                        if (!isV) { u32x4 w; w.x = cvt_pk_bf16(v0[0], v0[1]); w.y = cvt_pk_bf16(v0[2], v0[3]); w.z = cvt_pk_bf16(v1[0], v1[1]); w.w = cvt_pk_bf16(v1[2], v1[3]);
                            *(u32x4*)(KB + (size_t)row * 1024 + col) = w; }
                        else {
#pragma unroll
                            for (int j = 0; j < 4; ++j) { VT[(size_t)(col + j) * 1024 + row] = (bf16_t)f2bf(v0[j]); VT[(size_t)(col + 4 + j) * 1024 + row] = (bf16_t)f2bf(v1[j]); } } } }
            publish(0);
        }
    }
};
__device__ __forceinline__ void wait_done(unsigned* done) {
    if (threadIdx.x == 0) { unsigned spins = 0;
        while (__hip_atomic_load(done, __ATOMIC_RELAXED, __HIP_MEMORY_SCOPE_AGENT) < 32u || __hip_atomic_load(done + 64, __ATOMIC_RELAXED, __HIP_MEMORY_SCOPE_AGENT) < 48u) { __builtin_amdgcn_s_sleep(8); if (++spins > (1u << 21)) break; }
        __builtin_amdgcn_fence(__ATOMIC_ACQUIRE, "agent"); asm volatile("s_waitcnt vmcnt(0)" ::: "memory"); }
    __syncthreads();
}
struct SchedP3 {
    int G, c; pg8::TileOrder to; const char* OALL; const char* WbT;
    __device__ __forceinline__ void a_ready(const pg8::Unit&) const {}
    __device__ __forceinline__ bool next(int i, pg8::Unit& u) const {
        const int nmine = (32 * 8 - c + G - 1) / G;
        int e = 96;
        if (G == 256) {
            int qm, qn; to.map(c, qm, qn);
            if (qm < 12) { if (i == 0) e = qm * 8 + qn; else i -= 1; }
        }
        if (e >= 96 && i < 3 * nmine) { const int ti = i / 3, j = i - 3 * ti; const int L = ti * G + c;
            int pm, pn; to.map(L, pm, pn);
            u.A = OALL + ((size_t)pm * 256 * DMIX + (size_t)j * 1024) * 2; u.B = WbT + ((size_t)pn * 256 * DMIX + (size_t)j * 1024) * 2; u.pm = pm; u.pn = pn; u.kind = 0; u.aux = j; u.nt = 16; u.half = 0; u.ks = 0; u.grp = 0; return true; }
        if (G != 256) e = (i - 3 * nmine) * G + c;
        if (e >= 96) return false;
        const int pn = e / 12, r = e - 12 * pn, j = r >> 2, k4 = r & 3;
        u.A = OALL + ((size_t)32 * 256 * DMIX + (size_t)j * 1024 + (size_t)k4 * 256) * 2; u.B = WbT + ((size_t)pn * 256 * DMIX + (size_t)j * 1024 + (size_t)k4 * 256) * 2;
        u.pm = 32; u.pn = pn; u.kind = 1; u.aux = j; u.nt = 4; u.half = 1; u.ks = r; u.grp = pn; return true;
    }
};
struct EpiP3 {
    const bf16_t* Z; bf16_t* PART; bf16_t* MERGED; float* slabs; unsigned* cnt; volatile LAS unsigned* misc; unsigned* done3;
    __device__ __forceinline__ void operator()(f32x4 (&acc)[2][2][4][2], const pg8::Unit& u, int wr, int wc, int fr, int fq) const {
        const int row0 = u.pm * 256 + wr * 64 + fr, col0 = u.pn * 256 + wc * 32 + 8 * fq, j = u.aux;
        if (u.kind == 0) {
            const __amdgpu_buffer_rsrc_t mrs = __builtin_amdgcn_make_buffer_rsrc((void*)MERGED, (short)0, (int)((size_t)MPAD * DM * 2), 0x00020000);
#pragma unroll
            for (int ai = 0; ai < 2; ++ai) {
                u32x4 g[4][2], pp[4][2];
#pragma unroll
                for (int m = 0; m < 4; ++m)
#pragma unroll
                    for (int bj = 0; bj < 2; ++bj) g[m][bj] = __builtin_nontemporal_load((const u32x4*)(Z + (size_t)(row0 + ai * 128 + m * 16) * DIN + ZC_GT + j * DM + col0 + bj * 128));
#pragma unroll
                for (int m = 0; m < 4; ++m)
#pragma unroll
                    for (int bj = 0; bj < 2; ++bj) { pp[m][bj] = (u32x4){0u, 0u, 0u, 0u}; if (j > 0) pp[m][bj] = *(const u32x4*)(PART + (size_t)(row0 + ai * 128 + m * 16) * DM + col0 + bj * 128); }
#pragma unroll
                for (int m = 0; m < 4; ++m) { const size_t row = (size_t)(row0 + ai * 128 + m * 16);
#pragma unroll
                    for (int bj = 0; bj < 2; ++bj) { const int col = col0 + bj * 128;
                        const u32x4 gg = g[m][bj], q = pp[m][bj];
                        f32x4 p0 = (f32x4){bf_lo(q.x), bf_hi(q.x), bf_lo(q.y), bf_hi(q.y)}, p1 = (f32x4){bf_lo(q.z), bf_hi(q.z), bf_lo(q.w), bf_hi(q.w)};
                        const f32x4 a0 = acc[ai][bj][m][0], a1 = acc[ai][bj][m][1];
                        p0[0] += bf_lo(gg.x) * a0[0]; p0[1] += bf_hi(gg.x) * a0[1]; p0[2] += bf_lo(gg.y) * a0[2]; p0[3] += bf_hi(gg.y) * a0[3];
                        p1[0] += bf_lo(gg.z) * a1[0]; p1[1] += bf_hi(gg.z) * a1[1]; p1[2] += bf_lo(gg.w) * a1[2]; p1[3] += bf_hi(gg.w) * a1[3];
                        u32x4 w; w.x = cvt_pk_bf16(p0[0], p0[1]); w.y = cvt_pk_bf16(p0[2], p0[3]); w.z = cvt_pk_bf16(p1[0], p1[1]); w.w = cvt_pk_bf16(p1[2], p1[3]);
                        if (j < 2) *(u32x4*)(PART + row * DM + col) = w;
                        else __builtin_amdgcn_raw_buffer_store_b128(w, mrs, (unsigned)(row * DM + col) * 2u, 0, 16); } }
            }
            if (j == 2) publish_count_wt(done3 + 64 * u.pm);
        } else {
#pragma unroll
            for (int m = 0; m < 4; ++m) { const size_t row = (size_t)(row0 + m * 16);
#pragma unroll
                for (int bj = 0; bj < 2; ++bj) { const int col = col0 + bj * 128;
                    const u32x4 g = __builtin_nontemporal_load((const u32x4*)(Z + row * DIN + ZC_GT + j * DM + col));
                    f32x4& a0 = acc[0][bj][m][0]; f32x4& a1 = acc[0][bj][m][1];
                    a0[0] *= bf_lo(g.x); a0[1] *= bf_hi(g.x); a0[2] *= bf_lo(g.y); a0[3] *= bf_hi(g.y);
                    a1[0] *= bf_lo(g.z); a1[1] *= bf_hi(g.z); a1[2] *= bf_lo(g.w); a1[3] *= bf_hi(g.w); } }
            const __amdgpu_buffer_rsrc_t mrs2 = __builtin_amdgcn_make_buffer_rsrc((void*)MERGED, (short)0, (int)((size_t)MPAD * DM * 2), 0x00020000);
            const unsigned cm = splitk_share<12, true>(acc, slabs + (size_t)u.grp * 12 * SLAB_FLOATS, u.ks, cnt + 64 * u.grp, misc);
#pragma unroll
            for (int m = 0; m < 4; ++m) { const size_t row = (size_t)(row0 + m * 16);
#pragma unroll
                for (int bj = 0; bj < 2; ++bj) { if (!((cm >> (bj * 4 + m)) & 1u)) continue;
                    const int col = col0 + bj * 128; const f32x4 p0 = acc[0][bj][m][0], p1 = acc[0][bj][m][1];
                    u32x4 w; w.x = cvt_pk_bf16(p0[0], p0[1]); w.y = cvt_pk_bf16(p0[2], p0[3]); w.z = cvt_pk_bf16(p1[0], p1[1]); w.w = cvt_pk_bf16(p1[2], p1[3]);
                    __builtin_amdgcn_raw_buffer_store_b128(w, mrs2, (unsigned)(row * DM + col) * 2u, 0, 16); } }
            publish_count_wt(done3 + 64 * 32);
        }
    }
};
struct SchedP4 {
    int G, c; pg8::TileOrder to; const char* MERGED; const char* WoT; unsigned* done3;
    __device__ __forceinline__ bool next(int i, pg8::Unit& u) const {
        int e = -1;
        if (G == 256) {
            int qm, qn; to.map(c, qm, qn);
            if (qm >= 12 && qm < 16) { if (i == 0) e = (qm - 12) * 8 + qn; else i -= 1; }
        }
        const int L = i * G + c;
        if (e < 0 && L < 32 * 8) { int pm, pn; to.map(L, pm, pn);
            u.A = MERGED + (size_t)pm * 256 * DM * 2; u.B = WoT + (size_t)pn * 256 * DM * 2; u.pm = pm; u.pn = pn; u.kind = 0; u.aux = 0; u.nt = 32; u.half = 0; u.ks = 0; u.grp = 0; return true; }
        if (G != 256) e = L - 32 * 8 - 48;
        if (e < 0 || e >= 32) return false;
        const int pn = e >> 2, ks = e & 3;
        u.A = MERGED + ((size_t)32 * 256 * DM + (size_t)ks * 512) * 2; u.B = WoT + ((size_t)pn * 256 * DM + (size_t)ks * 512) * 2; u.pm = 32; u.pn = pn; u.kind = 1; u.aux = 0; u.nt = 8; u.half = 1; u.ks = ks; u.grp = pn; return true;
    }
    __device__ __forceinline__ void a_ready(const pg8::Unit& n) const {
        if (threadIdx.x == 0) poll_count(done3 + 64 * n.pm, n.kind == 0 ? 8u : 96u);
        asm volatile("" ::: "memory"); __builtin_amdgcn_s_barrier(); asm volatile("" ::: "memory");
    }
};
struct EpiP4 {
    bf16_t* OUTF; float* slabs; unsigned* cnt; volatile LAS unsigned* misc; unsigned* done4;
    __device__ __forceinline__ void operator()(f32x4 (&acc)[2][2][4][2], const pg8::Unit& u, int wr, int wc, int fr, int fq) const {
        const int row0 = u.pm * 256 + wr * 64 + fr, col0 = u.pn * 256 + wc * 32 + 8 * fq;
        const __amdgpu_buffer_rsrc_t ors = __builtin_amdgcn_make_buffer_rsrc((void*)OUTF, (short)0, (int)((size_t)MPAD * DM * 2), 0x00020000);
        unsigned cm = 0xffffu;
        if (u.kind != 0) cm = splitk_share<4, true>(acc, slabs + (size_t)u.grp * 4 * SLAB_FLOATS, u.ks, cnt + 64 * u.grp, misc);
#pragma unroll
        for (int ai = 0; ai < 2; ++ai) { if (ai == 1 && u.half) break;
#pragma unroll
            for (int m = 0; m < 4; ++m) { const unsigned ooff = (unsigned)((row0 + ai * 128 + m * 16) * DM + col0) * 2u;
#pragma unroll
                for (int bj = 0; bj < 2; ++bj) { if (!((cm >> ((ai * 2 + bj) * 4 + m)) & 1u)) continue;
                    const f32x4 v0 = acc[ai][bj][m][0], v1 = acc[ai][bj][m][1];
                    u32x4 w; w.x = cvt_pk_bf16(v0[0], v0[1]); w.y = cvt_pk_bf16(v0[2], v0[3]); w.z = cvt_pk_bf16(v1[0], v1[1]); w.w = cvt_pk_bf16(v1[2], v1[3]);
                    __builtin_amdgcn_raw_buffer_store_b128(w, ors, ooff, bj * 256, 16); } } }
        publish_count_wt(done4 + 64 * u.pm);
    }
};

__device__ __forceinline__ void p0_transpose_item(const float* W, int N, bf16_t* WT, int ldt, LAS float* scr, int kb, int nb, int lane) {
    const int k0 = 64 * kb, n0 = 64 * nb;
    f32x4 v[16];
#pragma unroll
    for (int i = 0; i < 16; ++i) { const int idx = lane + 64 * i; v[i] = __builtin_nontemporal_load((const f32x4*)(W + (size_t)(k0 + (idx >> 4)) * N + n0 + 4 * (idx & 15))); }
#pragma unroll
    for (int i = 0; i < 16; ++i) { const int idx = lane + 64 * i, kr = idx >> 4; *(LAS f32x4*)(scr + kr * 68 + ((4 * (idx & 15)) ^ (((kr >> 3) & 3) << 3))) = v[i]; }
    asm volatile("s_waitcnt lgkmcnt(0)" ::: "memory");
    const int c = lane & 7;
#pragma unroll
    for (int j = 0; j < 8; ++j) { const int n = (lane >> 3) + 8 * j; const LAS float* s = scr + (8 * c) * 68 + (n ^ ((c & 3) << 3));
        u32x4 o; o.x = pk2(s[0 * 68], s[1 * 68]); o.y = pk2(s[2 * 68], s[3 * 68]); o.z = pk2(s[4 * 68], s[5 * 68]); o.w = pk2(s[6 * 68], s[7 * 68]);
        *(u32x4*)(WT + (size_t)(n0 + n) * ldt + k0 + 8 * c) = o; }
    asm volatile("s_waitcnt lgkmcnt(0)" ::: "memory");
}
__device__ __forceinline__ void rms_row_to_bf16(const float* xrow, const float* g, bf16_t* orow, int lane) {
    const f32x4* xr = (const f32x4*)xrow + lane; const f32x4* gr = (const f32x4*)g + lane;
    f32x4 v[8]; float s = 0.f;
#pragma unroll
    for (int j = 0; j < 8; ++j) { v[j] = __builtin_nontemporal_load(xr + 64 * j); s += (v[j].x * v[j].x + v[j].y * v[j].y) + (v[j].z * v[j].z + v[j].w * v[j].w); }
    const float rs = 1.0f / sqrtf(wave_sum(s) * (1.0f / DM) + EPS);
    u32x2* o8 = (u32x2*)orow + lane;
#pragma unroll
    for (int j = 0; j < 8; ++j) { const f32x4 gg = gr[64 * j]; u32x2 w; w.x = pk2(v[j].x * rs * gg.x, v[j].y * rs * gg.y); w.y = pk2(v[j].z * rs * gg.z, v[j].w * rs * gg.w); o8[64 * j] = w; }
}
__device__ __forceinline__ void p0_prologue(const Params& P, LAS unsigned char* lds, int G, int wave, int lane) {
    LAS float* scr = (LAS float*)(lds + wave * 17408);
    const int gw = blockIdx.x * 8 + wave, NGW = G * 8;
    bf16_t* WinT = (bf16_t*)(P.ws + WS_WINT); bf16_t* WkvT = (bf16_t*)(P.ws + WS_WKVT);
    bf16_t* WrgT = (bf16_t*)(P.ws + WS_WRGT); bf16_t* WpT = (bf16_t*)(P.ws + WS_WPT);
    constexpr int I_WIN = 32 * 192, I_WKV = 32 * 32, I_RG = 2 * 8 * 4, I_WP = 4 * 16;
    constexpr int NITEMS = I_WIN + I_WKV + I_RG + I_WP;
    for (int it = gw; it < NITEMS; it += NGW) {
        int r = it;
        if (r < I_WIN) { p0_transpose_item(P.w_in, DIN, WinT, 2048, scr, r / 192, r % 192, lane); continue; } r -= I_WIN;
        if (r < I_WKV) { p0_transpose_item(P.w_kv, 2048, WkvT, 2048, scr, r / 32, r % 32, lane); continue; } r -= I_WKV;
        if (r < I_RG) { const int gate = r >> 5, blk = (r >> 2) & 7, sub = r & 3;
            p0_transpose_item((gate ? P.w_rg_x : P.w_rg_a) + blk * 16384, 128, WrgT + (size_t)(gate * 8 + blk) * 16384, 128, scr, sub >> 1, sub & 1, lane); continue; } r -= I_RG;
        { const int grp = r >> 4, sub = r & 15;
            p0_transpose_item(P.w_pool + grp * 65536, 256, WpT + (size_t)grp * 65536, 256, scr, sub >> 2, sub & 3, lane); }
    }
    { unsigned long long* GR = (unsigned long long*)(P.ws + WS_GR); for (int i = blockIdx.x * 512 + threadIdx.x; i < 4 * 8 * 16 * 128; i += G * 512) GR[i] = ~0ull; }
    bf16_t* U = (bf16_t*)(P.ws + WS_U); bf16_t* MEMN = (bf16_t*)(P.ws + WS_MEMN);
    for (int m = gw; m < MPAD + 1024; m += NGW) {
        if (m < MP) rms_row_to_bf16(P.x_prompt + (size_t)m * DM, P.g_pre, U + (size_t)m * DM, lane);
        else if (m < MTOT) rms_row_to_bf16(P.x_sample + (size_t)(m - MP) * DM, P.g_pre, U + (size_t)m * DM, lane);
        else if (m < MPAD) { u32x2* o8 = (u32x2*)(U + (size_t)m * DM) + lane;
#pragma unroll
            for (int j = 0; j < 8; ++j) o8[64 * j] = (u32x2){0u, 0u}; }
        else rms_row_to_bf16(P.mem + (size_t)(m - MPAD) * DM, P.g_mem, MEMN + (size_t)(m - MPAD) * DM, lane);
    }
}

__device__ __forceinline__ void deferred_prep(const Params& P, LAS unsigned char* lds, int G, int wave, int lane) {
    const int first = (G == 256) ? 80 : 0, nw = G - first;
    if ((int)blockIdx.x < first) return;
    LAS float* scr = (LAS float*)(lds + wave * 17408);
    const int gw = ((int)blockIdx.x - first) * 8 + wave, NGW = nw * 8;
    bf16_t* WbT = (bf16_t*)(P.ws + WS_WBT); bf16_t* WoT = (bf16_t*)(P.ws + WS_WOT);
    constexpr int I_WB = 48 * 32, I_WO = 32 * 32;
    for (int it = gw; it < I_WB + I_WO; it += NGW) {
        if (it < I_WB) p0_transpose_item(P.w_branch, 2048, WbT, 3072, scr, it / 32, it % 32, lane);
        else { const int r = it - I_WB; p0_transpose_item(P.w_out, 2048, WoT, 2048, scr, r / 32, r % 32, lane); }
    }
    for (int r = gw; r < NS * 14 + NS * 2; r += NGW) {
        const float* src; float* dst;
        if (r < NS * 14) { const int s = r / 14, k = r - 14 * s; src = P.st_pool + ((size_t)s * 15 + k + 1) * 1024; dst = P.out + OFF_NPS + ((size_t)s * 15 + k) * 1024; }
        else { const int q = r - NS * 14, s = q >> 1, k = q & 1; src = P.st_conv + ((size_t)s * 3 + k + 1) * 1024; dst = P.out + OFF_NCS + ((size_t)s * 3 + k) * 1024; }
#pragma unroll
        for (int j = 0; j < 4; ++j) __builtin_nontemporal_store(__builtin_nontemporal_load((const f32x4*)src + 64 * j + lane), (f32x4*)dst + 64 * j + lane);
    }
}

__device__ __forceinline__ f32x2 ldz2(const bf16_t* p) { const unsigned u = *(const unsigned*)p; return (f32x2){bf_lo(u), bf_hi(u)}; }
__device__ __forceinline__ f32x2 lds2(const LAS unsigned char* p) { const unsigned u = *(const LAS unsigned*)p; return (f32x2){bf_lo(u), bf_hi(u)}; }
__device__ __forceinline__ u32x4 mul_bf16x8(u32x4 a, u32x4 b) {
    u32x4 o; o.x = pk2(bf_lo(a.x) * bf_lo(b.x), bf_hi(a.x) * bf_hi(b.x)); o.y = pk2(bf_lo(a.y) * bf_lo(b.y), bf_hi(a.y) * bf_hi(b.y));
    o.z = pk2(bf_lo(a.z) * bf_lo(b.z), bf_hi(a.z) * bf_hi(b.z)); o.w = pk2(bf_lo(a.w) * bf_lo(b.w), bf_hi(a.w) * bf_hi(b.w)); return o;
}
__device__ __forceinline__ float one_minus_sq(float x, float a) {
    const float p = -x * (1.0f + x * (0.5f + x * 0.16666667f));
    const float d = __builtin_fmaf(-a, a, 1.0f);
    return x > -0.01f ? p : d;
}
constexpr unsigned long long GR_EMPTY = ~0ull;

template <bool SAMPLE>
__device__ __forceinline__ void rglru_unit(const Params& P, LAS unsigned char* lds, int b, int n, int c) {
    constexpr int NMT = SAMPLE ? 2 : 16;
    constexpr int NROW = NMT * 16;
    int tid_ = threadIdx.x; asm volatile("" : "+v"(tid_));
    const int tid = tid_, wid = __builtin_amdgcn_readfirstlane(tid >> 6), lane = tid & 63, fr = lane & 15, fq = lane >> 4;
    const bf16_t* Z = (const bf16_t*)(P.ws + WS_Z); bf16_t* OALL = (bf16_t*)(P.ws + WS_OALL); const bf16_t* WrgT = (const bf16_t*)(P.ws + WS_WRGT);
    unsigned long long* GR = (unsigned long long*)(P.ws + WS_GR);
    constexpr int XS = 272;
    LAS unsigned char* XR = lds; LAS unsigned char* HO = lds; LAS unsigned char* XC = lds + 259 * XS;
    const int rowbase = SAMPLE ? MP + 32 * c : b * SEQ + c * 256;
    __syncthreads();
    if (!SAMPLE) {
        u32x4 xv[9];
#pragma unroll
        for (int i = 0; i < 9; ++i) { const int v = tid + 512 * i, row = v >> 4, cv = v & 15; int t = c * 256 - 3 + row; t = t < 0 ? 0 : (t > SEQ - 1 ? SEQ - 1 : t);
            xv[i] = __builtin_nontemporal_load((const u32x4*)(Z + (size_t)(b * SEQ + t) * DIN + ZC_XR + n * 128 + cv * 8)); }
#pragma unroll
        for (int i = 0; i < 9; ++i) { const int v = tid + 512 * i, row = v >> 4, cv = v & 15; const bool neg = (c * 256 - 3 + row) < 0;
            if (row < 259) *(LAS u32x4*)(XR + row * XS + cv * 16) = neg ? (u32x4){0u, 0u, 0u, 0u} : xv[i]; }
    }
    bf16x8 wa[4], wx[4];
    { const bf16_t* pa = WrgT + ((size_t)(0 * 8 + n) * 128 + 16 * wid + fr) * 128 + 8 * fq; const bf16_t* px = WrgT + ((size_t)(1 * 8 + n) * 128 + 16 * wid + fr) * 128 + 8 * fq;
#pragma unroll
      for (int ks = 0; ks < 4; ++ks) { wa[ks] = *(const bf16x8*)(pa + 32 * ks); wx[ks] = *(const bf16x8*)(px + 32 * ks); } }
    const int e = n * 128 + 16 * wid + fr;
    const float c8 = -8.0f * log1pf(expf(-P.lam[e]));
    const float nbaL = -P.b_rg_a[e] * LOG2E, nbxL = -P.b_rg_x[e] * LOG2E, c8L = c8 * LOG2E, c82 = 2.0f * c8;
    {
      const int cp = tid & 63, seg = tid >> 6, ch = n * 128 + 2 * cp;
      const f32x2 w0 = *(const f32x2*)(P.conv_w + 0 * 1024 + ch), w1 = *(const f32x2*)(P.conv_w + 1 * 1024 + ch), w2 = *(const f32x2*)(P.conv_w + 2 * 1024 + ch), w3 = *(const f32x2*)(P.conv_w + 3 * 1024 + ch);
      const f32x2 cb = *(const f32x2*)(P.conv_b + ch);
      if (!SAMPLE) {
          __syncthreads();
          const int r0 = 32 * seg;
          f32x2 x3 = lds2(XR + (r0 + 0) * XS + 4 * cp), x2 = lds2(XR + (r0 + 1) * XS + 4 * cp), x1 = lds2(XR + (r0 + 2) * XS + 4 * cp);
#pragma unroll 8
          for (int i = 0; i < 32; ++i) { const int t = c * 256 + r0 + i;
              const f32x2 x0 = lds2(XR + (r0 + i + 3) * XS + 4 * cp);
              const f32x2 xc = cb + w0 * x3 + w1 * x2 + w2 * x1 + w3 * x0;
              *(LAS unsigned*)(XC + (r0 + i) * XS + 4 * cp) = pk2(xc.x, xc.y);
              if (t >= SEQ - 3) *(f32x2*)(P.out + OFF_NCP + (size_t)(b * 3 + (t - (SEQ - 3))) * 1024 + ch) = x0;
              x3 = x2; x2 = x1; x1 = x0; }
      } else {
#pragma unroll
          for (int i = 0; i < 4; ++i) { const int sl = 4 * seg + i, s = 32 * c + sl;
              const f32x2 x3 = *(const f32x2*)(P.st_conv + (size_t)(s * 3 + 0) * 1024 + ch), x2 = *(const f32x2*)(P.st_conv + (size_t)(s * 3 + 1) * 1024 + ch), x1 = *(const f32x2*)(P.st_conv + (size_t)(s * 3 + 2) * 1024 + ch);
              const f32x2 x0 = ldz2(Z + (size_t)(MP + s) * DIN + ZC_XR + ch);
              const f32x2 xc = cb + w0 * x3 + w1 * x2 + w2 * x1 + w3 * x0;
              *(LAS unsigned*)(XC + sl * XS + 4 * cp) = pk2(xc.x, xc.y);
              *(f32x2*)(P.out + OFF_NCS + (size_t)(s * 3 + 2) * 1024 + ch) = x0; }
      } }
    __syncthreads();
    unsigned cumA[NMT][2], hloc[NMT][2];
    float Ac = 1.f, Hc = 0.f;
#pragma unroll
    for (int mt = 0; mt < NMT; ++mt) {
        f32x4 racc = (f32x4){0.f, 0.f, 0.f, 0.f}, iacc = racc;
#pragma unroll
        for (int ks = 0; ks < 4; ++ks) { const bf16x8 a = *(const LAS bf16x8*)(XC + (16 * mt + fr) * XS + (32 * ks + 8 * fq) * 2);
            racc = __builtin_amdgcn_mfma_f32_16x16x32_bf16(a, wa[ks], racc, 0, 0, 0); iacc = __builtin_amdgcn_mfma_f32_16x16x32_bf16(a, wx[ks], iacc, 0, 0, 0); }
        float av[4], bv[4];
#pragma unroll
        for (int j = 0; j < 4; ++j) { const int row = 16 * mt + 4 * fq + j;
            const float r = __builtin_amdgcn_rcpf(1.0f + __builtin_amdgcn_exp2f(__builtin_fmaf(racc[j], -LOG2E, nbaL)));
            const float ig = __builtin_amdgcn_rcpf(1.0f + __builtin_amdgcn_exp2f(__builtin_fmaf(iacc[j], -LOG2E, nbxL)));
            av[j] = __builtin_amdgcn_exp2f(c8L * r);
            const float mult = __builtin_amdgcn_sqrtf(one_minus_sq(c82 * r, av[j]));
            const float xcv = bf2f(*(const LAS bf16_t*)(XC + row * XS + (16 * wid + fr) * 2));
            bv[j] = mult * ig * xcv; }
        if (!SAMPLE) {
            float Pj[4], Qj[4]; float pp = 1.f, qq = 0.f;
#pragma unroll
            for (int j = 0; j < 4; ++j) { qq = av[j] * qq + bv[j]; pp = av[j] * pp; Pj[j] = pp; Qj[j] = qq; }
            float Arun = Ac, Hrun = Hc, Ain = 1.f, Hin = 0.f;
#pragma unroll
            for (int g = 0; g < 4; ++g) { const float pg = __shfl(pp, fr + 16 * g), qg = __shfl(qq, fr + 16 * g); if (g == fq) { Ain = Arun; Hin = Hrun; } Hrun = pg * Hrun + qg; Arun = pg * Arun; }
            Ac = Arun; Hc = Hrun;
            cumA[mt][0] = cvt_pk_bf16(Pj[0] * Ain, Pj[1] * Ain); cumA[mt][1] = cvt_pk_bf16(Pj[2] * Ain, Pj[3] * Ain);
            hloc[mt][0] = cvt_pk_bf16(Pj[0] * Hin + Qj[0], Pj[1] * Hin + Qj[1]); hloc[mt][1] = cvt_pk_bf16(Pj[2] * Hin + Qj[2], Pj[3] * Hin + Qj[3]);
        } else {
            const int s0 = 32 * c + 16 * mt + 4 * fq;
            float hv[4];
#pragma unroll
            for (int j = 0; j < 4; ++j) { const float h0 = P.st_h[(size_t)(s0 + j) * 1024 + e]; hv[j] = av[j] * h0 + bv[j]; P.out[OFF_NHS + (size_t)(s0 + j) * 1024 + e] = hv[j]; }
            cumA[mt][0] = 0u; cumA[mt][1] = 0u; hloc[mt][0] = cvt_pk_bf16(hv[0], hv[1]); hloc[mt][1] = cvt_pk_bf16(hv[2], hv[3]);
        }
    }
    u32x4 gg[NROW / 32];
#pragma unroll
    for (int i = 0; i < NROW / 32; ++i) { const int v = tid + 512 * i, row = v >> 4, cv = v & 15; gg[i] = __builtin_nontemporal_load((const u32x4*)(Z + (size_t)(rowbase + row) * DIN + ZC_GR + n * 128 + cv * 8)); }
    float carry = 0.f;
    if (!SAMPLE) {
        unsigned long long* gbase = GR + (size_t)((b * 8 + n) * 8) * 128 + 16 * wid + fr;
        if (fq == 0) __hip_atomic_store(gbase + (size_t)c * 128, ((unsigned long long)__builtin_bit_cast(unsigned, Hc) << 32) | (unsigned long long)__builtin_bit_cast(unsigned, Ac), __ATOMIC_RELAXED, __HIP_MEMORY_SCOPE_AGENT);
        if (c > 0) {
            unsigned long long g[7]; unsigned spins = 0;
            for (;;) { bool ok = true;
#pragma unroll
                for (int cc = 0; cc < 7; ++cc) { g[cc] = __hip_atomic_load(gbase + (size_t)cc * 128, __ATOMIC_RELAXED, __HIP_MEMORY_SCOPE_AGENT); }
#pragma unroll
                for (int cc = 0; cc < 7; ++cc) ok = ok && (cc >= c || g[cc] != GR_EMPTY);
                if (__all(ok) || ++spins > (1u << 20)) break;
                __builtin_amdgcn_s_sleep(2); }
#pragma unroll
            for (int cc = 0; cc < 7; ++cc) { const float ga = __builtin_bit_cast(float, (unsigned)g[cc]), gh = __builtin_bit_cast(float, (unsigned)(g[cc] >> 32)); const float nc = ga * carry + gh; carry = (cc < c) ? nc : carry; }
        }
        if (c == 7 && fq == 0) P.out[OFF_NHP + (size_t)b * 1024 + e] = Ac * carry + Hc;
    }
#pragma unroll
    for (int mt = 0; mt < NMT; ++mt)
#pragma unroll
        for (int j = 0; j < 4; ++j) { const int row = 16 * mt + 4 * fq + j;
            const unsigned ca = cumA[mt][j >> 1], hl = hloc[mt][j >> 1];
            const float h = ((j & 1) ? bf_hi(ca) : bf_lo(ca)) * carry + ((j & 1) ? bf_hi(hl) : bf_lo(hl));
            *(LAS bf16_t*)(HO + row * XS + (16 * wid + fr) * 2) = (bf16_t)f2bf(h); }
    __syncthreads();
    {
#pragma unroll
      for (int i = 0; i < NROW / 32; ++i) { const int v = tid + 512 * i, row = v >> 4, cv = v & 15;
          const u32x4 ho = *(const LAS u32x4*)(HO + row * XS + cv * 16);
          *(u32x4*)(OALL + (size_t)(rowbase + row) * DMIX + n * 128 + cv * 8) = mul_bf16x8(ho, gg[i]); } }
}

template <bool SAMPLE>
__device__ __forceinline__ void pool_unit(const Params& P, LAS unsigned char* lds, int b, int g, int blk) {
    int tid_ = threadIdx.x; asm volatile("" : "+v"(tid_));
    const int tid = tid_, wid = __builtin_amdgcn_readfirstlane(tid >> 6), lane = tid & 63, fr = lane & 15, fq = lane >> 4;
    const bf16_t* Z = (const bf16_t*)(P.ws + WS_Z); bf16_t* OALL = (bf16_t*)(P.ws + WS_OALL); const bf16_t* WpT = (const bf16_t*)(P.ws + WS_WPT);
    constexpr int DS = 528;
    LAS unsigned char* XP = lds; LAS unsigned char* OUT = lds; LAS unsigned char* D = lds + 144 * DS;
    const int W = 2 << g;
    const int rowbase = SAMPLE ? MP + 16 * blk : b * SEQ + blk * 128;
    const int nmt = SAMPLE ? 1 : 8;
    __syncthreads();
    if (!SAMPLE) {
        u32x4 xv[9];
#pragma unroll
        for (int i = 0; i < 9; ++i) { const int v = tid + 512 * i, row = v >> 5, cv = v & 31; int t = blk * 128 - 15 + row; t = t < 0 ? 0 : (t > SEQ - 1 ? SEQ - 1 : t);
            xv[i] = __builtin_nontemporal_load((const u32x4*)(Z + (size_t)(b * SEQ + t) * DIN + ZC_XP + g * 256 + cv * 8)); }
#pragma unroll
        for (int i = 0; i < 9; ++i) { const int v = tid + 512 * i, row = v >> 5, cv = v & 31; const bool neg = (blk * 128 - 15 + row) < 0;
            *(LAS u32x4*)(XP + row * DS + cv * 16) = neg ? (u32x4){0u, 0u, 0u, 0u} : xv[i]; }
        __syncthreads();
    }
    { const int cp = tid & 127, seg = tid >> 7, ch = g * 256 + 2 * cp;
      if (!SAMPLE) {
          const int r0 = 15 + 32 * seg;
          f32x2 s = (f32x2){0.f, 0.f};
          for (int k = 1; k < W; ++k) s += lds2(XP + (r0 - k) * DS + 4 * cp);
#pragma unroll 8
          for (int i = 0; i < 32; ++i) { const int t = blk * 128 + 32 * seg + i;
              const f32x2 x0 = lds2(XP + (r0 + i) * DS + 4 * cp); s += x0;
              const float inv = 1.0f / (float)((t + 1) < W ? (t + 1) : W);
              const f32x2 d = s * inv - x0;
              *(LAS unsigned*)(D + (32 * seg + i) * DS + 4 * cp) = pk2(d.x, d.y);
              s -= lds2(XP + (r0 + i - W + 1) * DS + 4 * cp);
              if (t >= SEQ - 15) *(f32x2*)(P.out + OFF_NPP + (size_t)(b * 15 + (t - (SEQ - 15))) * 1024 + ch) = x0; }
      } else {
          const float inv = 1.0f / (float)W;
#pragma unroll
          for (int i = 0; i < 4; ++i) { const int sl = seg + 4 * i, s_ = 16 * blk + sl;
              const f32x2 x0 = ldz2(Z + (size_t)(MP + s_) * DIN + ZC_XP + ch);
              const float* hp = P.st_pool + (size_t)s_ * 15 * 1024 + ch;
              f32x2 hv[15];
#pragma unroll
              for (int k = 1; k < 16; ++k) hv[k - 1] = *(const f32x2*)(hp + (size_t)(15 - k) * 1024);
              f32x2 s = x0;
#pragma unroll
              for (int k = 1; k < 16; ++k) { const f32x2 a = s + hv[k - 1]; s = (k < W) ? a : s; }
              *(f32x2*)(P.out + OFF_NPS + ((size_t)s_ * 15 + 14) * 1024 + ch) = x0;
              const f32x2 d = s * inv - x0;
              *(LAS unsigned*)(D + sl * DS + 4 * cp) = pk2(d.x, d.y); }
      } }
    __syncthreads();
    u32x4 ggp[SAMPLE ? 1 : 8];
#pragma unroll
    for (int i = 0; i < (SAMPLE ? 1 : 8); ++i) { const int v = tid + 512 * i, row = v >> 5, cv = v & 31;
        ggp[i] = __builtin_nontemporal_load((const u32x4*)(Z + (size_t)(rowbase + row) * DIN + ZC_GP + g * 256 + cv * 8)); }
    {
      bf16x8 bw[2][8];
#pragma unroll
      for (int nt = 0; nt < 2; ++nt) { const bf16_t* pw = WpT + ((size_t)g * 256 + 32 * wid + 16 * nt + fr) * 256 + 8 * fq;
#pragma unroll
          for (int ks = 0; ks < 8; ++ks) bw[nt][ks] = *(const bf16x8*)(pw + 32 * ks); }
      const float ps0 = P.pool_scale[g * 256 + 32 * wid + fr], ps1 = P.pool_scale[g * 256 + 32 * wid + 16 + fr];
#pragma unroll 2
      for (int mt = 0; mt < nmt; ++mt) {
          f32x4 a0 = (f32x4){0.f, 0.f, 0.f, 0.f}, a1 = a0;
#pragma unroll
          for (int ks = 0; ks < 8; ++ks) { const bf16x8 a = *(const LAS bf16x8*)(D + (16 * mt + fr) * DS + (32 * ks + 8 * fq) * 2);
              a0 = __builtin_amdgcn_mfma_f32_16x16x32_bf16(a, bw[0][ks], a0, 0, 0, 0); a1 = __builtin_amdgcn_mfma_f32_16x16x32_bf16(a, bw[1][ks], a1, 0, 0, 0); }
#pragma unroll
          for (int j = 0; j < 4; ++j) { const int row = 16 * mt + 4 * fq + j;
              *(LAS bf16_t*)(OUT + row * DS + (32 * wid + fr) * 2) = (bf16_t)f2bf(a0[j] * ps0); *(LAS bf16_t*)(OUT + row * DS + (32 * wid + 16 + fr) * 2) = (bf16_t)f2bf(a1[j] * ps1); }
      } }
    __syncthreads();
#pragma unroll
    for (int i = 0; i < (SAMPLE ? 1 : 8); ++i) { const int v = tid + 512 * i, row = v >> 5, cv = v & 31;
        const u32x4 ho = *(const LAS u32x4*)(OUT + row * DS + cv * 16);
        *(u32x4*)(OALL + (size_t)(rowbase + row) * DMIX + 1024 + g * 256 + cv * 8) = mul_bf16x8(ho, ggp[i]); }
}

__device__ __forceinline__ void attn_stage(LAS unsigned char* lds, const bf16_t* src  , int wid, int lane) {
#pragma unroll
    for (int i = 0; i < 16; ++i) { const int piece = wid * 16 + i, row = 2 * piece + (lane >> 5), p = lane & 31;
        __builtin_amdgcn_global_load_lds((const unsigned*)(src + (size_t)row * 1024 + ((p ^ (row & 15)) << 3)), (LAS unsigned*)(lds + piece * 1024), 16, 0, 0); }
}
__device__ __forceinline__ void attn_unit(const Params& P, LAS unsigned char* lds, int b, int h, int blk) {
    int tid_ = threadIdx.x; asm volatile("" : "+v"(tid_));
    const int tid = tid_, wid = __builtin_amdgcn_readfirstlane(tid >> 6), lane = tid & 63, fr = lane & 15, fq = lane >> 4;
    const bf16_t* Z = (const bf16_t*)(P.ws + WS_Z); bf16_t* OALL = (bf16_t*)(P.ws + WS_OALL); const bf16_t* KB = (const bf16_t*)(P.ws + WS_KB); const bf16_t* VT = (const bf16_t*)(P.ws + WS_VT);
    const int m0 = b * SEQ + blk * 128 + 16 * wid;
    __syncthreads();
    attn_stage(lds, KB + (size_t)(b * 256) * 1024 + h * 256, wid, lane);
    bf16x8 qf[8];
    { const bf16_t* qp = Z + (size_t)(m0 + fr) * DIN + ZC_Q + h * 256 + 8 * fq;
#pragma unroll
      for (int ks = 0; ks < 8; ++ks) qf[ks] = *(const bf16x8*)(qp + 32 * ks); }
    asm volatile("s_waitcnt vmcnt(0)" ::: "memory");
    __syncthreads();
    f32x4 st[16];
#pragma unroll
    for (int t = 0; t < 16; ++t) { f32x4 a = (f32x4){0.f, 0.f, 0.f, 0.f};
#pragma unroll
        for (int ks = 0; ks < 8; ++ks) { const bf16x8 kf = *(const LAS bf16x8*)(lds + (16 * t + fr) * 512 + (((4 * ks + fq) ^ fr) << 4)); a = __builtin_amdgcn_mfma_f32_16x16x32_bf16(kf, qf[ks], a, 0, 0, 0); }
        st[t] = a; }
    __syncthreads();
    attn_stage(lds, VT + (size_t)(h * 256) * 1024 + b * 256, wid, lane);
    float mx = -3.0e38f;
#pragma unroll
    for (int t = 0; t < 16; ++t) mx = fmaxf(mx, fmaxf(fmaxf(st[t][0], st[t][1]), fmaxf(st[t][2], st[t][3])));
    mx = fmaxf(mx, __shfl_xor(mx, 16)); mx = fmaxf(mx, __shfl_xor(mx, 32));
    const float sc = LOG2E * 0.0625f; float sum = 0.f;
#pragma unroll
    for (int t = 0; t < 16; ++t)
#pragma unroll
        for (int j = 0; j < 4; ++j) { const float p = __builtin_amdgcn_exp2f((st[t][j] - mx) * sc); st[t][j] = p; sum += p; }
    sum += __shfl_xor(sum, 16); sum += __shfl_xor(sum, 32);
    const float inv = 1.0f / sum;
    bf16x8 pf[8];
#pragma unroll
    for (int s = 0; s < 8; ++s) { u32x4 w; w.x = cvt_pk_bf16(st[2 * s][0], st[2 * s][1]); w.y = cvt_pk_bf16(st[2 * s][2], st[2 * s][3]); w.z = cvt_pk_bf16(st[2 * s + 1][0], st[2 * s + 1][1]); w.w = cvt_pk_bf16(st[2 * s + 1][2], st[2 * s + 1][3]);
        pf[s] = __builtin_bit_cast(bf16x8, w); }
    asm volatile("s_waitcnt vmcnt(0)" ::: "memory");
    __syncthreads();
    u32x4 gg[8];
#pragma unroll
    for (int i = 0; i < 8; ++i) { const int v = lane + 64 * i, row = v >> 5, cv = v & 31; gg[i] = __builtin_nontemporal_load((const u32x4*)(Z + (size_t)(m0 + row) * DIN + ZC_GX + h * 256 + cv * 8)); }
    u32x2 ov[16];
#pragma unroll
    for (int dt = 0; dt < 16; ++dt) { f32x4 a = (f32x4){0.f, 0.f, 0.f, 0.f};
#pragma unroll
        for (int s = 0; s < 8; ++s) { const LAS unsigned char* rp = lds + (16 * dt + fr) * 512 + 8 * (fq & 1);
            const u32x2 lo = *(const LAS u32x2*)(rp + (((4 * s + (fq >> 1)) ^ fr) << 4)), hi = *(const LAS u32x2*)(rp + (((4 * s + 2 + (fq >> 1)) ^ fr) << 4));
            const u32x4 w = (u32x4){lo.x, lo.y, hi.x, hi.y};
            a = __builtin_amdgcn_mfma_f32_16x16x32_bf16(__builtin_bit_cast(bf16x8, w), pf[s], a, 0, 0, 0); }
        ov[dt].x = pk2(a[0] * inv, a[1] * inv); ov[dt].y = pk2(a[2] * inv, a[3] * inv); }
    __syncthreads();
#pragma unroll
    for (int dt = 0; dt < 16; ++dt) *(LAS u32x2*)(lds + (16 * wid + fr) * 528 + (16 * dt + 4 * fq) * 2) = ov[dt];
    asm volatile("s_waitcnt lgkmcnt(0)" ::: "memory");
    {
#pragma unroll
      for (int i = 0; i < 8; ++i) { const int v = lane + 64 * i, row = v >> 5, cv = v & 31;
          const u32x4 ho = *(const LAS u32x4*)(lds + (16 * wid + row) * 528 + cv * 16);
          *(u32x4*)(OALL + (size_t)(m0 + row) * DMIX + 2048 + h * 256 + cv * 8) = mul_bf16x8(ho, gg[i]); } }
}

__device__ __forceinline__ void sattn_unit(const Params& P, LAS unsigned char* lds, int s, int h) {
    int tid_ = threadIdx.x; asm volatile("" : "+v"(tid_));
    const int tid = tid_, wid = __builtin_amdgcn_readfirstlane(tid >> 6), lane = tid & 63;
    const bf16_t* Z = (const bf16_t*)(P.ws + WS_Z); bf16_t* OALL = (bf16_t*)(P.ws + WS_OALL);
    LAS float* SC = (LAS float*)lds; LAS float* PS = SC + 256; LAS float* PO = PS + 256;
    __syncthreads();
    f32x4 q4;
    { const u32x2 qq = *(const u32x2*)(Z + (size_t)(MP + s) * DIN + ZC_Q + h * 256 + 4 * lane); q4 = (f32x4){bf_lo(qq.x), bf_hi(qq.x), bf_lo(qq.y), bf_hi(qq.y)}; }
    const float* kb = P.cache_k + ((size_t)(s * 256 + 32 * wid) * 4 + h) * 256 + 4 * lane;
    const float* vb = P.cache_v + ((size_t)(s * 256 + 32 * wid) * 4 + h) * 256 + 4 * lane;
    float mysc = 0.f;
    f32x4 v4[32];
    { f32x4 k4[32];
#pragma unroll
      for (int i = 0; i < 32; ++i) k4[i] = __builtin_nontemporal_load((const f32x4*)(kb + (size_t)i * 1024));
#pragma unroll
      for (int i = 0; i < 16; ++i) v4[i] = __builtin_nontemporal_load((const f32x4*)(vb + (size_t)i * 1024));
      float p[32];
#pragma unroll
      for (int i = 0; i < 32; ++i) p[i] = (k4[i].x * q4.x + k4[i].y * q4.y) + (k4[i].z * q4.z + k4[i].w * q4.w);
      float q16[16], q8[8], q4v[4], q2[2];
      { const bool hi = (lane & 32) != 0;
#pragma unroll
        for (int j = 0; j < 16; ++j) { const float send = hi ? p[j] : p[j + 16], keep = hi ? p[j + 16] : p[j]; q16[j] = keep + __shfl_xor(send, 32); } }
      { const bool hi = (lane & 16) != 0;
#pragma unroll
        for (int j = 0; j < 8; ++j) { const float send = hi ? q16[j] : q16[j + 8], keep = hi ? q16[j + 8] : q16[j]; q8[j] = keep + __shfl_xor(send, 16); } }
      { const bool hi = (lane & 8) != 0;
#pragma unroll
        for (int j = 0; j < 4; ++j) { const float send = hi ? q8[j] : q8[j + 4], keep = hi ? q8[j + 4] : q8[j]; q4v[j] = keep + __shfl_xor(send, 8); } }
      { const bool hi = (lane & 4) != 0;
#pragma unroll
        for (int j = 0; j < 2; ++j) { const float send = hi ? q4v[j] : q4v[j + 2], keep = hi ? q4v[j + 2] : q4v[j]; q2[j] = keep + __shfl_xor(send, 4); } }
      { const bool hi = (lane & 2) != 0; const float send = hi ? q2[0] : q2[1], keep = hi ? q2[1] : q2[0]; mysc = keep + __shfl_xor(send, 2); }
      mysc += __shfl_xor(mysc, 1); }
#pragma unroll
    for (int i = 16; i < 32; ++i) v4[i] = __builtin_nontemporal_load((const f32x4*)(vb + (size_t)i * 1024));
    if ((lane & 1) == 0) SC[32 * wid + (lane >> 1)] = mysc;
    __syncthreads();
    { float v[4]; float mx = -3.0e38f;
#pragma unroll
      for (int k = 0; k < 4; ++k) { v[k] = SC[lane + 64 * k]; mx = fmaxf(mx, v[k]); }
      mx = wave_max(mx); float sum = 0.f; const float sc = LOG2E * 0.0625f;
#pragma unroll
      for (int k = 0; k < 4; ++k) { v[k] = __builtin_amdgcn_exp2f((v[k] - mx) * sc); sum += v[k]; }
      sum = wave_sum(sum); const float inv = 1.0f / sum;
      if (wid == 0) {
#pragma unroll
          for (int k = 0; k < 4; ++k) PS[lane + 64 * k] = v[k] * inv; } }
    __syncthreads();
    { f32x4 a = (f32x4){0.f, 0.f, 0.f, 0.f};
#pragma unroll
      for (int i = 0; i < 32; ++i) { const float p = PS[32 * wid + i]; a += v4[i] * p; }
      *(LAS f32x4*)(PO + wid * 256 + 4 * lane) = a; }
    __syncthreads();
    if (tid < 256) { float o = 0.f;
#pragma unroll
        for (int w = 0; w < 8; ++w) o += PO[w * 256 + tid];
        const float gx = bf2f(Z[(size_t)(MP + s) * DIN + ZC_GX + h * 256 + tid]);
        OALL[(size_t)(MP + s) * DMIX + 2048 + h * 256 + tid] = (bf16_t)f2bf(o * gx); }
}

__device__ __forceinline__ void p5_rows(const Params& P, int m0, int mstep, int mend, int lane) {
    const bf16_t* OUTB = (const bf16_t*)(P.ws + WS_OUTB);
    for (int m = m0; m < mend; m += mstep) {
        const u32x4* orow = (const u32x4*)(OUTB + (size_t)m * DM) + lane;
        const f32x4* xrow = (const f32x4*)(m < MP ? P.x_prompt + (size_t)m * DM : P.x_sample + (size_t)(m - MP) * DM) + 2 * lane;
        const f32x4* gr = (const f32x4*)P.g_post + 2 * lane;
        u32x4 v[4]; f32x4 xa[4], xb[4]; float s = 0.f;
#pragma unroll
        for (int j = 0; j < 4; ++j) { v[j] = orow[64 * j]; xa[j] = xrow[128 * j]; xb[j] = xrow[128 * j + 1]; }
#pragma unroll
        for (int j = 0; j < 4; ++j) { const float a0 = bf_lo(v[j].x), a1 = bf_hi(v[j].x), a2 = bf_lo(v[j].y), a3 = bf_hi(v[j].y), a4 = bf_lo(v[j].z), a5 = bf_hi(v[j].z), a6 = bf_lo(v[j].w), a7 = bf_hi(v[j].w);
            s += ((a0 * a0 + a1 * a1) + (a2 * a2 + a3 * a3)) + ((a4 * a4 + a5 * a5) + (a6 * a6 + a7 * a7)); }
        const float rs = 1.0f / sqrtf(wave_sum(s) * (1.0f / DM) + EPS);
        f32x4* yrow = (f32x4*)(P.out + OFF_Y + (size_t)m * DM) + 2 * lane;
#pragma unroll
        for (int j = 0; j < 4; ++j) { const f32x4 g0 = gr[128 * j], g1 = gr[128 * j + 1];
            const f32x4 o0 = (f32x4){bf_lo(v[j].x), bf_hi(v[j].x), bf_lo(v[j].y), bf_hi(v[j].y)}, o1 = (f32x4){bf_lo(v[j].z), bf_hi(v[j].z), bf_lo(v[j].w), bf_hi(v[j].w)};
            yrow[128 * j] = xa[j] + o0 * rs * g0; yrow[128 * j + 1] = xb[j] + o1 * rs * g1; }
    }
}

__global__ void __launch_bounds__(512, 2) fwd_kernel(Params P) {
    extern __shared__ __attribute__((aligned(16))) unsigned char lds_raw[];
    LAS unsigned char* lds = (LAS unsigned char*)lds_raw;
    cg::grid_group grid = cg::this_grid();
    const int tid = threadIdx.x, lane = tid & 63, wave = __builtin_amdgcn_readfirstlane(tid >> 6);
    const int G = gridDim.x;
    const int lo = P.ph_lo, hi = P.ph_hi;
    volatile LAS unsigned* MISC = (volatile LAS unsigned*)(lds + LDS_MISC_OFF);
    if (tid < 16) MISC[tid] = 0u;
    __syncthreads();
    const XcdBarrier xbar = xcd_barrier_post((unsigned*)(P.ws + WS_CTL), MISC);
#define GSYNC(k) do { if (USE_CG_SEAM(k)) grid.sync(); else xcd_barrier(xbar); } while (0)
#define IN(k) (lo <= (k) && (k) < hi)
#define BOTH(k) (IN(k) && IN((k) + 1))
    if (IN(0)) { if (PROBE_REPEAT == 0) { p0_prologue(P, lds, G, wave, lane); GSYNC(9); } p0_prologue(P, lds, G, wave, lane); if (BOTH(0)) GSYNC(0); }
    if (IN(1)) {
        SchedP1 S; S.mode = 0; S.G = G; S.c = blockIdx.x; S.to.init(32, 48); S.U = (const char*)(P.ws + WS_U); S.WinT = (const char*)(P.ws + WS_WINT); S.MEMN = (const char*)(P.ws + WS_MEMN); S.WkvT = (const char*)(P.ws + WS_WKVT);
        EpiP1T<false> E; E.Z = (bf16_t*)(P.ws + WS_Z); E.out = P.out; E.KB = (bf16_t*)(P.ws + WS_KB); E.VT = (bf16_t*)(P.ws + WS_VT); E.slabs = (float*)(P.ws + WS_OALL); E.cnt = (unsigned*)(P.ws + WS_CTL) + CW_CNT + 64 * CNT_P1S; E.misc = MISC; E.done = (unsigned*)(P.ws + WS_CTL) + CW_DONE;
        if (PROBE_REPEAT == 1) { pg8::gemm_phase<EpiP1T<false>, SchedP1>(lds, 2048, 2048, S, E); GSYNC(9); }
        pg8::gemm_phase<EpiP1T<false>, SchedP1>(lds, 2048, 2048, S, E);
        if (BOTH(1)) GSYNC(9);
    }
    if (IN(2)) {
        constexpr int U_RGP = 256, U_RGS = 32, U_ATT = 256, U_PP = 256, U_PS = 32, U_SA = 512;
        constexpr int NU = U_RGP + U_RGS + U_ATT + U_PP + U_PS + U_SA;
        unsigned* done = (unsigned*)(P.ws + WS_CTL) + CW_DONE;
        { SchedP1 S; S.mode = 1; S.G = G; S.c = blockIdx.x; S.to.init(32, 48); S.U = (const char*)(P.ws + WS_U); S.WinT = (const char*)(P.ws + WS_WINT); S.MEMN = (const char*)(P.ws + WS_MEMN); S.WkvT = (const char*)(P.ws + WS_WKVT);
          EpiP1T<true> E; E.Z = (bf16_t*)(P.ws + WS_Z); E.out = P.out; E.KB = (bf16_t*)(P.ws + WS_KB); E.VT = (bf16_t*)(P.ws + WS_VT); E.slabs = (float*)(P.ws + WS_PART); E.cnt = (unsigned*)(P.ws + WS_CTL) + CW_CNT + 64 * CNT_P1S; E.misc = MISC; E.done = done;
          pg8::gemm_phase<EpiP1T<true>, SchedP1>(lds, 2048, 2048, S, E); }
        if (G == 256) {
            const int c = blockIdx.x;
            deferred_prep(P, lds, G, wave, lane);
            pool_unit<false>(P, lds, c >> 6, (c >> 4) & 3, c & 15);
            rglru_unit<false>(P, lds, c >> 6, (c >> 3) & 7, c & 7);
            wait_done(done);
            attn_unit(P, lds, c >> 6, (c >> 4) & 3, c & 15);
            {
              const int s0 = c < 80 ? c : (c < 160 ? 80 + 3 * (c - 80) : 320 + 2 * (c - 160)), ns = c < 80 ? 1 : (c < 160 ? 3 : 2);
              for (int k = 0; k < ns; ++k) sattn_unit(P, lds, (s0 + k) >> 2, (s0 + k) & 3); }
            if (c >= 224) rglru_unit<true>(P, lds, 0, (c - 224) >> 2, (c - 224) & 3);
            else if (c >= 192) pool_unit<true>(P, lds, 0, (c - 192) >> 3, (c - 192) & 7);
        } else {
        deferred_prep(P, lds, G, wave, lane);
        wait_done(done);
        for (int u = blockIdx.x; u < NU; u += G) {
            int r = u;
            if (r < U_RGP) { rglru_unit<false>(P, lds, r >> 6, (r >> 3) & 7, r & 7); continue; } r -= U_RGP;
            if (r < U_RGS) { rglru_unit<true>(P, lds, 0, r >> 2, r & 3); continue; } r -= U_RGS;
            if (r < U_ATT) { attn_unit(P, lds, r >> 6, (r >> 4) & 3, r & 15); continue; } r -= U_ATT;
            if (r < U_PP) { pool_unit<false>(P, lds, r >> 6, (r >> 4) & 3, r & 15); continue; } r -= U_PP;
            if (r < U_PS) { pool_unit<true>(P, lds, 0, r >> 3, r & 7); continue; } r -= U_PS;
            sattn_unit(P, lds, r >> 2, r & 3);
        }
        }
        __syncthreads();
        if (BOTH(2)) GSYNC(9);
    }
    if (IN(3)) {
        SchedP3 S; S.G = G; S.c = blockIdx.x; S.to.init(32, 8); S.OALL = (const char*)(P.ws + WS_OALL); S.WbT = (const char*)(P.ws + WS_WBT);
        EpiP3 E; E.Z = (const bf16_t*)(P.ws + WS_Z); E.PART = (bf16_t*)(P.ws + WS_PART); E.MERGED = (bf16_t*)(P.ws + WS_MERGED); E.slabs = (float*)(P.ws + WS_U); E.cnt = (unsigned*)(P.ws + WS_CTL) + CW_CNT + 64 * CNT_P3S; E.misc = MISC; E.done3 = (unsigned*)(P.ws + WS_CTL) + CW_DONE + 128;
        pg8::gemm_phase<EpiP3, SchedP3>(lds, DMIX, DMIX, S, E);
        if (BOTH(3) && !IN(4)) GSYNC(9);
    }
    if (IN(4)) {
        SchedP4 S; S.G = G; S.c = blockIdx.x; S.to.init(32, 8); S.MERGED = (const char*)(P.ws + WS_MERGED); S.WoT = (const char*)(P.ws + WS_WOT); S.done3 = (unsigned*)(P.ws + WS_CTL) + CW_DONE + 128;
        { pg8::Unit u0; if (S.next(0, u0)) { if (tid == 0) poll_count(S.done3 + 64 * u0.pm, u0.kind == 0 ? 8u : 96u); } __syncthreads(); }
        EpiP4 E; E.OUTF = (bf16_t*)(P.ws + WS_OUTB); E.slabs = (float*)(P.ws + WS_U + 24 * MiB); E.cnt = (unsigned*)(P.ws + WS_CTL) + CW_CNT + 64 * CNT_P4S; E.misc = MISC; E.done4 = (unsigned*)(P.ws + WS_CTL) + CW_DONE4;
        pg8::gemm_phase<EpiP4, SchedP4>(lds, DM, DM, S, E);
        if (BOTH(4) && G != 256) GSYNC(9);
    }
    if (IN(5)) {
        if (G == 256 && IN(4)) {
            unsigned* done4 = (unsigned*)(P.ws + WS_CTL) + CW_DONE4;
            pg8::TileOrder to; to.init(32, 8); int pm, pn; to.map(blockIdx.x, pm, pn);
            if (tid == 0) poll_count(done4 + 64 * pm, 8u);
            __syncthreads();
            p5_rows(P, pm * 256 + pn * 32 + wave, 8, pm * 256 + pn * 32 + 32, lane);
            if (pm >= 16 && pm < 18) {
                const int sr = ((pm - 16) * 8 + pn) * 8;
                if (tid == 0) poll_count(done4 + 64 * 32, 32u);
                __syncthreads();
                p5_rows(P, MP + sr + wave, 8, MP + sr + 8, lane);
            }
        } else p5_rows(P, blockIdx.x * 8 + wave, G * 8, MTOT, lane);
    }
#undef IN
#undef BOTH
}

extern "C" void kernel_launch(void* const* d_in, const int* in_sizes, int n_in, void* d_out, int out_size, void* d_ws, size_t ws_size, hipStream_t stream) {
    static int grid = 0;
    if (grid == 0) {
        if (n_in != 24 || (size_t)out_size != OUT_TOTAL || ws_size < WS_END) { fprintf(stderr, "kernel_launch: unexpected problem (n_in %d, out %d, ws %zu); nothing launched\n", n_in, out_size, ws_size); grid = -1; return; }
        int dev = 0, cus = 0, per_cu = 0;
        if (hipGetDevice(&dev) != hipSuccess || hipDeviceGetAttribute(&cus, hipDeviceAttributeMultiprocessorCount, dev) != hipSuccess) { grid = -1; return; }
        if (hipFuncSetAttribute((const void*)fwd_kernel, hipFuncAttributeMaxDynamicSharedMemorySize, LDS_BYTES) != hipSuccess) { fprintf(stderr, "kernel_launch: hipFuncSetAttribute failed\n"); grid = -1; return; }
        if (hipOccupancyMaxActiveBlocksPerMultiprocessor(&per_cu, (const void*)fwd_kernel, 512, LDS_BYTES) != hipSuccess || per_cu < 1) { fprintf(stderr, "kernel_launch: occupancy query failed (%d)\n", per_cu); (void)hipGetLastError(); grid = -1; return; }
        grid = cus * per_cu;
    }
    if (grid < 0) return;
    Params p{};
    p.x_prompt = (const float*)d_in[0]; p.x_sample = (const float*)d_in[1]; p.mem = (const float*)d_in[2]; p.st_h = (const float*)d_in[3]; p.st_conv = (const float*)d_in[4]; p.st_pool = (const float*)d_in[5];
    p.cache_k = (const float*)d_in[6]; p.cache_v = (const float*)d_in[7]; p.g_pre = (const float*)d_in[8]; p.w_in = (const float*)d_in[9]; p.conv_w = (const float*)d_in[10]; p.conv_b = (const float*)d_in[11];
    p.w_rg_a = (const float*)d_in[12]; p.b_rg_a = (const float*)d_in[13]; p.w_rg_x = (const float*)d_in[14]; p.b_rg_x = (const float*)d_in[15]; p.lam = (const float*)d_in[16]; p.w_pool = (const float*)d_in[17];
    p.pool_scale = (const float*)d_in[18]; p.g_mem = (const float*)d_in[19]; p.w_kv = (const float*)d_in[20]; p.w_branch = (const float*)d_in[21]; p.w_out = (const float*)d_in[22]; p.g_post = (const float*)d_in[23];
    p.out = (float*)d_out; p.ws = (unsigned char*)d_ws;
    if (hipMemsetAsync((char*)d_ws + WS_CTL, 0, CTL_ZERO_BYTES, stream) != hipSuccess) { fprintf(stderr, "kernel_launch: memset failed\n"); return; }
#if MK_N_LAUNCHES == 1
    p.ph_lo = 0; p.ph_hi = 6;
    void* args[] = {&p};
    hipError_t e = hipLaunchCooperativeKernel((const void*)fwd_kernel, dim3(grid), dim3(512), args, LDS_BYTES, stream);
    if (e != hipSuccess) fprintf(stderr, "kernel_launch: cooperative launch failed: %s (grid %d)\n", hipGetErrorString(e), grid);
#else
    for (int ph = 0; ph < 6; ++ph) { p.ph_lo = ph; p.ph_hi = ph + 1; hipLaunchKernelGGL(fwd_kernel, dim3(grid), dim3(512), LDS_BYTES, stream, p); }
#endif
}
```

```cpp
#include <hip/hip_runtime.h>
#include <hip/hip_cooperative_groups.h>
#include <cstdio>
#include <cstdint>
namespace cg = cooperative_groups;

#define LAS __attribute__((address_space(3)))
typedef unsigned short bf16_t;
typedef short bf16x8 __attribute__((ext_vector_type(8)));
typedef short bf16x4 __attribute__((ext_vector_type(4)));
typedef float f32x4 __attribute__((ext_vector_type(4)));
typedef float f32x2 __attribute__((ext_vector_type(2)));
typedef unsigned u32x4 __attribute__((ext_vector_type(4)));
typedef unsigned u32x2 __attribute__((ext_vector_type(2)));

#ifndef MK_N_LAUNCHES
#define MK_N_LAUNCHES 1
#endif
#ifndef CG_SEAM_MASK
#define CG_SEAM_MASK 0
#endif
#define USE_CG_SEAM(k) (((CG_SEAM_MASK) >> (k)) & 1)
#ifndef PROBE_REPEAT
#define PROBE_REPEAT -1
#endif

constexpr int DM = 2048, NBATCH = 4, SEQ = 2048, NS = 128;
constexpr int MP = NBATCH * SEQ;
constexpr int MTOT = MP + NS;
constexpr int MPAD = 8448;
constexpr int DIN = 12288, DMIX = 3072, NMEM = 256;
constexpr int ZC_XR = 0, ZC_GR = 1024, ZC_XP = 2048, ZC_GP = 3072, ZC_Q = 4096, ZC_GX = 5120, ZC_GT = 6144;
constexpr float EPS = 1e-6f;
constexpr float LOG2E = 1.4426950408889634f;

constexpr size_t OFF_Y = 0;
constexpr size_t OFF_NHP = 17039360, OFF_NCP = 17043456, OFF_NPP = 17055744, OFF_MEMK = 17117184, OFF_MEMV = 18165760;
constexpr size_t OFF_NHS = 19214336, OFF_NCS = 19345408, OFF_NPS = 19738624, OUT_TOTAL = 21704704;

constexpr size_t MiB = 1u << 20;
constexpr size_t WS_CTL = 0, WS_WINT = 1 * MiB, WS_WKVT = 49 * MiB, WS_WBT = 57 * MiB, WS_WOT = 69 * MiB, WS_WRGT = 77 * MiB, WS_WPT = 77 * MiB + 512 * 1024;
constexpr size_t WS_U = 78 * MiB, WS_MEMN = 111 * MiB, WS_KB = 115 * MiB, WS_VT = 117 * MiB, WS_Z = 119 * MiB, WS_OALL = 317 * MiB, WS_PART = 367 * MiB;
constexpr size_t WS_MERGED = 433 * MiB, WS_OUTB = 466 * MiB, WS_END = 500 * MiB;
constexpr size_t WS_GR = WS_CTL + 256 * 1024;
constexpr size_t CTL_ZERO_BYTES = 65536;
constexpr int LDS_BYTES = 147456;
constexpr int LDS_MISC_OFF = 147200;

struct Params {
    const float* x_prompt; const float* x_sample; const float* mem; const float* st_h; const float* st_conv; const float* st_pool;
    const float* cache_k; const float* cache_v; const float* g_pre; const float* w_in; const float* conv_w; const float* conv_b;
    const float* w_rg_a; const float* b_rg_a; const float* w_rg_x; const float* b_rg_x; const float* lam; const float* w_pool;
    const float* pool_scale; const float* g_mem; const float* w_kv; const float* w_branch; const float* w_out; const float* g_post;
    float* out; unsigned char* ws; int ph_lo, ph_hi;
};

__device__ __forceinline__ unsigned f2bf(float f) { unsigned u = __builtin_bit_cast(unsigned, f); return (u + 0x7fffu + ((u >> 16) & 1u)) >> 16; }
__device__ __forceinline__ unsigned pk2(float lo, float hi) { unsigned r; asm volatile("v_cvt_pk_bf16_f32 %0, %1, %2" : "=v"(r) : "v"(lo), "v"(hi)); return r; }
__device__ __forceinline__ float bf_lo(unsigned u) { return __builtin_bit_cast(float, u << 16); }
__device__ __forceinline__ float bf_hi(unsigned u) { return __builtin_bit_cast(float, u & 0xffff0000u); }
__device__ __forceinline__ float bf2f(bf16_t b) { return __builtin_bit_cast(float, ((unsigned)b) << 16); }
__device__ __forceinline__ unsigned cvt_pk_bf16(float lo, float hi) { unsigned r; asm volatile("v_cvt_pk_bf16_f32 %0, %1, %2" : "=v"(r) : "v"(lo), "v"(hi)); return r; }
__device__ __forceinline__ float wave_sum(float v) {
#pragma unroll
    for (int o = 1; o < 64; o <<= 1) v += __shfl_xor(v, o);
    return v;
}
__device__ __forceinline__ float wave_max(float v) {
#pragma unroll
    for (int o = 1; o < 64; o <<= 1) v = fmaxf(v, __shfl_xor(v, o));
    return v;
}
__device__ __forceinline__ float sigmoid_f(float x) { return __builtin_amdgcn_rcpf(1.0f + __builtin_amdgcn_exp2f(-x * LOG2E)); }
__device__ __forceinline__ float silu_f(float x) { return x * sigmoid_f(x); }


#define XB_TMO      128
#define XB_XCNT(j)  (256  + 64 * (j))
#define XB_XSUB(j)  (1280 + 64 * (j))
#define XB_XGEN(j)  (2304 + 64 * (j))
#define XB_TOP      3328
#define XB_TOPGEN   3392
#define XCD_BAR_WORDS 3456
#define XB_SPIN_CAP (1u << 18)
__device__ __forceinline__ unsigned xb_ld(unsigned* p)              { return __hip_atomic_load(p, __ATOMIC_RELAXED, __HIP_MEMORY_SCOPE_AGENT); }
__device__ __forceinline__ unsigned xb_add(unsigned* p, unsigned v) { return __hip_atomic_fetch_add(p, v, __ATOMIC_RELAXED, __HIP_MEMORY_SCOPE_AGENT); }
__device__ __forceinline__ unsigned xb_xcc_id() { return (unsigned)__builtin_amdgcn_s_getreg((3 << 11) | 20) & 0xFu; }
#define XB_SPIN(cond, bar) do { unsigned _sp = 0; while (cond) { __builtin_amdgcn_s_sleep(1); \
    if ((++_sp & 255u) == 0u) { if (xb_ld(&(bar)[XB_TMO])) break; if (_sp > XB_SPIN_CAP) { atomicAdd(&(bar)[XB_TMO], 1u); break; } } } } while (0)
struct XcdBarrier { unsigned* bar; unsigned x; volatile LAS unsigned* st; };
__device__ __forceinline__ XcdBarrier xcd_barrier_post(unsigned* bar, volatile LAS unsigned* st) {
    XcdBarrier b; b.bar = bar; b.x = xb_xcc_id(); b.st = st;
    if (threadIdx.x == 0) (void)xb_add(&bar[XB_XCNT(b.x)], 1u);
    return b;
}
__device__ __forceinline__ void xcd_barrier_complete(unsigned* bar, unsigned x, unsigned& nloc, unsigned& nx) {
    const unsigned G = gridDim.x * gridDim.y * gridDim.z;
    unsigned sum, cnt, mine, sp = 0u;
    for (;;) {
        sum = 0u; cnt = 0u; mine = 0u;
#pragma unroll
        for (unsigned j = 0; j < 16; ++j) { const unsigned c = xb_ld(&bar[XB_XCNT(j)]); sum += c; cnt += (c > 0u) ? 1u : 0u; mine = (j == x) ? c : mine; }
        if (sum == G) break;
        __builtin_amdgcn_s_sleep(1);
        if ((++sp & 255u) == 0u) { if (xb_ld(&bar[XB_TMO])) break; if (sp > XB_SPIN_CAP) { atomicAdd(&bar[XB_TMO], 1u); break; } }
    }
    nloc = mine > 0u ? mine : 1u; nx = cnt > 0u ? cnt : 1u;
}
__device__ __forceinline__ void xcd_barrier(const XcdBarrier& b) {
    asm volatile("s_waitcnt vmcnt(0)" ::: "memory");
    __syncthreads();
    if (threadIdx.x == 0) {
        unsigned* bar = b.bar;
        __builtin_amdgcn_s_waitcnt(0);
        unsigned nloc = b.st[0], nx = b.st[1];
        if (nloc == 0u) { xcd_barrier_complete(bar, b.x, nloc, nx); b.st[0] = nloc; b.st[1] = nx; }
        const unsigned old = xb_add(&bar[XB_XSUB(b.x)], 1u);
        const unsigned gen = old / nloc;
        if (old + 1u == (gen + 1u) * nloc) {
            __builtin_amdgcn_fence(__ATOMIC_RELEASE, "agent");
            asm volatile("s_waitcnt vmcnt(0)" ::: "memory");
            const unsigned og = xb_add(&bar[XB_TOP], 1u);
            const unsigned tg = og / nx;
            if (og + 1u == (tg + 1u) * nx) xb_add(&bar[XB_TOPGEN], 1u);
            else XB_SPIN(xb_ld(&bar[XB_TOPGEN]) == tg, bar);
            __builtin_amdgcn_fence(__ATOMIC_ACQUIRE, "agent");
            xb_add(&bar[XB_XGEN(b.x)], 1u);
            asm volatile("s_waitcnt vmcnt(0)" ::: "memory");
        } else {
            XB_SPIN(xb_ld(&bar[XB_XGEN(b.x)]) == gen, bar);
            __builtin_amdgcn_fence(__ATOMIC_ACQUIRE, "agent");
            asm volatile("s_waitcnt vmcnt(0)" ::: "memory");
        }
    }
    __syncthreads();
}

namespace pg8 {
constexpr int BM = 256, BK = 64, HALF = 128, HTB = HALF * BK * 2, STAGE_BYTES = 8 * HTB, NXCD = 8, WGM = 4;
__device__ __forceinline__ int lds_byte(int r, int c) { const int st = (r >> 4) * 2 + (c >> 5), rr = r & 15, cc = c & 31, ob = rr * 64 + cc * 2; return st * 1024 + (ob ^ (((ob >> 9) & 1) << 5)); }
__device__ __forceinline__ void stage_rc(int b, int& R, int& C) { const int st = b / 1024, sb = b % 1024, swz = sb ^ (((sb >> 9) & 1) << 5); R = (st >> 1) * 16 + swz / 64; C = (st & 1) * 32 + (swz % 64) / 2; }
__device__ __forceinline__ int perm32(int rho) { const int n = rho >> 4, i = rho & 15; return 8 * (i >> 2) + 4 * n + (i & 3); }

struct Unit { const char* A; const char* B; int pm, pn, kind, aux, nt, half, ks, grp; };
struct TileOrder {
    int nM, nN, nwg;
    __device__ __forceinline__ void init(int nM_, int nN_) { nM = nM_; nN = nN_; nwg = nM_ * nN_; }
    __device__ __forceinline__ void map(int L, int& pm, int& pn) const {
        int wgid = L; { const int q = nwg / NXCD, r = nwg % NXCD, xcd = wgid % NXCD, off = wgid / NXCD; wgid = (xcd < r ? xcd * (q + 1) : r * (q + 1) + (xcd - r) * q) + off; }
        const int nig = WGM * nN, gid = wgid / nig, fm = gid * WGM, gsz = (nM - fm) < WGM ? (nM - fm) : WGM;
        pm = fm + ((wgid % nig) % gsz); pn = (wgid % nig) / gsz;
    }
};

template <class Epi, class Sched>
__device__ __forceinline__ void gemm_phase(LAS unsigned char* lds, const int lda, const int ldb, const Sched& S, const Epi& E) {
    const int tid = threadIdx.x, wid = __builtin_amdgcn_readfirstlane(tid >> 6), lane = tid & 63, wr = wid >> 2, wc = wid & 3, fr = lane & 15, fq = lane >> 4;
    unsigned voffA[2], voffB[2];
#pragma unroll
    for (int i = 0; i < 2; ++i) { int R, C; stage_rc(tid * 16 + i * 8192, R, C); const int Rb = (R & ~31) + perm32(R & 31);
        voffA[i] = (unsigned)(R * lda + C) * 2u; voffB[i] = (unsigned)(Rb * ldb + C) * 2u; }
    const size_t kstep = (size_t)(BK * 2);
    const size_t hstepA = (size_t)HALF * lda * 2, hstepB = (size_t)HALF * ldb * 2;
    const unsigned ldsw = (unsigned)wid * 1024u;
    const int aoff = lds_byte(wr * 64 + fr, fq * 8), boff = lds_byte(wc * 32 + fr, fq * 8);
#define PG8_SA(b, h) (((b) * 2 + (h)) * HTB)
#define PG8_SB(b, h) ((4 + (b) * 2 + (h)) * HTB)
#define PG8_STAGE(bufoff, gbase, voff) do { _Pragma("unroll") for (int _i = 0; _i < 2; ++_i) \
        __builtin_amdgcn_global_load_lds((const unsigned*)((const char*)(gbase) + (voff)[_i]), (LAS unsigned*)(lds + (bufoff) + ldsw + _i * 8192), 16, 0, 0); } while (0)
#define PG8_LDA(dst, b, h) do { _Pragma("unroll") for (int m = 0; m < 4; ++m) _Pragma("unroll") for (int k = 0; k < 2; ++k) dst[m][k] = *(const LAS bf16x8*)(lds + PG8_SA(b, h) + aoff + m * 2048 + k * 1024); } while (0)
#define PG8_LDB(dst, b, h) do { _Pragma("unroll") for (int n = 0; n < 2; ++n) _Pragma("unroll") for (int k = 0; k < 2; ++k) dst[n][k] = *(const LAS bf16x8*)(lds + PG8_SB(b, h) + boff + n * 2048 + k * 1024); } while (0)
#define PG8_MMA(ai, bj, At, Bt) do { __builtin_amdgcn_s_setprio(1); _Pragma("unroll") for (int m = 0; m < 4; ++m) _Pragma("unroll") for (int n = 0; n < 2; ++n) _Pragma("unroll") for (int k = 0; k < 2; ++k) \
        acc[ai][bj][m][n] = __builtin_amdgcn_mfma_f32_16x16x32_bf16(Bt[n][k], At[m][k], acc[ai][bj][m][n], 0, 0, 0); __builtin_amdgcn_s_setprio(0); } while (0)
#define PG8_WAIT_V(n) asm volatile("s_waitcnt vmcnt(" #n ")" ::: "memory")
#define PG8_WAIT_L(n) asm volatile("s_waitcnt lgkmcnt(" #n ")" ::: "memory")
#define PG8_BAR __builtin_amdgcn_s_barrier()
#define PG8_SCHED __builtin_amdgcn_sched_barrier(0)
    Unit cur, nxt; int ui = 0;
    if (!S.next(0, cur)) return;
    f32x4 acc[2][2][4][2];
#pragma unroll
    for (int a = 0; a < 2; ++a)
#pragma unroll
        for (int b = 0; b < 2; ++b)
#pragma unroll
            for (int m = 0; m < 4; ++m)
#pragma unroll
                for (int n = 0; n < 2; ++n) acc[a][b][m][n] = (f32x4){0.f, 0.f, 0.f, 0.f};
    bf16x8 At[4][2], B0[2][2], B1[2][2];
    const char* cA = cur.A; const char* cB = cur.B;
    PG8_STAGE(PG8_SB(0, 0), cB, voffB); PG8_STAGE(PG8_SB(0, 1), cB + hstepB, voffB); PG8_STAGE(PG8_SA(0, 0), cA, voffA); PG8_STAGE(PG8_SA(0, 1), cA + hstepA, voffA);
    if (wr == 1) PG8_BAR;
    PG8_WAIT_V(2); PG8_BAR;
    PG8_STAGE(PG8_SB(1, 0), cB + kstep, voffB); PG8_STAGE(PG8_SA(1, 0), cA + kstep, voffA); PG8_STAGE(PG8_SB(1, 1), cB + hstepB + kstep, voffB);
    PG8_WAIT_V(6); PG8_BAR;
    for (;;) {
        const bool has_next = S.next(ui + 1, nxt);
        const char* nA = has_next ? nxt.A : cA; const char* nB = has_next ? nxt.B : cB;
        const int nt = cur.nt; const bool full = (cur.half == 0);
        for (int t = 0; t < nt; t += 2) {
            const bool last = (t == nt - 2);
            if (last && has_next) S.a_ready(nxt);
            const char* a1 = cA + (size_t)(t + 1) * kstep;
            const char* a2 = last ? nA : cA + (size_t)(t + 2) * kstep; const char* b2 = last ? nB : cB + (size_t)(t + 2) * kstep;
            const char* a3 = a2 + kstep; const char* b3 = b2 + kstep;
            PG8_LDB(B0, 0, 0); PG8_LDB(B1, 0, 1); PG8_SCHED; PG8_LDA(At, 0, 0); PG8_STAGE(PG8_SA(1, 1), a1 + hstepA, voffA);
            PG8_WAIT_V(8); PG8_WAIT_L(0); PG8_BAR; PG8_MMA(0, 0, At, B0); PG8_MMA(0, 1, At, B1); PG8_BAR; PG8_SCHED;
            PG8_LDA(At, 0, 1); PG8_STAGE(PG8_SB(0, 0), b2, voffB); PG8_STAGE(PG8_SB(0, 1), b2 + hstepB, voffB); PG8_STAGE(PG8_SA(0, 0), a2, voffA);
            PG8_WAIT_V(8); PG8_WAIT_L(0); PG8_BAR; if (full) { PG8_MMA(1, 0, At, B0); PG8_MMA(1, 1, At, B1); } PG8_BAR; PG8_SCHED;
            PG8_LDB(B0, 1, 0); PG8_LDB(B1, 1, 1); PG8_SCHED; PG8_LDA(At, 1, 0); PG8_STAGE(PG8_SA(0, 1), a2 + hstepA, voffA);
            PG8_WAIT_V(8); PG8_WAIT_L(0); PG8_BAR; PG8_MMA(0, 0, At, B0); PG8_MMA(0, 1, At, B1); PG8_BAR; PG8_SCHED;
            PG8_LDA(At, 1, 1); PG8_STAGE(PG8_SB(1, 0), b3, voffB); PG8_STAGE(PG8_SB(1, 1), b3 + hstepB, voffB); PG8_STAGE(PG8_SA(1, 0), a3, voffA);
            PG8_WAIT_V(8); PG8_WAIT_L(0); PG8_BAR; if (full) { PG8_MMA(1, 0, At, B0); PG8_MMA(1, 1, At, B1); } PG8_BAR; PG8_SCHED;
        }
        if (wr == 0) PG8_BAR;
        E(acc, cur, wr, wc, fr, fq);
        if (!has_next) break;
#pragma unroll
        for (int a = 0; a < 2; ++a)
#pragma unroll
            for (int b = 0; b < 2; ++b)
#pragma unroll
                for (int m = 0; m < 4; ++m)
#pragma unroll
                    for (int n = 0; n < 2; ++n) acc[a][b][m][n] = (f32x4){0.f, 0.f, 0.f, 0.f};
        cur = nxt; cA = nA; cB = nB; ++ui;
        if (wr == 1) PG8_BAR;
    }
    PG8_WAIT_V(0);
    PG8_BAR;
#undef PG8_SA
#undef PG8_SB
#undef PG8_STAGE
#undef PG8_LDA
#undef PG8_LDB
#undef PG8_MMA
#undef PG8_WAIT_V
#undef PG8_WAIT_L
#undef PG8_BAR
#undef PG8_SCHED
}
}

constexpr int SLAB_FLOATS = 32 * 512 * 4;
constexpr int CW_CNT = 4096;
constexpr int CNT_P1S = 0, CNT_P1KV = 48, CNT_P3S = 80, CNT_P4S = 88;
constexpr int CW_DONE4 = 10240;
constexpr int CW_DONE = 13312;
template <int NSL, bool HALF, int KS>
__device__ __forceinline__ unsigned share_body(f32x4 (&acc)[2][2][4][2], const float* slabs, int tid) {
    unsigned mask = 0;
    const f32x4* p0 = (const f32x4*)slabs + tid;
#pragma unroll
    for (int c = 0; c < (HALF ? 8 : 16); ++c) { if (c % NSL != KS) continue;
        const int ai = c >> 3, bj = (c >> 2) & 1, m = c & 3; mask |= 1u << c;
#pragma unroll
        for (int s = 0; s < NSL; ++s) { if (s == KS) continue;
            acc[ai][bj][m][0] += p0[(size_t)s * (SLAB_FLOATS / 4) + (size_t)(c * 2 + 0) * 512]; acc[ai][bj][m][1] += p0[(size_t)s * (SLAB_FLOATS / 4) + (size_t)(c * 2 + 1) * 512]; }
        asm volatile("" ::: "memory"); }
    return mask;
}
template <int NSL, bool HALF>
__device__ __forceinline__ unsigned splitk_share(f32x4 (&acc)[2][2][4][2], float* slabs, int ks, unsigned* cnt, volatile LAS unsigned* misc) {
    int tid_ = threadIdx.x; asm volatile("" : "+v"(tid_));
    const int tid = tid_;
    {
      const unsigned long long pa = (unsigned long long)(slabs + (size_t)ks * SLAB_FLOATS);
      const unsigned plo = __builtin_amdgcn_readfirstlane((unsigned)pa), phi = __builtin_amdgcn_readfirstlane((unsigned)(pa >> 32));
      const __amdgpu_buffer_rsrc_t rs = __builtin_amdgcn_make_buffer_rsrc((void*)(((unsigned long long)phi << 32) | plo), (short)0, SLAB_FLOATS * 4, 0x00020000);
#pragma unroll
      for (int ai = 0; ai < (HALF ? 1 : 2); ++ai)
#pragma unroll
          for (int bj = 0; bj < 2; ++bj)
#pragma unroll
              for (int m = 0; m < 4; ++m)
#pragma unroll
                  for (int n = 0; n < 2; ++n) __builtin_amdgcn_raw_buffer_store_b128(__builtin_bit_cast(u32x4, acc[ai][bj][m][n]), rs, (unsigned)tid * 16u, ((((ai * 2 + bj) * 4 + m) * 2 + n) * 512) * 16, 16); }
    asm volatile("s_waitcnt vmcnt(0)" ::: "memory");
    __syncthreads();
    if (tid == 0) {
        (void)__hip_atomic_fetch_add(cnt, 1u, __ATOMIC_RELAXED, __HIP_MEMORY_SCOPE_AGENT);
        unsigned spins = 0;
        if (ks < (HALF ? 8 : 16))
        while (__hip_atomic_load(cnt, __ATOMIC_RELAXED, __HIP_MEMORY_SCOPE_AGENT) < (unsigned)NSL) { __builtin_amdgcn_s_sleep(2); if (++spins > (1u << 21)) break; }
        __builtin_amdgcn_fence(__ATOMIC_ACQUIRE, "agent"); asm volatile("s_waitcnt vmcnt(0)" ::: "memory");
    }
    __syncthreads();
    unsigned mask = 0;
    if (NSL >= 1 && ks == 0) mask = share_body<NSL, HALF, 0>(acc, slabs, tid);
    if (NSL >= 2 && ks == 1) mask = share_body<NSL, HALF, (NSL >= 2 ? 1 : 0)>(acc, slabs, tid);
    if (NSL >= 3 && ks == 2) mask = share_body<NSL, HALF, (NSL >= 3 ? 2 : 0)>(acc, slabs, tid);
    if (NSL >= 4 && ks == 3) mask = share_body<NSL, HALF, (NSL >= 4 ? 3 : 0)>(acc, slabs, tid);
    if (NSL >= 5 && ks == 4) mask = share_body<NSL, HALF, (NSL >= 5 ? 4 : 0)>(acc, slabs, tid);
    if (NSL >= 6 && ks == 5) mask = share_body<NSL, HALF, (NSL >= 6 ? 5 : 0)>(acc, slabs, tid);
    if (NSL >= 7 && ks == 6) mask = share_body<NSL, HALF, (NSL >= 7 ? 6 : 0)>(acc, slabs, tid);
    if (NSL >= 8 && ks == 7) mask = share_body<NSL, HALF, (NSL >= 8 ? 7 : 0)>(acc, slabs, tid);
    return mask;
}

__device__ __forceinline__ void publish_count(unsigned* ctr) {
    asm volatile("s_waitcnt vmcnt(0)" ::: "memory"); __syncthreads();
    if (threadIdx.x == 0) { __builtin_amdgcn_fence(__ATOMIC_RELEASE, "agent"); asm volatile("s_waitcnt vmcnt(0)" ::: "memory"); __hip_atomic_fetch_add(ctr, 1u, __ATOMIC_RELAXED, __HIP_MEMORY_SCOPE_AGENT); }
}
__device__ __forceinline__ void publish_count_wt(unsigned* ctr) {
    asm volatile("s_waitcnt vmcnt(0)" ::: "memory"); __syncthreads();
    if (threadIdx.x == 0) __hip_atomic_fetch_add(ctr, 1u, __ATOMIC_RELAXED, __HIP_MEMORY_SCOPE_AGENT);
}
__device__ __forceinline__ void poll_count(unsigned* ctr, unsigned need) {
    unsigned spins = 0;
    while (__hip_atomic_load(ctr, __ATOMIC_RELAXED, __HIP_MEMORY_SCOPE_AGENT) < need) { __builtin_amdgcn_s_sleep(4); if (++spins > (1u << 21)) break; }
    __builtin_amdgcn_fence(__ATOMIC_ACQUIRE, "agent"); asm volatile("s_waitcnt vmcnt(0)" ::: "memory");
}

__device__ __forceinline__ bf16_t* gate_frag_ptr(bf16_t* Z, int pm, int colbase, int f) {
    const int tid = threadIdx.x;
    return Z + (size_t)(pm * 256 + 16 * f + (tid >> 5)) * DIN + colbase + (tid & 31) * 8;
}
struct SchedP1 {
    int mode; int G, c; pg8::TileOrder to; const char* U; const char* WinT; const char* MEMN; const char* WkvT;
    __device__ __forceinline__ void a_ready(const pg8::Unit&) const {}
    __device__ __forceinline__ bool next(int i, pg8::Unit& u) const {
        const int L = i * G + c;
        int e;
        if (mode == 1) e = L;
        else { if (L < 32 * 48) { int pm, pn; to.map(L, pm, pn); u.A = U + (size_t)pm * 256 * 2048 * 2; u.B = WinT + (size_t)pn * 256 * 2048 * 2; u.pm = pm; u.pn = pn; u.kind = 0; u.nt = 32; u.half = 0; u.ks = 0; u.grp = 0; return true; }
            if (mode == 0) return false;
            e = L - 32 * 48; }
        if (e >= 80) return false;
        u.nt = 32; u.ks = 0; u.grp = 0;
        if (e < 32) { const int pm = e & 3, pn = e >> 2;
            u.A = MEMN + (size_t)pm * 256 * 2048 * 2; u.B = WkvT + (size_t)pn * 256 * 2048 * 2; u.pm = pm; u.pn = pn; u.kind = 2; u.half = 0; }
        else { const int t = e - 32;
            u.A = U + (size_t)32 * 256 * 2048 * 2; u.B = WinT + (size_t)t * 256 * 2048 * 2; u.pm = 32; u.pn = t; u.kind = 1; u.half = 1; }
        return true;
    }
};
template <bool EXTRA>
struct EpiP1T {
    bf16_t* Z; float* out; bf16_t* KB; bf16_t* VT; float* slabs; unsigned* cnt; volatile LAS unsigned* misc; unsigned* done;
    __device__ __forceinline__ void publish(int which) const {
        asm volatile("s_waitcnt vmcnt(0)" ::: "memory"); __syncthreads();
        if (threadIdx.x == 0) { __builtin_amdgcn_fence(__ATOMIC_RELEASE, "agent"); asm volatile("s_waitcnt vmcnt(0)" ::: "memory"); __hip_atomic_fetch_add(done + 64 * which, 1u, __ATOMIC_RELAXED, __HIP_MEMORY_SCOPE_AGENT); }
    }
    __device__ __forceinline__ void operator()(f32x4 (&acc)[2][2][4][2], const pg8::Unit& u, int wr, int wc, int fr, int fq) const {
        const int row0 = u.pm * 256 + wr * 64 + fr, col0 = u.pn * 256 + wc * 32 + 8 * fq;
        unsigned cm = 0xffffu;

        if (!EXTRA || u.kind != 2) {
            const int seg = u.pn >> 2;
            const int act = (seg >= 6) ? 2 : ((seg & 1) ? 1 : 0);
#pragma unroll
            for (int ai = 0; ai < 2; ++ai) { if (ai == 1 && u.half) break;
#pragma unroll
                for (int m = 0; m < 4; ++m) { bf16_t* rowp = Z + (size_t)(row0 + ai * 128 + m * 16) * DIN + col0;
#pragma unroll
                    for (int bj = 0; bj < 2; ++bj) { if (EXTRA && !((cm >> ((ai * 2 + bj) * 4 + m)) & 1u)) continue;
                        f32x4 v0 = acc[ai][bj][m][0], v1 = acc[ai][bj][m][1];
                        if (act == 1) {
#pragma unroll
                            for (int j = 0; j < 4; ++j) { v0[j] = silu_f(v0[j]); v1[j] = silu_f(v1[j]); } }
                        else if (act == 2) {
#pragma unroll
                            for (int j = 0; j < 4; ++j) { v0[j] = sigmoid_f(v0[j]); v1[j] = sigmoid_f(v1[j]); } }
                        u32x4 w; w.x = cvt_pk_bf16(v0[0], v0[1]); w.y = cvt_pk_bf16(v0[2], v0[3]); w.z = cvt_pk_bf16(v1[0], v1[1]); w.w = cvt_pk_bf16(v1[2], v1[3]);
                        bf16_t* dst = rowp + bj * 128;
                        if (!EXTRA && act == 2) dst = gate_frag_ptr(Z, u.pm, u.pn * 256, (ai * 4 + m) * 2 + bj);
                        __builtin_nontemporal_store(w, (u32x4*)dst); } } }
            if (EXTRA) publish(1);
        } else {
            const bool isV = u.pn >= 4;
            const int c0 = isV ? col0 - 1024 : col0;
            float* ob = out + (isV ? OFF_MEMV : OFF_MEMK);
#pragma unroll
            for (int ai = 0; ai < 2; ++ai)
#pragma unroll
                for (int m = 0; m < 4; ++m) { const int row = row0 + ai * 128 + m * 16;
#pragma unroll
                    for (int bj = 0; bj < 2; ++bj) { if (!((cm >> ((ai * 2 + bj) * 4 + m)) & 1u)) continue;
                        const f32x4 v0 = acc[ai][bj][m][0], v1 = acc[ai][bj][m][1]; const int col = c0 + bj * 128;
                        __builtin_nontemporal_store(v0, (f32x4*)(ob + (size_t)row * 1024 + col)); __builtin_nontemporal_store(v1, (f32x4*)(ob + (size_t)row * 1024 + col + 4));
                        if (!isV) { u32x4 w; w.x = cvt_pk_bf16(v0[0], v0[1]); w.y = cvt_pk_bf16(v0[2], v0[3]); w.z = cvt_pk_bf16(v1[0], v1[1]); w.w = cvt_pk_bf16(v1[2], v1[3]);
                            *(u32x4*)(KB + (size_t)row * 1024 + col) = w; }
                        else {
#pragma unroll
                            for (int j = 0; j < 4; ++j) { VT[(size_t)(col + j) * 1024 + row] = (bf16_t)f2bf(v0[j]); VT[(size_t)(col + 4 + j) * 1024 + row] = (bf16_t)f2bf(v1[j]); } } } }
            publish(0);
        }
    }
};
__device__ __forceinline__ void wait_done(unsigned* done) {
    if (threadIdx.x == 0) { unsigned spins = 0;
        while (__hip_atomic_load(done, __ATOMIC_RELAXED, __HIP_MEMORY_SCOPE_AGENT) < 32u || __hip_atomic_load(done + 64, __ATOMIC_RELAXED, __HIP_MEMORY_SCOPE_AGENT) < 48u) { __builtin_amdgcn_s_sleep(8); if (++spins > (1u << 21)) break; }
        __builtin_amdgcn_fence(__ATOMIC_ACQUIRE, "agent"); asm volatile("s_waitcnt vmcnt(0)" ::: "memory"); }
    __syncthreads();
}
struct SchedP3 {
    int G, c; pg8::TileOrder to; const char* OALL; const char* WbT;
    __device__ __forceinline__ void a_ready(const pg8::Unit&) const {}
    __device__ __forceinline__ bool next(int i, pg8::Unit& u) const {
        const int nmine = (32 * 8 - c + G - 1) / G;
        int e = 96;
        if (G == 256) {
            int qm, qn; to.map(c, qm, qn);
            if (qm < 12) { if (i == 0) e = qm * 8 + qn; else i -= 1; }
        }
        if (e >= 96 && i < 3 * nmine) { const int ti = i / 3, j = i - 3 * ti; const int L = ti * G + c;
            int pm, pn; to.map(L, pm, pn);
            u.A = OALL + ((size_t)pm * 256 * DMIX + (size_t)j * 1024) * 2; u.B = WbT + ((size_t)pn * 256 * DMIX + (size_t)j * 1024) * 2; u.pm = pm; u.pn = pn; u.kind = 0; u.aux = j; u.nt = 16; u.half = 0; u.ks = 0; u.grp = 0; return true; }
        if (G != 256) e = (i - 3 * nmine) * G + c;
        if (e >= 96) return false;
        const int pn = e / 12, r = e - 12 * pn, j = r >> 2, k4 = r & 3;
        u.A = OALL + ((size_t)32 * 256 * DMIX + (size_t)j * 1024 + (size_t)k4 * 256) * 2; u.B = WbT + ((size_t)pn * 256 * DMIX + (size_t)j * 1024 + (size_t)k4 * 256) * 2;
        u.pm = 32; u.pn = pn; u.kind = 1; u.aux = j; u.nt = 4; u.half = 1; u.ks = r; u.grp = pn; return true;
    }
};
struct EpiP3 {
    const bf16_t* Z; bf16_t* PART; bf16_t* MERGED; float* slabs; unsigned* cnt; volatile LAS unsigned* misc; unsigned* done3;
    __device__ __forceinline__ void operator()(f32x4 (&acc)[2][2][4][2], const pg8::Unit& u, int wr, int wc, int fr, int fq) const {
        const int row0 = u.pm * 256 + wr * 64 + fr, col0 = u.pn * 256 + wc * 32 + 8 * fq, j = u.aux;
        if (u.kind == 0) {
            const __amdgpu_buffer_rsrc_t mrs = __builtin_amdgcn_make_buffer_rsrc((void*)MERGED, (short)0, (int)((size_t)MPAD * DM * 2), 0x00020000);
#pragma unroll
            for (int ai = 0; ai < 2; ++ai) {
                u32x4 g[4][2], pp[4][2];
#pragma unroll
                for (int m = 0; m < 4; ++m)
#pragma unroll
                    for (int bj = 0; bj < 2; ++bj) g[m][bj] = __builtin_nontemporal_load((const u32x4*)gate_frag_ptr((bf16_t*)Z, u.pm, ZC_GT + j * DM + u.pn * 256, (ai * 4 + m) * 2 + bj));
#pragma unroll
                for (int m = 0; m < 4; ++m)
#pragma unroll
                    for (int bj = 0; bj < 2; ++bj) { pp[m][bj] = (u32x4){0u, 0u, 0u, 0u}; if (j > 0) pp[m][bj] = *(const u32x4*)(PART + ((size_t)((u.pm * 8 + u.pn) * 16 + (ai * 4 + m) * 2 + bj) * 512 + threadIdx.x) * 8); }
#pragma unroll
                for (int m = 0; m < 4; ++m) { const size_t row = (size_t)(row0 + ai * 128 + m * 16);
#pragma unroll
                    for (int bj = 0; bj < 2; ++bj) { const int col = col0 + bj * 128;
                        const u32x4 gg = g[m][bj], q = pp[m][bj];
                        f32x4 p0 = (f32x4){bf_lo(q.x), bf_hi(q.x), bf_lo(q.y), bf_hi(q.y)}, p1 = (f32x4){bf_lo(q.z), bf_hi(q.z), bf_lo(q.w), bf_hi(q.w)};
                        const f32x4 a0 = acc[ai][bj][m][0], a1 = acc[ai][bj][m][1];
                        p0[0] += bf_lo(gg.x) * a0[0]; p0[1] += bf_hi(gg.x) * a0[1]; p0[2] += bf_lo(gg.y) * a0[2]; p0[3] += bf_hi(gg.y) * a0[3];
                        p1[0] += bf_lo(gg.z) * a1[0]; p1[1] += bf_hi(gg.z) * a1[1]; p1[2] += bf_lo(gg.w) * a1[2]; p1[3] += bf_hi(gg.w) * a1[3];
                        u32x4 w; w.x = cvt_pk_bf16(p0[0], p0[1]); w.y = cvt_pk_bf16(p0[2], p0[3]); w.z = cvt_pk_bf16(p1[0], p1[1]); w.w = cvt_pk_bf16(p1[2], p1[3]);
                        if (j < 2) *(u32x4*)(PART + ((size_t)((u.pm * 8 + u.pn) * 16 + (ai * 4 + m) * 2 + bj) * 512 + threadIdx.x) * 8) = w;
                        else __builtin_amdgcn_raw_buffer_store_b128(w, mrs, (unsigned)(row * DM + col) * 2u, 0, 16); } }
            }
            if (j == 2) publish_count_wt(done3 + 64 * u.pm);
        } else {
#pragma unroll
            for (int m = 0; m < 4; ++m) { const size_t row = (size_t)(row0 + m * 16);
#pragma unroll
                for (int bj = 0; bj < 2; ++bj) { const int col = col0 + bj * 128;
                    const u32x4 g = __builtin_nontemporal_load((const u32x4*)(Z + row * DIN + ZC_GT + j * DM + col));
                    f32x4& a0 = acc[0][bj][m][0]; f32x4& a1 = acc[0][bj][m][1];
                    a0[0] *= bf_lo(g.x); a0[1] *= bf_hi(g.x); a0[2] *= bf_lo(g.y); a0[3] *= bf_hi(g.y);
                    a1[0] *= bf_lo(g.z); a1[1] *= bf_hi(g.z); a1[2] *= bf_lo(g.w); a1[3] *= bf_hi(g.w); } }
            const __amdgpu_buffer_rsrc_t mrs2 = __builtin_amdgcn_make_buffer_rsrc((void*)MERGED, (short)0, (int)((size_t)MPAD * DM * 2), 0x00020000);
            const unsigned cm = splitk_share<12, true>(acc, slabs + (size_t)u.grp * 12 * SLAB_FLOATS, u.ks, cnt + 64 * u.grp, misc);
#pragma unroll
            for (int m = 0; m < 4; ++m) { const size_t row = (size_t)(row0 + m * 16);
#pragma unroll
                for (int bj = 0; bj < 2; ++bj) { if (!((cm >> (bj * 4 + m)) & 1u)) continue;
                    const int col = col0 + bj * 128; const f32x4 p0 = acc[0][bj][m][0], p1 = acc[0][bj][m][1];
                    u32x4 w; w.x = cvt_pk_bf16(p0[0], p0[1]); w.y = cvt_pk_bf16(p0[2], p0[3]); w.z = cvt_pk_bf16(p1[0], p1[1]); w.w = cvt_pk_bf16(p1[2], p1[3]);
                    __builtin_amdgcn_raw_buffer_store_b128(w, mrs2, (unsigned)(row * DM + col) * 2u, 0, 16); } }
            publish_count_wt(done3 + 64 * 32);
        }
    }
};
struct SchedP4 {
    int G, c; pg8::TileOrder to; const char* MERGED; const char* WoT; unsigned* done3;
    __device__ __forceinline__ bool next(int i, pg8::Unit& u) const {
        int e = -1;
        if (G == 256) {
            int qm, qn; to.map(c, qm, qn);
            if (qm >= 12 && qm < 16) { if (i == 0) e = (qm - 12) * 8 + qn; else i -= 1; }
        }
        const int L = i * G + c;
        if (e < 0 && L < 32 * 8) { int pm, pn; to.map(L, pm, pn);
            u.A = MERGED + (size_t)pm * 256 * DM * 2; u.B = WoT + (size_t)pn * 256 * DM * 2; u.pm = pm; u.pn = pn; u.kind = 0; u.aux = 0; u.nt = 32; u.half = 0; u.ks = 0; u.grp = 0; return true; }
        if (G != 256) e = L - 32 * 8 - 48;
        if (e < 0 || e >= 32) return false;
        const int pn = e >> 2, ks = e & 3;
        u.A = MERGED + ((size_t)32 * 256 * DM + (size_t)ks * 512) * 2; u.B = WoT + ((size_t)pn * 256 * DM + (size_t)ks * 512) * 2; u.pm = 32; u.pn = pn; u.kind = 1; u.aux = 0; u.nt = 8; u.half = 1; u.ks = ks; u.grp = pn; return true;
    }
    __device__ __forceinline__ void a_ready(const pg8::Unit& n) const {
        if (threadIdx.x == 0) poll_count(done3 + 64 * n.pm, n.kind == 0 ? 8u : 96u);
        asm volatile("" ::: "memory"); __builtin_amdgcn_s_barrier(); asm volatile("" ::: "memory");
    }
};
struct EpiP4 {
    bf16_t* OUTF; float* slabs; unsigned* cnt; volatile LAS unsigned* misc; unsigned* done4;
    __device__ __forceinline__ void operator()(f32x4 (&acc)[2][2][4][2], const pg8::Unit& u, int wr, int wc, int fr, int fq) const {
        const int row0 = u.pm * 256 + wr * 64 + fr, col0 = u.pn * 256 + wc * 32 + 8 * fq;
        const __amdgpu_buffer_rsrc_t ors = __builtin_amdgcn_make_buffer_rsrc((void*)OUTF, (short)0, (int)((size_t)MPAD * DM * 2), 0x00020000);
        unsigned cm = 0xffffu;
        if (u.kind != 0) cm = splitk_share<4, true>(acc, slabs + (size_t)u.grp * 4 * SLAB_FLOATS, u.ks, cnt + 64 * u.grp, misc);
#pragma unroll
        for (int ai = 0; ai < 2; ++ai) { if (ai == 1 && u.half) break;
#pragma unroll
            for (int m = 0; m < 4; ++m) { const unsigned ooff = (unsigned)((row0 + ai * 128 + m * 16) * DM + col0) * 2u;
#pragma unroll
                for (int bj = 0; bj < 2; ++bj) { if (!((cm >> ((ai * 2 + bj) * 4 + m)) & 1u)) continue;
                    const f32x4 v0 = acc[ai][bj][m][0], v1 = acc[ai][bj][m][1];
                    u32x4 w; w.x = cvt_pk_bf16(v0[0], v0[1]); w.y = cvt_pk_bf16(v0[2], v0[3]); w.z = cvt_pk_bf16(v1[0], v1[1]); w.w = cvt_pk_bf16(v1[2], v1[3]);
                    __builtin_amdgcn_raw_buffer_store_b128(w, ors, ooff, bj * 256, 16); } } }
        publish_count_wt(done4 + 64 * u.pm);
    }
};

__device__ __forceinline__ void p0_transpose_item(const float* W, int N, bf16_t* WT, int ldt, LAS float* scr, int kb, int nb, int lane) {
    const int k0 = 64 * kb, n0 = 64 * nb;
    f32x4 v[16];
#pragma unroll
    for (int i = 0; i < 16; ++i) { const int idx = lane + 64 * i; v[i] = __builtin_nontemporal_load((const f32x4*)(W + (size_t)(k0 + (idx >> 4)) * N + n0 + 4 * (idx & 15))); }
#pragma unroll
    for (int i = 0; i < 16; ++i) { const int idx = lane + 64 * i, kr = idx >> 4; *(LAS f32x4*)(scr + kr * 68 + ((4 * (idx & 15)) ^ (((kr >> 3) & 3) << 3))) = v[i]; }
    asm volatile("s_waitcnt lgkmcnt(0)" ::: "memory");
    const int c = lane & 7;
#pragma unroll
    for (int j = 0; j < 8; ++j) { const int n = (lane >> 3) + 8 * j; const LAS float* s = scr + (8 * c) * 68 + (n ^ ((c & 3) << 3));
        u32x4 o; o.x = pk2(s[0 * 68], s[1 * 68]); o.y = pk2(s[2 * 68], s[3 * 68]); o.z = pk2(s[4 * 68], s[5 * 68]); o.w = pk2(s[6 * 68], s[7 * 68]);
        *(u32x4*)(WT + (size_t)(n0 + n) * ldt + k0 + 8 * c) = o; }
    asm volatile("s_waitcnt lgkmcnt(0)" ::: "memory");
}
__device__ __forceinline__ void rms_row_to_bf16(const float* xrow, const float* g, bf16_t* orow, int lane) {
    const f32x4* xr = (const f32x4*)xrow + lane; const f32x4* gr = (const f32x4*)g + lane;
    f32x4 v[8]; float s = 0.f;
#pragma unroll
    for (int j = 0; j < 8; ++j) { v[j] = __builtin_nontemporal_load(xr + 64 * j); s += (v[j].x * v[j].x + v[j].y * v[j].y) + (v[j].z * v[j].z + v[j].w * v[j].w); }
    const float rs = 1.0f / sqrtf(wave_sum(s) * (1.0f / DM) + EPS);
    u32x2* o8 = (u32x2*)orow + lane;
#pragma unroll
    for (int j = 0; j < 8; ++j) { const f32x4 gg = gr[64 * j]; u32x2 w; w.x = pk2(v[j].x * rs * gg.x, v[j].y * rs * gg.y); w.y = pk2(v[j].z * rs * gg.z, v[j].w * rs * gg.w); o8[64 * j] = w; }
}
__device__ __forceinline__ void p0_prologue(const Params& P, LAS unsigned char* lds, int G, int wave, int lane) {
    LAS float* scr = (LAS float*)(lds + wave * 17408);
    const int gw = blockIdx.x * 8 + wave, NGW = G * 8;
    bf16_t* WinT = (bf16_t*)(P.ws + WS_WINT); bf16_t* WkvT = (bf16_t*)(P.ws + WS_WKVT);
    bf16_t* WrgT = (bf16_t*)(P.ws + WS_WRGT); bf16_t* WpT = (bf16_t*)(P.ws + WS_WPT);
    constexpr int I_WIN = 32 * 192, I_WKV = 32 * 32, I_RG = 2 * 8 * 4, I_WP = 4 * 16;
    constexpr int NITEMS = I_WIN + I_WKV + I_RG + I_WP;
    for (int it = gw; it < NITEMS; it += NGW) {
        int r = it;
        if (r < I_WIN) { p0_transpose_item(P.w_in, DIN, WinT, 2048, scr, r / 192, r % 192, lane); continue; } r -= I_WIN;
        if (r < I_WKV) { p0_transpose_item(P.w_kv, 2048, WkvT, 2048, scr, r / 32, r % 32, lane); continue; } r -= I_WKV;
        if (r < I_RG) { const int gate = r >> 5, blk = (r >> 2) & 7, sub = r & 3;
            p0_transpose_item((gate ? P.w_rg_x : P.w_rg_a) + blk * 16384, 128, WrgT + (size_t)(gate * 8 + blk) * 16384, 128, scr, sub >> 1, sub & 1, lane); continue; } r -= I_RG;
        { const int grp = r >> 4, sub = r & 15;
            p0_transpose_item(P.w_pool + grp * 65536, 256, WpT + (size_t)grp * 65536, 256, scr, sub >> 2, sub & 3, lane); }
    }
    { unsigned long long* GR = (unsigned long long*)(P.ws + WS_GR); for (int i = blockIdx.x * 512 + threadIdx.x; i < 4 * 8 * 16 * 128; i += G * 512) GR[i] = ~0ull; }
    bf16_t* U = (bf16_t*)(P.ws + WS_U); bf16_t* MEMN = (bf16_t*)(P.ws + WS_MEMN);
    for (int m = gw; m < MPAD + 1024; m += NGW) {
        if (m < MP) rms_row_to_bf16(P.x_prompt + (size_t)m * DM, P.g_pre, U + (size_t)m * DM, lane);
        else if (m < MTOT) rms_row_to_bf16(P.x_sample + (size_t)(m - MP) * DM, P.g_pre, U + (size_t)m * DM, lane);
        else if (m < MPAD) { u32x2* o8 = (u32x2*)(U + (size_t)m * DM) + lane;
#pragma unroll
            for (int j = 0; j < 8; ++j) o8[64 * j] = (u32x2){0u, 0u}; }
        else rms_row_to_bf16(P.mem + (size_t)(m - MPAD) * DM, P.g_mem, MEMN + (size_t)(m - MPAD) * DM, lane);
    }
}

__device__ __forceinline__ void deferred_prep(const Params& P, LAS unsigned char* lds, int G, int wave, int lane) {
    const int first = (G == 256) ? 80 : 0, nw = G - first;
    if ((int)blockIdx.x < first) return;
    LAS float* scr = (LAS float*)(lds + wave * 17408);
    const int gw = ((int)blockIdx.x - first) * 8 + wave, NGW = nw * 8;
    bf16_t* WbT = (bf16_t*)(P.ws + WS_WBT); bf16_t* WoT = (bf16_t*)(P.ws + WS_WOT);
    constexpr int I_WB = 48 * 32, I_WO = 32 * 32;
    for (int it = gw; it < I_WB + I_WO; it += NGW) {
        if (it < I_WB) p0_transpose_item(P.w_branch, 2048, WbT, 3072, scr, it / 32, it % 32, lane);
        else { const int r = it - I_WB; p0_transpose_item(P.w_out, 2048, WoT, 2048, scr, r / 32, r % 32, lane); }
    }
    for (int r = gw; r < NS * 14 + NS * 2; r += NGW) {
        const float* src; float* dst;
        if (r < NS * 14) { const int s = r / 14, k = r - 14 * s; src = P.st_pool + ((size_t)s * 15 + k + 1) * 1024; dst = P.out + OFF_NPS + ((size_t)s * 15 + k) * 1024; }
        else { const int q = r - NS * 14, s = q >> 1, k = q & 1; src = P.st_conv + ((size_t)s * 3 + k + 1) * 1024; dst = P.out + OFF_NCS + ((size_t)s * 3 + k) * 1024; }
#pragma unroll
        for (int j = 0; j < 4; ++j) __builtin_nontemporal_store(__builtin_nontemporal_load((const f32x4*)src + 64 * j + lane), (f32x4*)dst + 64 * j + lane);
    }
}

__device__ __forceinline__ f32x2 ldz2(const bf16_t* p) { const unsigned u = *(const unsigned*)p; return (f32x2){bf_lo(u), bf_hi(u)}; }
__device__ __forceinline__ f32x2 lds2(const LAS unsigned char* p) { const unsigned u = *(const LAS unsigned*)p; return (f32x2){bf_lo(u), bf_hi(u)}; }
__device__ __forceinline__ u32x4 mul_bf16x8(u32x4 a, u32x4 b) {
    u32x4 o; o.x = pk2(bf_lo(a.x) * bf_lo(b.x), bf_hi(a.x) * bf_hi(b.x)); o.y = pk2(bf_lo(a.y) * bf_lo(b.y), bf_hi(a.y) * bf_hi(b.y));
    o.z = pk2(bf_lo(a.z) * bf_lo(b.z), bf_hi(a.z) * bf_hi(b.z)); o.w = pk2(bf_lo(a.w) * bf_lo(b.w), bf_hi(a.w) * bf_hi(b.w)); return o;
}
__device__ __forceinline__ float one_minus_sq(float x, float a) {
    const float p = -x * (1.0f + x * (0.5f + x * 0.16666667f));
    const float d = __builtin_fmaf(-a, a, 1.0f);
    return x > -0.01f ? p : d;
}
constexpr unsigned long long GR_EMPTY = ~0ull;

template <bool SAMPLE>
__device__ __forceinline__ void rglru_unit(const Params& P, LAS unsigned char* lds, int b, int n, int c) {
    constexpr int NMT = SAMPLE ? 2 : 16;
    constexpr int NROW = NMT * 16;
    int tid_ = threadIdx.x; asm volatile("" : "+v"(tid_));
    const int tid = tid_, wid = __builtin_amdgcn_readfirstlane(tid >> 6), lane = tid & 63, fr = lane & 15, fq = lane >> 4;
    const bf16_t* Z = (const bf16_t*)(P.ws + WS_Z); bf16_t* OALL = (bf16_t*)(P.ws + WS_OALL); const bf16_t* WrgT = (const bf16_t*)(P.ws + WS_WRGT);
    unsigned long long* GR = (unsigned long long*)(P.ws + WS_GR);
    constexpr int XS = 272;
    LAS unsigned char* XR = lds; LAS unsigned char* HO = lds; LAS unsigned char* XC = lds + 259 * XS;
    const int rowbase = SAMPLE ? MP + 32 * c : b * SEQ + c * 256;
    __syncthreads();
    if (!SAMPLE) {
        u32x4 xv[9];
#pragma unroll
        for (int i = 0; i < 9; ++i) { const int v = tid + 512 * i, row = v >> 4, cv = v & 15; int t = c * 256 - 3 + row; t = t < 0 ? 0 : (t > SEQ - 1 ? SEQ - 1 : t);
            xv[i] = __builtin_nontemporal_load((const u32x4*)(Z + (size_t)(b * SEQ + t) * DIN + ZC_XR + n * 128 + cv * 8)); }
#pragma unroll
        for (int i = 0; i < 9; ++i) { const int v = tid + 512 * i, row = v >> 4, cv = v & 15; const bool neg = (c * 256 - 3 + row) < 0;
            if (row < 259) *(LAS u32x4*)(XR + row * XS + cv * 16) = neg ? (u32x4){0u, 0u, 0u, 0u} : xv[i]; }
    }
    bf16x8 wa[4], wx[4];
    { const bf16_t* pa = WrgT + ((size_t)(0 * 8 + n) * 128 + 16 * wid + fr) * 128 + 8 * fq; const bf16_t* px = WrgT + ((size_t)(1 * 8 + n) * 128 + 16 * wid + fr) * 128 + 8 * fq;
#pragma unroll
      for (int ks = 0; ks < 4; ++ks) { wa[ks] = *(const bf16x8*)(pa + 32 * ks); wx[ks] = *(const bf16x8*)(px + 32 * ks); } }
    const int e = n * 128 + 16 * wid + fr;
    const float c8 = -8.0f * log1pf(expf(-P.lam[e]));
    const float nbaL = -P.b_rg_a[e] * LOG2E, nbxL = -P.b_rg_x[e] * LOG2E, c8L = c8 * LOG2E, c82 = 2.0f * c8;
    {
      const int cp = tid & 63, seg = tid >> 6, ch = n * 128 + 2 * cp;
      const f32x2 w0 = *(const f32x2*)(P.conv_w + 0 * 1024 + ch), w1 = *(const f32x2*)(P.conv_w + 1 * 1024 + ch), w2 = *(const f32x2*)(P.conv_w + 2 * 1024 + ch), w3 = *(const f32x2*)(P.conv_w + 3 * 1024 + ch);
      const f32x2 cb = *(const f32x2*)(P.conv_b + ch);
      if (!SAMPLE) {
          __syncthreads();
          const int r0 = 32 * seg;
          f32x2 x3 = lds2(XR + (r0 + 0) * XS + 4 * cp), x2 = lds2(XR + (r0 + 1) * XS + 4 * cp), x1 = lds2(XR + (r0 + 2) * XS + 4 * cp);
#pragma unroll 8
          for (int i = 0; i < 32; ++i) { const int t = c * 256 + r0 + i;
              const f32x2 x0 = lds2(XR + (r0 + i + 3) * XS + 4 * cp);
              const f32x2 xc = cb + w0 * x3 + w1 * x2 + w2 * x1 + w3 * x0;
              *(LAS unsigned*)(XC + (r0 + i) * XS + 4 * cp) = pk2(xc.x, xc.y);
              if (t >= SEQ - 3) *(f32x2*)(P.out + OFF_NCP + (size_t)(b * 3 + (t - (SEQ - 3))) * 1024 + ch) = x0;
              x3 = x2; x2 = x1; x1 = x0; }
      } else {
#pragma unroll
          for (int i = 0; i < 4; ++i) { const int sl = 4 * seg + i, s = 32 * c + sl;
              const f32x2 x3 = *(const f32x2*)(P.st_conv + (size_t)(s * 3 + 0) * 1024 + ch), x2 = *(const f32x2*)(P.st_conv + (size_t)(s * 3 + 1) * 1024 + ch), x1 = *(const f32x2*)(P.st_conv + (size_t)(s * 3 + 2) * 1024 + ch);
              const f32x2 x0 = ldz2(Z + (size_t)(MP + s) * DIN + ZC_XR + ch);
              const f32x2 xc = cb + w0 * x3 + w1 * x2 + w2 * x1 + w3 * x0;
              *(LAS unsigned*)(XC + sl * XS + 4 * cp) = pk2(xc.x, xc.y);
              *(f32x2*)(P.out + OFF_NCS + (size_t)(s * 3 + 2) * 1024 + ch) = x0; }
      } }
    __syncthreads();
    unsigned cumA[NMT][2], hloc[NMT][2];
    float Ac = 1.f, Hc = 0.f;
#pragma unroll
    for (int mt = 0; mt < NMT; ++mt) {
        f32x4 racc = (f32x4){0.f, 0.f, 0.f, 0.f}, iacc = racc;
#pragma unroll
        for (int ks = 0; ks < 4; ++ks) { const bf16x8 a = *(const LAS bf16x8*)(XC + (16 * mt + fr) * XS + (32 * ks + 8 * fq) * 2);
            racc = __builtin_amdgcn_mfma_f32_16x16x32_bf16(a, wa[ks], racc, 0, 0, 0); iacc = __builtin_amdgcn_mfma_f32_16x16x32_bf16(a, wx[ks], iacc, 0, 0, 0); }
        float av[4], bv[4];
#pragma unroll
        for (int j = 0; j < 4; ++j) { const int row = 16 * mt + 4 * fq + j;
            const float r = __builtin_amdgcn_rcpf(1.0f + __builtin_amdgcn_exp2f(__builtin_fmaf(racc[j], -LOG2E, nbaL)));
            const float ig = __builtin_amdgcn_rcpf(1.0f + __builtin_amdgcn_exp2f(__builtin_fmaf(iacc[j], -LOG2E, nbxL)));
            av[j] = __builtin_amdgcn_exp2f(c8L * r);
            const float mult = __builtin_amdgcn_sqrtf(one_minus_sq(c82 * r, av[j]));
            const float xcv = bf2f(*(const LAS bf16_t*)(XC + row * XS + (16 * wid + fr) * 2));
            bv[j] = mult * ig * xcv; }
        if (!SAMPLE) {
            float Pj[4], Qj[4]; float pp = 1.f, qq = 0.f;
#pragma unroll
            for (int j = 0; j < 4; ++j) { qq = av[j] * qq + bv[j]; pp = av[j] * pp; Pj[j] = pp; Qj[j] = qq; }
            float Arun = Ac, Hrun = Hc, Ain = 1.f, Hin = 0.f;
#pragma unroll
            for (int g = 0; g < 4; ++g) { const float pg = __shfl(pp, fr + 16 * g), qg = __shfl(qq, fr + 16 * g); if (g == fq) { Ain = Arun; Hin = Hrun; } Hrun = pg * Hrun + qg; Arun = pg * Arun; }
            Ac = Arun; Hc = Hrun;
            cumA[mt][0] = cvt_pk_bf16(Pj[0] * Ain, Pj[1] * Ain); cumA[mt][1] = cvt_pk_bf16(Pj[2] * Ain, Pj[3] * Ain);
            hloc[mt][0] = cvt_pk_bf16(Pj[0] * Hin + Qj[0], Pj[1] * Hin + Qj[1]); hloc[mt][1] = cvt_pk_bf16(Pj[2] * Hin + Qj[2], Pj[3] * Hin + Qj[3]);
        } else {
            const int s0 = 32 * c + 16 * mt + 4 * fq;
            float hv[4];
#pragma unroll
            for (int j = 0; j < 4; ++j) { const float h0 = P.st_h[(size_t)(s0 + j) * 1024 + e]; hv[j] = av[j] * h0 + bv[j]; P.out[OFF_NHS + (size_t)(s0 + j) * 1024 + e] = hv[j]; }
            cumA[mt][0] = 0u; cumA[mt][1] = 0u; hloc[mt][0] = cvt_pk_bf16(hv[0], hv[1]); hloc[mt][1] = cvt_pk_bf16(hv[2], hv[3]);
        }
    }
    u32x4 gg[NROW / 32];
#pragma unroll
    for (int i = 0; i < NROW / 32; ++i) { const int v = tid + 512 * i, row = v >> 4, cv = v & 15; gg[i] = __builtin_nontemporal_load((const u32x4*)(Z + (size_t)(rowbase + row) * DIN + ZC_GR + n * 128 + cv * 8)); }
    float carry = 0.f;
    if (!SAMPLE) {
        unsigned long long* gbase = GR + (size_t)((b * 8 + n) * 8) * 128 + 16 * wid + fr;
        if (fq == 0) __hip_atomic_store(gbase + (size_t)c * 128, ((unsigned long long)__builtin_bit_cast(unsigned, Hc) << 32) | (unsigned long long)__builtin_bit_cast(unsigned, Ac), __ATOMIC_RELAXED, __HIP_MEMORY_SCOPE_AGENT);
        if (c > 0) {
            unsigned long long g[7]; unsigned spins = 0;
            for (;;) { bool ok = true;
#pragma unroll
                for (int cc = 0; cc < 7; ++cc) { g[cc] = __hip_atomic_load(gbase + (size_t)cc * 128, __ATOMIC_RELAXED, __HIP_MEMORY_SCOPE_AGENT); }
#pragma unroll
                for (int cc = 0; cc < 7; ++cc) ok = ok && (cc >= c || g[cc] != GR_EMPTY);
                if (__all(ok) || ++spins > (1u << 20)) break;
                __builtin_amdgcn_s_sleep(2); }
#pragma unroll
            for (int cc = 0; cc < 7; ++cc) { const float ga = __builtin_bit_cast(float, (unsigned)g[cc]), gh = __builtin_bit_cast(float, (unsigned)(g[cc] >> 32)); const float nc = ga * carry + gh; carry = (cc < c) ? nc : carry; }
        }
        if (c == 7 && fq == 0) P.out[OFF_NHP + (size_t)b * 1024 + e] = Ac * carry + Hc;
    }
#pragma unroll
    for (int mt = 0; mt < NMT; ++mt)
#pragma unroll
        for (int j = 0; j < 4; ++j) { const int row = 16 * mt + 4 * fq + j;
            const unsigned ca = cumA[mt][j >> 1], hl = hloc[mt][j >> 1];
            const float h = ((j & 1) ? bf_hi(ca) : bf_lo(ca)) * carry + ((j & 1) ? bf_hi(hl) : bf_lo(hl));
            *(LAS bf16_t*)(HO + row * XS + (16 * wid + fr) * 2) = (bf16_t)f2bf(h); }
    __syncthreads();
    {
#pragma unroll
      for (int i = 0; i < NROW / 32; ++i) { const int v = tid + 512 * i, row = v >> 4, cv = v & 15;
          const u32x4 ho = *(const LAS u32x4*)(HO + row * XS + cv * 16);
          *(u32x4*)(OALL + (size_t)(rowbase + row) * DMIX + n * 128 + cv * 8) = mul_bf16x8(ho, gg[i]); } }
}

template <bool SAMPLE>
__device__ __forceinline__ void pool_unit(const Params& P, LAS unsigned char* lds, int b, int g, int blk) {
    int tid_ = threadIdx.x; asm volatile("" : "+v"(tid_));
    const int tid = tid_, wid = __builtin_amdgcn_readfirstlane(tid >> 6), lane = tid & 63, fr = lane & 15, fq = lane >> 4;
    const bf16_t* Z = (const bf16_t*)(P.ws + WS_Z); bf16_t* OALL = (bf16_t*)(P.ws + WS_OALL); const bf16_t* WpT = (const bf16_t*)(P.ws + WS_WPT);
    constexpr int DS = 528;
    LAS unsigned char* XP = lds; LAS unsigned char* OUT = lds; LAS unsigned char* D = lds + 144 * DS;
    const int W = 2 << g;
    const int rowbase = SAMPLE ? MP + 16 * blk : b * SEQ + blk * 128;
    const int nmt = SAMPLE ? 1 : 8;
    __syncthreads();
    if (!SAMPLE) {
        u32x4 xv[9];
#pragma unroll
        for (int i = 0; i < 9; ++i) { const int v = tid + 512 * i, row = v >> 5, cv = v & 31; int t = blk * 128 - 15 + row; t = t < 0 ? 0 : (t > SEQ - 1 ? SEQ - 1 : t);
            xv[i] = __builtin_nontemporal_load((const u32x4*)(Z + (size_t)(b * SEQ + t) * DIN + ZC_XP + g * 256 + cv * 8)); }
#pragma unroll
        for (int i = 0; i < 9; ++i) { const int v = tid + 512 * i, row = v >> 5, cv = v & 31; const bool neg = (blk * 128 - 15 + row) < 0;
            *(LAS u32x4*)(XP + row * DS + cv * 16) = neg ? (u32x4){0u, 0u, 0u, 0u} : xv[i]; }
        __syncthreads();
    }
    { const int cp = tid & 127, seg = tid >> 7, ch = g * 256 + 2 * cp;
      if (!SAMPLE) {
          const int r0 = 15 + 32 * seg;
          f32x2 s = (f32x2){0.f, 0.f};
          for (int k = 1; k < W; ++k) s += lds2(XP + (r0 - k) * DS + 4 * cp);
#pragma unroll 8
          for (int i = 0; i < 32; ++i) { const int t = blk * 128 + 32 * seg + i;
              const f32x2 x0 = lds2(XP + (r0 + i) * DS + 4 * cp); s += x0;
              const float inv = 1.0f / (float)((t + 1) < W ? (t + 1) : W);
              const f32x2 d = s * inv - x0;
              *(LAS unsigned*)(D + (32 * seg + i) * DS + 4 * cp) = pk2(d.x, d.y);
              s -= lds2(XP + (r0 + i - W + 1) * DS + 4 * cp);
              if (t >= SEQ - 15) *(f32x2*)(P.out + OFF_NPP + (size_t)(b * 15 + (t - (SEQ - 15))) * 1024 + ch) = x0; }
      } else {
          const float inv = 1.0f / (float)W;
#pragma unroll
          for (int i = 0; i < 4; ++i) { const int sl = seg + 4 * i, s_ = 16 * blk + sl;
              const f32x2 x0 = ldz2(Z + (size_t)(MP + s_) * DIN + ZC_XP + ch);
              const float* hp = P.st_pool + (size_t)s_ * 15 * 1024 + ch;
              f32x2 hv[15];
#pragma unroll
              for (int k = 1; k < 16; ++k) hv[k - 1] = *(const f32x2*)(hp + (size_t)(15 - k) * 1024);
              f32x2 s = x0;
#pragma unroll
              for (int k = 1; k < 16; ++k) { const f32x2 a = s + hv[k - 1]; s = (k < W) ? a : s; }
              *(f32x2*)(P.out + OFF_NPS + ((size_t)s_ * 15 + 14) * 1024 + ch) = x0;
              const f32x2 d = s * inv - x0;
              *(LAS unsigned*)(D + sl * DS + 4 * cp) = pk2(d.x, d.y); }
      } }
    __syncthreads();
    u32x4 ggp[SAMPLE ? 1 : 8];
#pragma unroll
    for (int i = 0; i < (SAMPLE ? 1 : 8); ++i) { const int v = tid + 512 * i, row = v >> 5, cv = v & 31;
        ggp[i] = __builtin_nontemporal_load((const u32x4*)(Z + (size_t)(rowbase + row) * DIN + ZC_GP + g * 256 + cv * 8)); }
    {
      bf16x8 bw[2][8];
#pragma unroll
      for (int nt = 0; nt < 2; ++nt) { const bf16_t* pw = WpT + ((size_t)g * 256 + 32 * wid + 16 * nt + fr) * 256 + 8 * fq;
#pragma unroll
          for (int ks = 0; ks < 8; ++ks) bw[nt][ks] = *(const bf16x8*)(pw + 32 * ks); }
      const float ps0 = P.pool_scale[g * 256 + 32 * wid + fr], ps1 = P.pool_scale[g * 256 + 32 * wid + 16 + fr];
#pragma unroll 2
      for (int mt = 0; mt < nmt; ++mt) {
          f32x4 a0 = (f32x4){0.f, 0.f, 0.f, 0.f}, a1 = a0;
#pragma unroll
          for (int ks = 0; ks < 8; ++ks) { const bf16x8 a = *(const LAS bf16x8*)(D + (16 * mt + fr) * DS + (32 * ks + 8 * fq) * 2);
              a0 = __builtin_amdgcn_mfma_f32_16x16x32_bf16(a, bw[0][ks], a0, 0, 0, 0); a1 = __builtin_amdgcn_mfma_f32_16x16x32_bf16(a, bw[1][ks], a1, 0, 0, 0); }
#pragma unroll
          for (int j = 0; j < 4; ++j) { const int row = 16 * mt + 4 * fq + j;
              *(LAS bf16_t*)(OUT + row * DS + (32 * wid + fr) * 2) = (bf16_t)f2bf(a0[j] * ps0); *(LAS bf16_t*)(OUT + row * DS + (32 * wid + 16 + fr) * 2) = (bf16_t)f2bf(a1[j] * ps1); }
      } }
    __syncthreads();
#pragma unroll
    for (int i = 0; i < (SAMPLE ? 1 : 8); ++i) { const int v = tid + 512 * i, row = v >> 5, cv = v & 31;
        const u32x4 ho = *(const LAS u32x4*)(OUT + row * DS + cv * 16);
        *(u32x4*)(OALL + (size_t)(rowbase + row) * DMIX + 1024 + g * 256 + cv * 8) = mul_bf16x8(ho, ggp[i]); }
}

__device__ __forceinline__ void attn_stage(LAS unsigned char* lds, const bf16_t* src  , int wid, int lane) {
#pragma unroll
    for (int i = 0; i < 16; ++i) { const int piece = wid * 16 + i, row = 2 * piece + (lane >> 5), p = lane & 31;
        __builtin_amdgcn_global_load_lds((const unsigned*)(src + (size_t)row * 1024 + ((p ^ (row & 15)) << 3)), (LAS unsigned*)(lds + piece * 1024), 16, 0, 0); }
}
__device__ __forceinline__ void attn_unit(const Params& P, LAS unsigned char* lds, int b, int h, int blk) {
    int tid_ = threadIdx.x; asm volatile("" : "+v"(tid_));
    const int tid = tid_, wid = __builtin_amdgcn_readfirstlane(tid >> 6), lane = tid & 63, fr = lane & 15, fq = lane >> 4;
    const bf16_t* Z = (const bf16_t*)(P.ws + WS_Z); bf16_t* OALL = (bf16_t*)(P.ws + WS_OALL); const bf16_t* KB = (const bf16_t*)(P.ws + WS_KB); const bf16_t* VT = (const bf16_t*)(P.ws + WS_VT);
    const int m0 = b * SEQ + blk * 128 + 16 * wid;
    __syncthreads();
    attn_stage(lds, KB + (size_t)(b * 256) * 1024 + h * 256, wid, lane);
    bf16x8 qf[8];
    { const bf16_t* qp = Z + (size_t)(m0 + fr) * DIN + ZC_Q + h * 256 + 8 * fq;
#pragma unroll
      for (int ks = 0; ks < 8; ++ks) qf[ks] = *(const bf16x8*)(qp + 32 * ks); }
    asm volatile("s_waitcnt vmcnt(0)" ::: "memory");
    __syncthreads();
    f32x4 st[16];
#pragma unroll
    for (int t = 0; t < 16; ++t) { f32x4 a = (f32x4){0.f, 0.f, 0.f, 0.f};
#pragma unroll
        for (int ks = 0; ks < 8; ++ks) { const bf16x8 kf = *(const LAS bf16x8*)(lds + (16 * t + fr) * 512 + (((4 * ks + fq) ^ fr) << 4)); a = __builtin_amdgcn_mfma_f32_16x16x32_bf16(kf, qf[ks], a, 0, 0, 0); }
        st[t] = a; }
    __syncthreads();
    attn_stage(lds, VT + (size_t)(h * 256) * 1024 + b * 256, wid, lane);
    float mx = -3.0e38f;
#pragma unroll
    for (int t = 0; t < 16; ++t) mx = fmaxf(mx, fmaxf(fmaxf(st[t][0], st[t][1]), fmaxf(st[t][2], st[t][3])));
    mx = fmaxf(mx, __shfl_xor(mx, 16)); mx = fmaxf(mx, __shfl_xor(mx, 32));
    const float sc = LOG2E * 0.0625f; float sum = 0.f;
#pragma unroll
    for (int t = 0; t < 16; ++t)
#pragma unroll
        for (int j = 0; j < 4; ++j) { const float p = __builtin_amdgcn_exp2f((st[t][j] - mx) * sc); st[t][j] = p; sum += p; }
    sum += __shfl_xor(sum, 16); sum += __shfl_xor(sum, 32);
    const float inv = 1.0f / sum;
    bf16x8 pf[8];
#pragma unroll
    for (int s = 0; s < 8; ++s) { u32x4 w; w.x = cvt_pk_bf16(st[2 * s][0], st[2 * s][1]); w.y = cvt_pk_bf16(st[2 * s][2], st[2 * s][3]); w.z = cvt_pk_bf16(st[2 * s + 1][0], st[2 * s + 1][1]); w.w = cvt_pk_bf16(st[2 * s + 1][2], st[2 * s + 1][3]);
        pf[s] = __builtin_bit_cast(bf16x8, w); }
    asm volatile("s_waitcnt vmcnt(0)" ::: "memory");
    __syncthreads();
    u32x4 gg[8];
#pragma unroll
    for (int i = 0; i < 8; ++i) { const int v = lane + 64 * i, row = v >> 5, cv = v & 31; gg[i] = __builtin_nontemporal_load((const u32x4*)(Z + (size_t)(m0 + row) * DIN + ZC_GX + h * 256 + cv * 8)); }
    u32x2 ov[16];
#pragma unroll
    for (int dt = 0; dt < 16; ++dt) { f32x4 a = (f32x4){0.f, 0.f, 0.f, 0.f};
#pragma unroll
        for (int s = 0; s < 8; ++s) { const LAS unsigned char* rp = lds + (16 * dt + fr) * 512 + 8 * (fq & 1);
            const u32x2 lo = *(const LAS u32x2*)(rp + (((4 * s + (fq >> 1)) ^ fr) << 4)), hi = *(const LAS u32x2*)(rp + (((4 * s + 2 + (fq >> 1)) ^ fr) << 4));
            const u32x4 w = (u32x4){lo.x, lo.y, hi.x, hi.y};
            a = __builtin_amdgcn_mfma_f32_16x16x32_bf16(__builtin_bit_cast(bf16x8, w), pf[s], a, 0, 0, 0); }
        ov[dt].x = pk2(a[0] * inv, a[1] * inv); ov[dt].y = pk2(a[2] * inv, a[3] * inv); }
    __syncthreads();
#pragma unroll
    for (int dt = 0; dt < 16; ++dt) *(LAS u32x2*)(lds + (16 * wid + fr) * 528 + (16 * dt + 4 * fq) * 2) = ov[dt];
    asm volatile("s_waitcnt lgkmcnt(0)" ::: "memory");
    {
#pragma unroll
      for (int i = 0; i < 8; ++i) { const int v = lane + 64 * i, row = v >> 5, cv = v & 31;
          const u32x4 ho = *(const LAS u32x4*)(lds + (16 * wid + row) * 528 + cv * 16);
          *(u32x4*)(OALL + (size_t)(m0 + row) * DMIX + 2048 + h * 256 + cv * 8) = mul_bf16x8(ho, gg[i]); } }
}

__device__ __forceinline__ void sattn_unit(const Params& P, LAS unsigned char* lds, int s, int h) {
    int tid_ = threadIdx.x; asm volatile("" : "+v"(tid_));
    const int tid = tid_, wid = __builtin_amdgcn_readfirstlane(tid >> 6), lane = tid & 63;
    const bf16_t* Z = (const bf16_t*)(P.ws + WS_Z); bf16_t* OALL = (bf16_t*)(P.ws + WS_OALL);
    LAS float* SC = (LAS float*)lds; LAS float* PS = SC + 256; LAS float* PO = PS + 256;
    __syncthreads();
    f32x4 q4;
    { const u32x2 qq = *(const u32x2*)(Z + (size_t)(MP + s) * DIN + ZC_Q + h * 256 + 4 * lane); q4 = (f32x4){bf_lo(qq.x), bf_hi(qq.x), bf_lo(qq.y), bf_hi(qq.y)}; }
    const float* kb = P.cache_k + ((size_t)(s * 256 + 32 * wid) * 4 + h) * 256 + 4 * lane;
    const float* vb = P.cache_v + ((size_t)(s * 256 + 32 * wid) * 4 + h) * 256 + 4 * lane;
    float mysc = 0.f;
    f32x4 v4[32];
    { f32x4 k4[32];
#pragma unroll
      for (int i = 0; i < 32; ++i) k4[i] = __builtin_nontemporal_load((const f32x4*)(kb + (size_t)i * 1024));
#pragma unroll
      for (int i = 0; i < 16; ++i) v4[i] = __builtin_nontemporal_load((const f32x4*)(vb + (size_t)i * 1024));
      float p[32];
#pragma unroll
      for (int i = 0; i < 32; ++i) p[i] = (k4[i].x * q4.x + k4[i].y * q4.y) + (k4[i].z * q4.z + k4[i].w * q4.w);
      float q16[16], q8[8], q4v[4], q2[2];
      { const bool hi = (lane & 32) != 0;
#pragma unroll
        for (int j = 0; j < 16; ++j) { const float send = hi ? p[j] : p[j + 16], keep = hi ? p[j + 16] : p[j]; q16[j] = keep + __shfl_xor(send, 32); } }
      { const bool hi = (lane & 16) != 0;
#pragma unroll
        for (int j = 0; j < 8; ++j) { const float send = hi ? q16[j] : q16[j + 8], keep = hi ? q16[j + 8] : q16[j]; q8[j] = keep + __shfl_xor(send, 16); } }
      { const bool hi = (lane & 8) != 0;
#pragma unroll
        for (int j = 0; j < 4; ++j) { const float send = hi ? q8[j] : q8[j + 4], keep = hi ? q8[j + 4] : q8[j]; q4v[j] = keep + __shfl_xor(send, 8); } }
      { const bool hi = (lane & 4) != 0;
#pragma unroll
        for (int j = 0; j < 2; ++j) { const float send = hi ? q4v[j] : q4v[j + 2], keep = hi ? q4v[j + 2] : q4v[j]; q2[j] = keep + __shfl_xor(send, 4); } }
      { const bool hi = (lane & 2) != 0; const float send = hi ? q2[0] : q2[1], keep = hi ? q2[1] : q2[0]; mysc = keep + __shfl_xor(send, 2); }
      mysc += __shfl_xor(mysc, 1); }
#pragma unroll
    for (int i = 16; i < 32; ++i) v4[i] = __builtin_nontemporal_load((const f32x4*)(vb + (size_t)i * 1024));
    if ((lane & 1) == 0) SC[32 * wid + (lane >> 1)] = mysc;
    __syncthreads();
    { float v[4]; float mx = -3.0e38f;
#pragma unroll
      for (int k = 0; k < 4; ++k) { v[k] = SC[lane + 64 * k]; mx = fmaxf(mx, v[k]); }
      mx = wave_max(mx); float sum = 0.f; const float sc = LOG2E * 0.0625f;
#pragma unroll
      for (int k = 0; k < 4; ++k) { v[k] = __builtin_amdgcn_exp2f((v[k] - mx) * sc); sum += v[k]; }
      sum = wave_sum(sum); const float inv = 1.0f / sum;
      if (wid == 0) {
#pragma unroll
          for (int k = 0; k < 4; ++k) PS[lane + 64 * k] = v[k] * inv; } }
    __syncthreads();
    { f32x4 a = (f32x4){0.f, 0.f, 0.f, 0.f};
#pragma unroll
      for (int i = 0; i < 32; ++i) { const float p = PS[32 * wid + i]; a += v4[i] * p; }
      *(LAS f32x4*)(PO + wid * 256 + 4 * lane) = a; }
    __syncthreads();
    if (tid < 256) { float o = 0.f;
#pragma unroll
        for (int w = 0; w < 8; ++w) o += PO[w * 256 + tid];
        const float gx = bf2f(Z[(size_t)(MP + s) * DIN + ZC_GX + h * 256 + tid]);
        OALL[(size_t)(MP + s) * DMIX + 2048 + h * 256 + tid] = (bf16_t)f2bf(o * gx); }
}

__device__ __forceinline__ void p5_rows(const Params& P, int m0, int mstep, int mend, int lane) {
    const bf16_t* OUTB = (const bf16_t*)(P.ws + WS_OUTB);
    for (int m = m0; m < mend; m += mstep) {
        const u32x4* orow = (const u32x4*)(OUTB + (size_t)m * DM) + lane;
        const f32x4* xrow = (const f32x4*)(m < MP ? P.x_prompt + (size_t)m * DM : P.x_sample + (size_t)(m - MP) * DM) + 2 * lane;
        const f32x4* gr = (const f32x4*)P.g_post + 2 * lane;
        u32x4 v[4]; f32x4 xa[4], xb[4]; float s = 0.f;
#pragma unroll
        for (int j = 0; j < 4; ++j) { v[j] = orow[64 * j]; xa[j] = xrow[128 * j]; xb[j] = xrow[128 * j + 1]; }
#pragma unroll
        for (int j = 0; j < 4; ++j) { const float a0 = bf_lo(v[j].x), a1 = bf_hi(v[j].x), a2 = bf_lo(v[j].y), a3 = bf_hi(v[j].y), a4 = bf_lo(v[j].z), a5 = bf_hi(v[j].z), a6 = bf_lo(v[j].w), a7 = bf_hi(v[j].w);
            s += ((a0 * a0 + a1 * a1) + (a2 * a2 + a3 * a3)) + ((a4 * a4 + a5 * a5) + (a6 * a6 + a7 * a7)); }
        const float rs = 1.0f / sqrtf(wave_sum(s) * (1.0f / DM) + EPS);
        f32x4* yrow = (f32x4*)(P.out + OFF_Y + (size_t)m * DM) + 2 * lane;
#pragma unroll
        for (int j = 0; j < 4; ++j) { const f32x4 g0 = gr[128 * j], g1 = gr[128 * j + 1];
            const f32x4 o0 = (f32x4){bf_lo(v[j].x), bf_hi(v[j].x), bf_lo(v[j].y), bf_hi(v[j].y)}, o1 = (f32x4){bf_lo(v[j].z), bf_hi(v[j].z), bf_lo(v[j].w), bf_hi(v[j].w)};
            yrow[128 * j] = xa[j] + o0 * rs * g0; yrow[128 * j + 1] = xb[j] + o1 * rs * g1; }
    }
}

__global__ void __launch_bounds__(512, 2) fwd_kernel(Params P) {
    extern __shared__ __attribute__((aligned(16))) unsigned char lds_raw[];
    LAS unsigned char* lds = (LAS unsigned char*)lds_raw;
    cg::grid_group grid = cg::this_grid();
    const int tid = threadIdx.x, lane = tid & 63, wave = __builtin_amdgcn_readfirstlane(tid >> 6);
    const int G = gridDim.x;
    const int lo = P.ph_lo, hi = P.ph_hi;
    volatile LAS unsigned* MISC = (volatile LAS unsigned*)(lds + LDS_MISC_OFF);
    if (tid < 16) MISC[tid] = 0u;
    __syncthreads();
    const XcdBarrier xbar = xcd_barrier_post((unsigned*)(P.ws + WS_CTL), MISC);
#define GSYNC(k) do { if (USE_CG_SEAM(k)) grid.sync(); else xcd_barrier(xbar); } while (0)
#define IN(k) (lo <= (k) && (k) < hi)
#define BOTH(k) (IN(k) && IN((k) + 1))
    if (IN(0)) { if (PROBE_REPEAT == 0) { p0_prologue(P, lds, G, wave, lane); GSYNC(9); } p0_prologue(P, lds, G, wave, lane); if (BOTH(0)) GSYNC(0); }
    if (IN(1)) {
        SchedP1 S; S.mode = 0; S.G = G; S.c = blockIdx.x; S.to.init(32, 48); S.U = (const char*)(P.ws + WS_U); S.WinT = (const char*)(P.ws + WS_WINT); S.MEMN = (const char*)(P.ws + WS_MEMN); S.WkvT = (const char*)(P.ws + WS_WKVT);
        EpiP1T<false> E; E.Z = (bf16_t*)(P.ws + WS_Z); E.out = P.out; E.KB = (bf16_t*)(P.ws + WS_KB); E.VT = (bf16_t*)(P.ws + WS_VT); E.slabs = (float*)(P.ws + WS_OALL); E.cnt = (unsigned*)(P.ws + WS_CTL) + CW_CNT + 64 * CNT_P1S; E.misc = MISC; E.done = (unsigned*)(P.ws + WS_CTL) + CW_DONE;
        if (PROBE_REPEAT == 1) { pg8::gemm_phase<EpiP1T<false>, SchedP1>(lds, 2048, 2048, S, E); GSYNC(9); }
        pg8::gemm_phase<EpiP1T<false>, SchedP1>(lds, 2048, 2048, S, E);
        if (BOTH(1)) GSYNC(9);
    }
    if (IN(2)) {
        constexpr int U_RGP = 256, U_RGS = 32, U_ATT = 256, U_PP = 256, U_PS = 32, U_SA = 512;
        constexpr int NU = U_RGP + U_RGS + U_ATT + U_PP + U_PS + U_SA;
        unsigned* done = (unsigned*)(P.ws + WS_CTL) + CW_DONE;
        { SchedP1 S; S.mode = 1; S.G = G; S.c = blockIdx.x; S.to.init(32, 48); S.U = (const char*)(P.ws + WS_U); S.WinT = (const char*)(P.ws + WS_WINT); S.MEMN = (const char*)(P.ws + WS_MEMN); S.WkvT = (const char*)(P.ws + WS_WKVT);
          EpiP1T<true> E; E.Z = (bf16_t*)(P.ws + WS_Z); E.out = P.out; E.KB = (bf16_t*)(P.ws + WS_KB); E.VT = (bf16_t*)(P.ws + WS_VT); E.slabs = (float*)(P.ws + WS_PART); E.cnt = (unsigned*)(P.ws + WS_CTL) + CW_CNT + 64 * CNT_P1S; E.misc = MISC; E.done = done;
          pg8::gemm_phase<EpiP1T<true>, SchedP1>(lds, 2048, 2048, S, E); }
        if (G == 256) {
            const int c = blockIdx.x;
            deferred_prep(P, lds, G, wave, lane);
            pool_unit<false>(P, lds, c >> 6, (c >> 4) & 3, c & 15);
            rglru_unit<false>(P, lds, c >> 6, (c >> 3) & 7, c & 7);
            wait_done(done);
            attn_unit(P, lds, c >> 6, (c >> 4) & 3, c & 15);
            {
              const int s0 = c < 80 ? c : (c < 160 ? 80 + 3 * (c - 80) : 320 + 2 * (c - 160)), ns = c < 80 ? 1 : (c < 160 ? 3 : 2);
              for (int k = 0; k < ns; ++k) sattn_unit(P, lds, (s0 + k) >> 2, (s0 + k) & 3); }
            if (c >= 224) rglru_unit<true>(P, lds, 0, (c - 224) >> 2, (c - 224) & 3);
            else if (c >= 192) pool_unit<true>(P, lds, 0, (c - 192) >> 3, (c - 192) & 7);
        } else {
        deferred_prep(P, lds, G, wave, lane);
        wait_done(done);
        for (int u = blockIdx.x; u < NU; u += G) {
            int r = u;
            if (r < U_RGP) { rglru_unit<false>(P, lds, r >> 6, (r >> 3) & 7, r & 7); continue; } r -= U_RGP;
            if (r < U_RGS) { rglru_unit<true>(P, lds, 0, r >> 2, r & 3); continue; } r -= U_RGS;
            if (r < U_ATT) { attn_unit(P, lds, r >> 6, (r >> 4) & 3, r & 15); continue; } r -= U_ATT;
            if (r < U_PP) { pool_unit<false>(P, lds, r >> 6, (r >> 4) & 3, r & 15); continue; } r -= U_PP;
            if (r < U_PS) { pool_unit<true>(P, lds, 0, r >> 3, r & 7); continue; } r -= U_PS;
            sattn_unit(P, lds, r >> 2, r & 3);
        }
        }
        __syncthreads();
        if (BOTH(2)) GSYNC(9);
    }
    if (IN(3)) {
        SchedP3 S; S.G = G; S.c = blockIdx.x; S.to.init(32, 8); S.OALL = (const char*)(P.ws + WS_OALL); S.WbT = (const char*)(P.ws + WS_WBT);
        EpiP3 E; E.Z = (const bf16_t*)(P.ws + WS_Z); E.PART = (bf16_t*)(P.ws + WS_PART); E.MERGED = (bf16_t*)(P.ws + WS_MERGED); E.slabs = (float*)(P.ws + WS_U); E.cnt = (unsigned*)(P.ws + WS_CTL) + CW_CNT + 64 * CNT_P3S; E.misc = MISC; E.done3 = (unsigned*)(P.ws + WS_CTL) + CW_DONE + 128;
        pg8::gemm_phase<EpiP3, SchedP3>(lds, DMIX, DMIX, S, E);
        if (BOTH(3) && !IN(4)) GSYNC(9);
    }
    if (IN(4)) {
        SchedP4 S; S.G = G; S.c = blockIdx.x; S.to.init(32, 8); S.MERGED = (const char*)(P.ws + WS_MERGED); S.WoT = (const char*)(P.ws + WS_WOT); S.done3 = (unsigned*)(P.ws + WS_CTL) + CW_DONE + 128;
        { pg8::Unit u0; if (S.next(0, u0)) { if (tid == 0) poll_count(S.done3 + 64 * u0.pm, u0.kind == 0 ? 8u : 96u); } __syncthreads(); }
        EpiP4 E; E.OUTF = (bf16_t*)(P.ws + WS_OUTB); E.slabs = (float*)(P.ws + WS_U + 24 * MiB); E.cnt = (unsigned*)(P.ws + WS_CTL) + CW_CNT + 64 * CNT_P4S; E.misc = MISC; E.done4 = (unsigned*)(P.ws + WS_CTL) + CW_DONE4;
        pg8::gemm_phase<EpiP4, SchedP4>(lds, DM, DM, S, E);
        if (BOTH(4) && G != 256) GSYNC(9);
    }
    if (IN(5)) {
        if (G == 256 && IN(4)) {
            unsigned* done4 = (unsigned*)(P.ws + WS_CTL) + CW_DONE4;
            pg8::TileOrder to; to.init(32, 8); int pm, pn; to.map(blockIdx.x, pm, pn);
            if (tid == 0) poll_count(done4 + 64 * pm, 8u);
            __syncthreads();
            p5_rows(P, pm * 256 + pn * 32 + wave, 8, pm * 256 + pn * 32 + 32, lane);
            if (pm >= 16 && pm < 18) {
                const int sr = ((pm - 16) * 8 + pn) * 8;
                if (tid == 0) poll_count(done4 + 64 * 32, 32u);
                __syncthreads();
                p5_rows(P, MP + sr + wave, 8, MP + sr + 8, lane);
            }
        } else p5_rows(P, blockIdx.x * 8 + wave, G * 8, MTOT, lane);
    }
#undef IN
#undef BOTH
}

extern "C" void kernel_launch(void* const* d_in, const int* in_sizes, int n_in, void* d_out, int out_size, void* d_ws, size_t ws_size, hipStream_t stream) {
    static int grid = 0;
    if (grid == 0) {
        if (n_in != 24 || (size_t)out_size != OUT_TOTAL || ws_size < WS_END) { fprintf(stderr, "kernel_launch: unexpected problem (n_in %d, out %d, ws %zu); nothing launched\n", n_in, out_size, ws_size); grid = -1; return; }
        int dev = 0, cus = 0, per_cu = 0;
        if (hipGetDevice(&dev) != hipSuccess || hipDeviceGetAttribute(&cus, hipDeviceAttributeMultiprocessorCount, dev) != hipSuccess) { grid = -1; return; }
        if (hipFuncSetAttribute((const void*)fwd_kernel, hipFuncAttributeMaxDynamicSharedMemorySize, LDS_BYTES) != hipSuccess) { fprintf(stderr, "kernel_launch: hipFuncSetAttribute failed\n"); grid = -1; return; }
        if (hipOccupancyMaxActiveBlocksPerMultiprocessor(&per_cu, (const void*)fwd_kernel, 512, LDS_BYTES) != hipSuccess || per_cu < 1) { fprintf(stderr, "kernel_launch: occupancy query failed (%d)\n", per_cu); (void)hipGetLastError(); grid = -1; return; }
        grid = cus * per_cu;
    }
    if (grid < 0) return;
    Params p{};
    p.x_prompt = (const float*)d_in[0]; p.x_sample = (const float*)d_in[1]; p.mem = (const float*)d_in[2]; p.st_h = (const float*)d_in[3]; p.st_conv = (const float*)d_in[4]; p.st_pool = (const float*)d_in[5];
    p.cache_k = (const float*)d_in[6]; p.cache_v = (const float*)d_in[7]; p.g_pre = (const float*)d_in[8]; p.w_in = (const float*)d_in[9]; p.conv_w = (const float*)d_in[10]; p.conv_b = (const float*)d_in[11];
    p.w_rg_a = (const float*)d_in[12]; p.b_rg_a = (const float*)d_in[13]; p.w_rg_x = (const float*)d_in[14]; p.b_rg_x = (const float*)d_in[15]; p.lam = (const float*)d_in[16]; p.w_pool = (const float*)d_in[17];
    p.pool_scale = (const float*)d_in[18]; p.g_mem = (const float*)d_in[19]; p.w_kv = (const float*)d_in[20]; p.w_branch = (const float*)d_in[21]; p.w_out = (const float*)d_in[22]; p.g_post = (const float*)d_in[23];
    p.out = (float*)d_out; p.ws = (unsigned char*)d_ws;
    if (hipMemsetAsync((char*)d_ws + WS_CTL, 0, CTL_ZERO_BYTES, stream) != hipSuccess) { fprintf(stderr, "kernel_launch: memset failed\n"); return; }
#if MK_N_LAUNCHES == 1
    p.ph_lo = 0; p.ph_hi = 6;
    void* args[] = {&p};
    hipError_t e = hipLaunchCooperativeKernel((const void*)fwd_kernel, dim3(grid), dim3(512), args, LDS_BYTES, stream);
    if (e != hipSuccess) fprintf(stderr, "kernel_launch: cooperative launch failed: %s (grid %d)\n", hipGetErrorString(e), grid);
#else
    for (int ph = 0; ph < 6; ++ph) { p.ph_lo = ph; p.ph_hi = ph + 1; hipLaunchKernelGGL(fwd_kernel, dim3(grid), dim3(512), LDS_BYTES, stream, p); }
#endif
}
```

```cpp
#include <hip/hip_runtime.h>
#include <hip/hip_cooperative_groups.h>
#include <cstdio>
#include <cstdint>
namespace cg = cooperative_groups;

#define LAS __attribute__((address_space(3)))
typedef unsigned short bf16_t;
typedef short bf16x8 __attribute__((ext_vector_type(8)));
typedef short bf16x4 __attribute__((ext_vector_type(4)));
typedef float f32x4 __attribute__((ext_vector_type(4)));
typedef float f32x2 __attribute__((ext_vector_type(2)));
typedef unsigned u32x4 __attribute__((ext_vector_type(4)));
typedef unsigned u32x2 __attribute__((ext_vector_type(2)));

#ifndef MK_N_LAUNCHES
#define MK_N_LAUNCHES 1
#endif
#ifndef CG_SEAM_MASK
#define CG_SEAM_MASK 0
#endif
#define USE_CG_SEAM(k) (((CG_SEAM_MASK) >> (k)) & 1)
#ifndef PROBE_REPEAT
#define PROBE_REPEAT -1
#endif

constexpr int DM = 2048, NBATCH = 4, SEQ = 2048, NS = 128;
constexpr int MP = NBATCH * SEQ;
constexpr int MTOT = MP + NS;
constexpr int MPAD = 8448;
constexpr int DIN = 12288, DMIX = 3072, NMEM = 256;
constexpr int ZC_XR = 0, ZC_GR = 1024, ZC_XP = 2048, ZC_GP = 3072, ZC_Q = 4096, ZC_GX = 5120, ZC_GT = 6144;
constexpr float EPS = 1e-6f;
constexpr float LOG2E = 1.4426950408889634f;

constexpr size_t OFF_Y = 0;
constexpr size_t OFF_NHP = 17039360, OFF_NCP = 17043456, OFF_NPP = 17055744, OFF_MEMK = 17117184, OFF_MEMV = 18165760;
constexpr size_t OFF_NHS = 19214336, OFF_NCS = 19345408, OFF_NPS = 19738624, OUT_TOTAL = 21704704;

constexpr size_t MiB = 1u << 20;
constexpr size_t WS_CTL = 0, WS_WINT = 1 * MiB, WS_WKVT = 49 * MiB, WS_WBT = 57 * MiB, WS_WOT = 69 * MiB, WS_WRGT = 77 * MiB, WS_WPT = 77 * MiB + 512 * 1024;
constexpr size_t WS_U = 78 * MiB, WS_MEMN = 111 * MiB, WS_KB = 115 * MiB, WS_VT = 117 * MiB, WS_Z = 119 * MiB, WS_OALL = 317 * MiB, WS_PART = 367 * MiB;
constexpr size_t WS_MERGED = 433 * MiB, WS_OUTB = 466 * MiB, WS_END = 500 * MiB;
constexpr size_t WS_GR = WS_CTL + 256 * 1024;
constexpr size_t CTL_ZERO_BYTES = 65536;
constexpr int LDS_BYTES = 147456;
constexpr int LDS_MISC_OFF = 147200;

struct Params {
    const float* x_prompt; const float* x_sample; const float* mem; const float* st_h; const float* st_conv; const float* st_pool;
    const float* cache_k; const float* cache_v; const float* g_pre; const float* w_in; const float* conv_w; const float* conv_b;
    const float* w_rg_a; const float* b_rg_a; const float* w_rg_x; const float* b_rg_x; const float* lam; const float* w_pool;
    const float* pool_scale; const float* g_mem; const float* w_kv; const float* w_branch; const float* w_out; const float* g_post;
    float* out; unsigned char* ws; int ph_lo, ph_hi;
};

__device__ __forceinline__ unsigned f2bf(float f) { unsigned u = __builtin_bit_cast(unsigned, f); return (u + 0x7fffu + ((u >> 16) & 1u)) >> 16; }
__device__ __forceinline__ unsigned pk2(float lo, float hi) { unsigned r; asm volatile("v_cvt_pk_bf16_f32 %0, %1, %2" : "=v"(r) : "v"(lo), "v"(hi)); return r; }
__device__ __forceinline__ float bf_lo(unsigned u) { return __builtin_bit_cast(float, u << 16); }
__device__ __forceinline__ float bf_hi(unsigned u) { return __builtin_bit_cast(float, u & 0xffff0000u); }
__device__ __forceinline__ float bf2f(bf16_t b) { return __builtin_bit_cast(float, ((unsigned)b) << 16); }
__device__ __forceinline__ unsigned cvt_pk_bf16(float lo, float hi) { unsigned r; asm volatile("v_cvt_pk_bf16_f32 %0, %1, %2" : "=v"(r) : "v"(lo), "v"(hi)); return r; }
__device__ __forceinline__ float wave_sum(float v) {
#pragma unroll
    for (int o = 1; o < 64; o <<= 1) v += __shfl_xor(v, o);
    return v;
}
__device__ __forceinline__ float wave_max(float v) {
#pragma unroll
    for (int o = 1; o < 64; o <<= 1) v = fmaxf(v, __shfl_xor(v, o));
    return v;
}
__device__ __forceinline__ float sigmoid_f(float x) { return __builtin_amdgcn_rcpf(1.0f + __builtin_amdgcn_exp2f(-x * LOG2E)); }
__device__ __forceinline__ float silu_f(float x) { return x * sigmoid_f(x); }


#define XB_TMO      128
#define XB_XCNT(j)  (256  + 64 * (j))
#define XB_XSUB(j)  (1280 + 64 * (j))
#define XB_XGEN(j)  (2304 + 64 * (j))
#define XB_TOP      3328
#define XB_TOPGEN   3392
#define XCD_BAR_WORDS 3456
#define XB_SPIN_CAP (1u << 18)
__device__ __forceinline__ unsigned xb_ld(unsigned* p)              { return __hip_atomic_load(p, __ATOMIC_RELAXED, __HIP_MEMORY_SCOPE_AGENT); }
__device__ __forceinline__ unsigned xb_add(unsigned* p, unsigned v) { return __hip_atomic_fetch_add(p, v, __ATOMIC_RELAXED, __HIP_MEMORY_SCOPE_AGENT); }
__device__ __forceinline__ unsigned xb_xcc_id() { return (unsigned)__builtin_amdgcn_s_getreg((3 << 11) | 20) & 0xFu; }
#define XB_SPIN(cond, bar) do { unsigned _sp = 0; while (cond) { __builtin_amdgcn_s_sleep(1); \
    if ((++_sp & 255u) == 0u) { if (xb_ld(&(bar)[XB_TMO])) break; if (_sp > XB_SPIN_CAP) { atomicAdd(&(bar)[XB_TMO], 1u); break; } } } } while (0)
struct XcdBarrier { unsigned* bar; unsigned x; volatile LAS unsigned* st; };
__device__ __forceinline__ XcdBarrier xcd_barrier_post(unsigned* bar, volatile LAS unsigned* st) {
    XcdBarrier b; b.bar = bar; b.x = xb_xcc_id(); b.st = st;
    if (threadIdx.x == 0) (void)xb_add(&bar[XB_XCNT(b.x)], 1u);
    return b;
}
__device__ __forceinline__ void xcd_barrier_complete(unsigned* bar, unsigned x, unsigned& nloc, unsigned& nx) {
    const unsigned G = gridDim.x * gridDim.y * gridDim.z;
    unsigned sum, cnt, mine, sp = 0u;
    for (;;) {
        sum = 0u; cnt = 0u; mine = 0u;
#pragma unroll
        for (unsigned j = 0; j < 16; ++j) { const unsigned c = xb_ld(&bar[XB_XCNT(j)]); sum += c; cnt += (c > 0u) ? 1u : 0u; mine = (j == x) ? c : mine; }
        if (sum == G) break;
        __builtin_amdgcn_s_sleep(1);
        if ((++sp & 255u) == 0u) { if (xb_ld(&bar[XB_TMO])) break; if (sp > XB_SPIN_CAP) { atomicAdd(&bar[XB_TMO], 1u); break; } }
    }
    nloc = mine > 0u ? mine : 1u; nx = cnt > 0u ? cnt : 1u;
}
__device__ __forceinline__ void xcd_barrier(const XcdBarrier& b) {
    asm volatile("s_waitcnt vmcnt(0)" ::: "memory");
    __syncthreads();
    if (threadIdx.x == 0) {
        unsigned* bar = b.bar;
        __builtin_amdgcn_s_waitcnt(0);
        unsigned nloc = b.st[0], nx = b.st[1];
        if (nloc == 0u) { xcd_barrier_complete(bar, b.x, nloc, nx); b.st[0] = nloc; b.st[1] = nx; }
        const unsigned old = xb_add(&bar[XB_XSUB(b.x)], 1u);
        const unsigned gen = old / nloc;
        if (old + 1u == (gen + 1u) * nloc) {
            __builtin_amdgcn_fence(__ATOMIC_RELEASE, "agent");
            asm volatile("s_waitcnt vmcnt(0)" ::: "memory");
            const unsigned og = xb_add(&bar[XB_TOP], 1u);
            const unsigned tg = og / nx;
            if (og + 1u == (tg + 1u) * nx) xb_add(&bar[XB_TOPGEN], 1u);
            else XB_SPIN(xb_ld(&bar[XB_TOPGEN]) == tg, bar);
            __builtin_amdgcn_fence(__ATOMIC_ACQUIRE, "agent");
            xb_add(&bar[XB_XGEN(b.x)], 1u);
            asm volatile("s_waitcnt vmcnt(0)" ::: "memory");
        } else {
            XB_SPIN(xb_ld(&bar[XB_XGEN(b.x)]) == gen, bar);
            __builtin_amdgcn_fence(__ATOMIC_ACQUIRE, "agent");
            asm volatile("s_waitcnt vmcnt(0)" ::: "memory");
        }
    }
    __syncthreads();
}

namespace pg8 {
constexpr int BM = 256, BK = 64, HALF = 128, HTB = HALF * BK * 2, STAGE_BYTES = 8 * HTB, NXCD = 8, WGM = 4;
__device__ __forceinline__ int lds_byte(int r, int c) { const int st = (r >> 4) * 2 + (c >> 5), rr = r & 15, cc = c & 31, ob = rr * 64 + cc * 2; return st * 1024 + (ob ^ (((ob >> 9) & 1) << 5)); }
__device__ __forceinline__ void stage_rc(int b, int& R, int& C) { const int st = b / 1024, sb = b % 1024, swz = sb ^ (((sb >> 9) & 1) << 5); R = (st >> 1) * 16 + swz / 64; C = (st & 1) * 32 + (swz % 64) / 2; }
__device__ __forceinline__ int perm32_inv(int y) { return 16 * ((y >> 2) & 1) + 4 * (y >> 3) + (y & 3); }
__device__ __forceinline__ int perm32(int rho) { const int n = rho >> 4, i = rho & 15; return 8 * (i >> 2) + 4 * n + (i & 3); }

struct Unit { const char* A; const char* B; int pm, pn, kind, aux, nt, half, ks, grp; };
struct TileOrder {
    int nM, nN, nwg;
    __device__ __forceinline__ void init(int nM_, int nN_) { nM = nM_; nN = nN_; nwg = nM_ * nN_; }
    __device__ __forceinline__ void map(int L, int& pm, int& pn) const {
        int wgid = L; { const int q = nwg / NXCD, r = nwg % NXCD, xcd = wgid % NXCD, off = wgid / NXCD; wgid = (xcd < r ? xcd * (q + 1) : r * (q + 1) + (xcd - r) * q) + off; }
        const int nig = WGM * nN, gid = wgid / nig, fm = gid * WGM, gsz = (nM - fm) < WGM ? (nM - fm) : WGM;
        pm = fm + ((wgid % nig) % gsz); pn = (wgid % nig) / gsz;
    }
};

template <class Epi, class Sched>
__device__ __forceinline__ void gemm_phase(LAS unsigned char* lds, const int lda, const int ldb, const Sched& S, const Epi& E) {
    const int tid = threadIdx.x, wid = __builtin_amdgcn_readfirstlane(tid >> 6), lane = tid & 63, wr = wid >> 2, wc = wid & 3, fr = lane & 15, fq = lane >> 4;
    unsigned voffA[2], voffB[2];
#pragma unroll
    for (int i = 0; i < 2; ++i) { int R, C; stage_rc(tid * 16 + i * 8192, R, C); const int Rb = (R & ~31) + perm32(R & 31);
        voffA[i] = lda ? (unsigned)(R * lda + C) * 2u : (unsigned)(tid * 16 + i * 8192); voffB[i] = ldb ? (unsigned)(Rb * ldb + C) * 2u : (unsigned)(tid * 16 + i * 8192); }
    const size_t kstepA = lda ? (size_t)(BK * 2) : (size_t)(2 * HTB), kstepB = ldb ? (size_t)(BK * 2) : (size_t)(2 * HTB);
    const size_t hstepA = lda ? (size_t)HALF * lda * 2 : (size_t)HTB, hstepB = ldb ? (size_t)HALF * ldb * 2 : (size_t)HTB;
    const unsigned ldsw = (unsigned)wid * 1024u;
    const int aoff = lds_byte(wr * 64 + fr, fq * 8), boff = lds_byte(wc * 32 + fr, fq * 8);
#define PG8_SA(b, h) (((b) * 2 + (h)) * HTB)
#define PG8_SB(b, h) ((4 + (b) * 2 + (h)) * HTB)
#define PG8_STAGE(bufoff, gbase, voff) do { _Pragma("unroll") for (int _i = 0; _i < 2; ++_i) \
        __builtin_amdgcn_global_load_lds((const unsigned*)((const char*)(gbase) + (voff)[_i]), (LAS unsigned*)(lds + (bufoff) + ldsw + _i * 8192), 16, 0, 0); } while (0)
#define PG8_LDA(dst, b, h) do { _Pragma("unroll") for (int m = 0; m < 4; ++m) _Pragma("unroll") for (int k = 0; k < 2; ++k) dst[m][k] = *(const LAS bf16x8*)(lds + PG8_SA(b, h) + aoff + m * 2048 + k * 1024); } while (0)
#define PG8_LDB(dst, b, h) do { _Pragma("unroll") for (int n = 0; n < 2; ++n) _Pragma("unroll") for (int k = 0; k < 2; ++k) dst[n][k] = *(const LAS bf16x8*)(lds + PG8_SB(b, h) + boff + n * 2048 + k * 1024); } while (0)
#define PG8_MMA(ai, bj, At, Bt) do { __builtin_amdgcn_s_setprio(1); _Pragma("unroll") for (int m = 0; m < 4; ++m) _Pragma("unroll") for (int n = 0; n < 2; ++n) _Pragma("unroll") for (int k = 0; k < 2; ++k) \
        acc[ai][bj][m][n] = __builtin_amdgcn_mfma_f32_16x16x32_bf16(Bt[n][k], At[m][k], acc[ai][bj][m][n], 0, 0, 0); __builtin_amdgcn_s_setprio(0); } while (0)
#define PG8_WAIT_V(n) asm volatile("s_waitcnt vmcnt(" #n ")" ::: "memory")
#define PG8_WAIT_L(n) asm volatile("s_waitcnt lgkmcnt(" #n ")" ::: "memory")
#define PG8_BAR __builtin_amdgcn_s_barrier()
#define PG8_SCHED __builtin_amdgcn_sched_barrier(0)
    Unit cur, nxt; int ui = 0;
    if (!S.next(0, cur)) return;
    f32x4 acc[2][2][4][2];
#pragma unroll
    for (int a = 0; a < 2; ++a)
#pragma unroll
        for (int b = 0; b < 2; ++b)
#pragma unroll
            for (int m = 0; m < 4; ++m)
#pragma unroll
                for (int n = 0; n < 2; ++n) acc[a][b][m][n] = (f32x4){0.f, 0.f, 0.f, 0.f};
    bf16x8 At[4][2], B0[2][2], B1[2][2];
    const char* cA = cur.A; const char* cB = cur.B;
    PG8_STAGE(PG8_SB(0, 0), cB, voffB); PG8_STAGE(PG8_SB(0, 1), cB + hstepB, voffB); PG8_STAGE(PG8_SA(0, 0), cA, voffA); PG8_STAGE(PG8_SA(0, 1), cA + hstepA, voffA);
    if (wr == 1) PG8_BAR;
    PG8_WAIT_V(2); PG8_BAR;
    PG8_STAGE(PG8_SB(1, 0), cB + kstepB, voffB); PG8_STAGE(PG8_SA(1, 0), cA + kstepA, voffA); PG8_STAGE(PG8_SB(1, 1), cB + hstepB + kstepB, voffB);
    PG8_WAIT_V(6); PG8_BAR;
    for (;;) {
        const bool has_next = S.next(ui + 1, nxt);
        const char* nA = has_next ? nxt.A : cA; const char* nB = has_next ? nxt.B : cB;
        const int nt = cur.nt; const bool full = (cur.half == 0);
        for (int t = 0; t < nt; t += 2) {
            const bool last = (t == nt - 2);
            if (last && has_next) S.a_ready(nxt);
            const char* a1 = cA + (size_t)(t + 1) * kstepA;
            const char* a2 = last ? nA : cA + (size_t)(t + 2) * kstepA; const char* b2 = last ? nB : cB + (size_t)(t + 2) * kstepB;
            const char* a3 = a2 + kstepA; const char* b3 = b2 + kstepB;
            PG8_LDB(B0, 0, 0); PG8_LDB(B1, 0, 1); PG8_SCHED; PG8_LDA(At, 0, 0); PG8_STAGE(PG8_SA(1, 1), a1 + hstepA, voffA);
            PG8_WAIT_V(8); PG8_WAIT_L(0); PG8_BAR; PG8_MMA(0, 0, At, B0); PG8_MMA(0, 1, At, B1); PG8_BAR; PG8_SCHED;
            PG8_LDA(At, 0, 1); PG8_STAGE(PG8_SB(0, 0), b2, voffB); PG8_STAGE(PG8_SB(0, 1), b2 + hstepB, voffB); PG8_STAGE(PG8_SA(0, 0), a2, voffA);
            PG8_WAIT_V(8); PG8_WAIT_L(0); PG8_BAR; if (full) { PG8_MMA(1, 0, At, B0); PG8_MMA(1, 1, At, B1); } PG8_BAR; PG8_SCHED;
            PG8_LDB(B0, 1, 0); PG8_LDB(B1, 1, 1); PG8_SCHED; PG8_LDA(At, 1, 0); PG8_STAGE(PG8_SA(0, 1), a2 + hstepA, voffA);
            PG8_WAIT_V(8); PG8_WAIT_L(0); PG8_BAR; PG8_MMA(0, 0, At, B0); PG8_MMA(0, 1, At, B1); PG8_BAR; PG8_SCHED;
            PG8_LDA(At, 1, 1); PG8_STAGE(PG8_SB(1, 0), b3, voffB); PG8_STAGE(PG8_SB(1, 1), b3 + hstepB, voffB); PG8_STAGE(PG8_SA(1, 0), a3, voffA);
            PG8_WAIT_V(8); PG8_WAIT_L(0); PG8_BAR; if (full) { PG8_MMA(1, 0, At, B0); PG8_MMA(1, 1, At, B1); } PG8_BAR; PG8_SCHED;
        }
        if (wr == 0) PG8_BAR;
        E(acc, cur, wr, wc, fr, fq);
        if (!has_next) break;
#pragma unroll
        for (int a = 0; a < 2; ++a)
#pragma unroll
            for (int b = 0; b < 2; ++b)
#pragma unroll
                for (int m = 0; m < 4; ++m)
#pragma unroll
                    for (int n = 0; n < 2; ++n) acc[a][b][m][n] = (f32x4){0.f, 0.f, 0.f, 0.f};
        cur = nxt; cA = nA; cB = nB; ++ui;
        if (wr == 1) PG8_BAR;
    }
    PG8_WAIT_V(0);
    PG8_BAR;
#undef PG8_SA
#undef PG8_SB
#undef PG8_STAGE
#undef PG8_LDA
#undef PG8_LDB
#undef PG8_MMA
#undef PG8_WAIT_V
#undef PG8_WAIT_L
#undef PG8_BAR
#undef PG8_SCHED
}
}

constexpr int SLAB_FLOATS = 32 * 512 * 4;
constexpr int CW_CNT = 4096;
constexpr int CNT_P1S = 0, CNT_P1KV = 48, CNT_P3S = 80, CNT_P4S = 88;
constexpr int CW_DONE4 = 10240;
constexpr int CW_DONE = 13312;
template <int NSL, bool HALF, int KS>
__device__ __forceinline__ unsigned share_body(f32x4 (&acc)[2][2][4][2], const float* slabs, int tid) {
    unsigned mask = 0;
    const f32x4* p0 = (const f32x4*)slabs + tid;
#pragma unroll
    for (int c = 0; c < (HALF ? 8 : 16); ++c) { if (c % NSL != KS) continue;
        const int ai = c >> 3, bj = (c >> 2) & 1, m = c & 3; mask |= 1u << c;
#pragma unroll
        for (int s = 0; s < NSL; ++s) { if (s == KS) continue;
            acc[ai][bj][m][0] += p0[(size_t)s * (SLAB_FLOATS / 4) + (size_t)(c * 2 + 0) * 512]; acc[ai][bj][m][1] += p0[(size_t)s * (SLAB_FLOATS / 4) + (size_t)(c * 2 + 1) * 512]; }
        asm volatile("" ::: "memory"); }
    return mask;
}
template <int NSL, bool HALF>
__device__ __forceinline__ unsigned splitk_share(f32x4 (&acc)[2][2][4][2], float* slabs, int ks, unsigned* cnt, volatile LAS unsigned* misc) {
    int tid_ = threadIdx.x; asm volatile("" : "+v"(tid_));
    const int tid = tid_;
    {
      const unsigned long long pa = (unsigned long long)(slabs + (size_t)ks * SLAB_FLOATS);
      const unsigned plo = __builtin_amdgcn_readfirstlane((unsigned)pa), phi = __builtin_amdgcn_readfirstlane((unsigned)(pa >> 32));
      const __amdgpu_buffer_rsrc_t rs = __builtin_amdgcn_make_buffer_rsrc((void*)(((unsigned long long)phi << 32) | plo), (short)0, SLAB_FLOATS * 4, 0x00020000);
#pragma unroll
      for (int ai = 0; ai < (HALF ? 1 : 2); ++ai)
#pragma unroll
          for (int bj = 0; bj < 2; ++bj)
#pragma unroll
              for (int m = 0; m < 4; ++m)
#pragma unroll
                  for (int n = 0; n < 2; ++n) __builtin_amdgcn_raw_buffer_store_b128(__builtin_bit_cast(u32x4, acc[ai][bj][m][n]), rs, (unsigned)tid * 16u, ((((ai * 2 + bj) * 4 + m) * 2 + n) * 512) * 16, 16); }
    asm volatile("s_waitcnt vmcnt(0)" ::: "memory");
    __syncthreads();
    if (tid == 0) {
        (void)__hip_atomic_fetch_add(cnt, 1u, __ATOMIC_RELAXED, __HIP_MEMORY_SCOPE_AGENT);
        unsigned spins = 0;
        if (ks < (HALF ? 8 : 16))
        while (__hip_atomic_load(cnt, __ATOMIC_RELAXED, __HIP_MEMORY_SCOPE_AGENT) < (unsigned)NSL) { __builtin_amdgcn_s_sleep(2); if (++spins > (1u << 21)) break; }
        __builtin_amdgcn_fence(__ATOMIC_ACQUIRE, "agent"); asm volatile("s_waitcnt vmcnt(0)" ::: "memory");
    }
    __syncthreads();
    unsigned mask = 0;
    if (NSL >= 1 && ks == 0) mask = share_body<NSL, HALF, 0>(acc, slabs, tid);
    if (NSL >= 2 && ks == 1) mask = share_body<NSL, HALF, (NSL >= 2 ? 1 : 0)>(acc, slabs, tid);
    if (NSL >= 3 && ks == 2) mask = share_body<NSL, HALF, (NSL >= 3 ? 2 : 0)>(acc, slabs, tid);
    if (NSL >= 4 && ks == 3) mask = share_body<NSL, HALF, (NSL >= 4 ? 3 : 0)>(acc, slabs, tid);
    if (NSL >= 5 && ks == 4) mask = share_body<NSL, HALF, (NSL >= 5 ? 4 : 0)>(acc, slabs, tid);
    if (NSL >= 6 && ks == 5) mask = share_body<NSL, HALF, (NSL >= 6 ? 5 : 0)>(acc, slabs, tid);
    if (NSL >= 7 && ks == 6) mask = share_body<NSL, HALF, (NSL >= 7 ? 6 : 0)>(acc, slabs, tid);
    if (NSL >= 8 && ks == 7) mask = share_body<NSL, HALF, (NSL >= 8 ? 7 : 0)>(acc, slabs, tid);
    return mask;
}

__device__ __forceinline__ void publish_count(unsigned* ctr) {
    asm volatile("s_waitcnt vmcnt(0)" ::: "memory"); __syncthreads();
    if (threadIdx.x == 0) { __builtin_amdgcn_fence(__ATOMIC_RELEASE, "agent"); asm volatile("s_waitcnt vmcnt(0)" ::: "memory"); __hip_atomic_fetch_add(ctr, 1u, __ATOMIC_RELAXED, __HIP_MEMORY_SCOPE_AGENT); }
}
__device__ __forceinline__ void publish_count_wt(unsigned* ctr) {
    asm volatile("s_waitcnt vmcnt(0)" ::: "memory"); __syncthreads();
    if (threadIdx.x == 0) __hip_atomic_fetch_add(ctr, 1u, __ATOMIC_RELAXED, __HIP_MEMORY_SCOPE_AGENT);
}
__device__ __forceinline__ void poll_count(unsigned* ctr, unsigned need) {
    unsigned spins = 0;
    while (__hip_atomic_load(ctr, __ATOMIC_RELAXED, __HIP_MEMORY_SCOPE_AGENT) < need) { __builtin_amdgcn_s_sleep(4); if (++spins > (1u << 21)) break; }
    __builtin_amdgcn_fence(__ATOMIC_ACQUIRE, "agent"); asm volatile("s_waitcnt vmcnt(0)" ::: "memory");
}

__device__ __forceinline__ bf16_t* gate_frag_ptr(bf16_t* Z, int pm, int colbase, int f) {
    const int tid = threadIdx.x;
    return Z + (size_t)(pm * 256 + 16 * f + (tid >> 5)) * DIN + colbase + (tid & 31) * 8;
}
__device__ __forceinline__ bf16_t* q_frag_ptr(bf16_t* Z, int rg, int colbase, int ks) {
    const int lane = threadIdx.x & 63;
    const int o = (((rg & 15) * 8 + ks) * 64 + lane);
    return Z + (size_t)((rg >> 4) * 256 + (o >> 5)) * DIN + colbase + (o & 31) * 8;
}
struct SchedP1 {
    int mode; int G, c; pg8::TileOrder to; const char* U; const char* WinT; const char* MEMN; const char* WkvT;
    __device__ __forceinline__ void a_ready(const pg8::Unit&) const {}
    __device__ __forceinline__ bool next(int i, pg8::Unit& u) const {
        const int L = i * G + c;
        int e;
        if (mode == 1) e = L;
        else { if (L < 32 * 48) { int pm, pn; to.map(L, pm, pn); u.A = U + (size_t)pm * 256 * 2048 * 2; u.B = WinT + (size_t)pn * 256 * 2048 * 2; u.pm = pm; u.pn = pn; u.kind = 0; u.nt = 32; u.half = 0; u.ks = 0; u.grp = 0; return true; }
            if (mode == 0) return false;
            e = L - 32 * 48; }
        if (e >= 80) return false;
        u.nt = 32; u.ks = 0; u.grp = 0;
        if (e < 32) { const int pm = e & 3, pn = e >> 2;
            u.A = MEMN + (size_t)pm * 256 * 2048 * 2; u.B = WkvT + (size_t)pn * 256 * 2048 * 2; u.pm = pm; u.pn = pn; u.kind = 2; u.half = 0; }
        else { const int t = e - 32;
            u.A = U + (size_t)32 * 256 * 2048 * 2; u.B = WinT + (size_t)t * 256 * 2048 * 2; u.pm = 32; u.pn = t; u.kind = 1; u.half = 1; }
        return true;
    }
};
template <bool EXTRA>
struct EpiP1T {
    bf16_t* Z; float* out; bf16_t* KB; bf16_t* VT; float* slabs; unsigned* cnt; volatile LAS unsigned* misc; unsigned* done;
    __device__ __forceinline__ void publish(int which) const {
        asm volatile("s_waitcnt vmcnt(0)" ::: "memory"); __syncthreads();
        if (threadIdx.x == 0) { __builtin_amdgcn_fence(__ATOMIC_RELEASE, "agent"); asm volatile("s_waitcnt vmcnt(0)" ::: "memory"); __hip_atomic_fetch_add(done + 64 * which, 1u, __ATOMIC_RELAXED, __HIP_MEMORY_SCOPE_AGENT); }
    }
    __device__ __forceinline__ void operator()(f32x4 (&acc)[2][2][4][2], const pg8::Unit& u, int wr, int wc, int fr, int fq) const {
        const int row0 = u.pm * 256 + wr * 64 + fr, col0 = u.pn * 256 + wc * 32 + 8 * fq;
        unsigned cm = 0xffffu;

        if (!EXTRA || u.kind != 2) {
            const int seg = u.pn >> 2;
            const int act = (seg >= 6) ? 2 : ((seg & 1) ? 1 : 0);
            const int lay = EXTRA ? 0 : (act == 2 ? 1 : (seg == 4 ? 2 : 0));
            const int tidv = threadIdx.x;
            const int lanebase = lay == 1 ? (tidv >> 5) * DIN + (tidv & 31) * 8 : (lay == 2 ? ((tidv >> 5) & 1) * DIN + (tidv & 31) * 8 : (wr * 64 + fr) * DIN + wc * 32 + 8 * fq);
            bf16_t* tb = Z + (size_t)u.pm * 256 * DIN + u.pn * 256 + lanebase;
#pragma unroll
            for (int ai = 0; ai < 2; ++ai) { if (ai == 1 && u.half) break;
#pragma unroll
                for (int m = 0; m < 4; ++m) {
#pragma unroll
                    for (int bj = 0; bj < 2; ++bj) { if (EXTRA && !((cm >> ((ai * 2 + bj) * 4 + m)) & 1u)) continue;
                        f32x4 v0 = acc[ai][bj][m][0], v1 = acc[ai][bj][m][1];
                        if (act == 1) {
#pragma unroll
                            for (int j = 0; j < 4; ++j) { v0[j] = silu_f(v0[j]); v1[j] = silu_f(v1[j]); } }
                        else if (act == 2) {
#pragma unroll
                            for (int j = 0; j < 4; ++j) { v0[j] = sigmoid_f(v0[j]); v1[j] = sigmoid_f(v1[j]); } }
                        u32x4 w; w.x = cvt_pk_bf16(v0[0], v0[1]); w.y = cvt_pk_bf16(v0[2], v0[3]); w.z = cvt_pk_bf16(v1[0], v1[1]); w.w = cvt_pk_bf16(v1[2], v1[3]);
                        const int co = lay == 1 ? 16 * ((ai * 4 + m) * 2 + bj) * DIN : (lay == 2 ? ((((ai * 8 + wr * 4 + m) & 15) * 8 + bj * 4 + wc) * 2) * DIN : (ai * 128 + m * 16) * DIN + bj * 128);
                        __builtin_nontemporal_store(w, (u32x4*)(tb + co)); } } }
            if (EXTRA) publish(1);
        } else {
            const bool isV = u.pn >= 4;
            const int c0 = isV ? col0 - 1024 : col0;
            float* ob = out + (isV ? OFF_MEMV : OFF_MEMK);
#pragma unroll
            for (int ai = 0; ai < 2; ++ai)
#pragma unroll
                for (int m = 0; m < 4; ++m) { const int row = row0 + ai * 128 + m * 16;
#pragma unroll
                    for (int bj = 0; bj < 2; ++bj) { if (!((cm >> ((ai * 2 + bj) * 4 + m)) & 1u)) continue;
                        const f32x4 v0 = acc[ai][bj][m][0], v1 = acc[ai][bj][m][1]; const int col = c0 + bj * 128;
                        __builtin_nontemporal_store(v0, (f32x4*)(ob + (size_t)row * 1024 + col)); __builtin_nontemporal_store(v1, (f32x4*)(ob + (size_t)row * 1024 + col + 4));
                        if (!isV) { u32x4 w; w.x = cvt_pk_bf16(v0[0], v0[1]); w.y = cvt_pk_bf16(v0[2], v0[3]); w.z = cvt_pk_bf16(v1[0], v1[1]); w.w = cvt_pk_bf16(v1[2], v1[3]);
                            *(u32x4*)(KB + (size_t)row * 1024 + col) = w; }
                        else {
#pragma unroll
                            for (int j = 0; j < 4; ++j) { VT[(size_t)(col + j) * 1024 + row] = (bf16_t)f2bf(v0[j]); VT[(size_t)(col + 4 + j) * 1024 + row] = (bf16_t)f2bf(v1[j]); } } } }
            publish(0);
        }
    }
};
__device__ __forceinline__ void wait_done(unsigned* done) {
    if (threadIdx.x == 0) { unsigned spins = 0;
        while (__hip_atomic_load(done, __ATOMIC_RELAXED, __HIP_MEMORY_SCOPE_AGENT) < 32u || __hip_atomic_load(done + 64, __ATOMIC_RELAXED, __HIP_MEMORY_SCOPE_AGENT) < 48u) { __builtin_amdgcn_s_sleep(8); if (++spins > (1u << 21)) break; }
        __builtin_amdgcn_fence(__ATOMIC_ACQUIRE, "agent"); asm volatile("s_waitcnt vmcnt(0)" ::: "memory"); }
    __syncthreads();
}
struct SchedP3 {
    int G, c; pg8::TileOrder to; const char* OALL; const char* WbT;
    __device__ __forceinline__ void a_ready(const pg8::Unit&) const {}
    __device__ __forceinline__ bool next(int i, pg8::Unit& u) const {
        const int nmine = (32 * 8 - c + G - 1) / G;
        int e = 96;
        if (G == 256) {
            int qm, qn; to.map(c, qm, qn);
            if (qm < 12) { if (i == 0) e = qm * 8 + qn; else i -= 1; }
        }
        if (e >= 96 && i < 3 * nmine) { const int ti = i / 3, j = i - 3 * ti; const int L = ti * G + c;
            int pm, pn; to.map(L, pm, pn);
            u.A = OALL + ((size_t)pm * 256 * DMIX + (size_t)j * 1024) * 2; u.B = WbT + (size_t)pn * 256 * DMIX * 2 + (size_t)j * 1024 * 512; u.pm = pm; u.pn = pn; u.kind = 0; u.aux = j; u.nt = 16; u.half = 0; u.ks = 0; u.grp = 0; return true; }
        if (G != 256) e = (i - 3 * nmine) * G + c;
        if (e >= 96) return false;
        const int pn = e / 12, r = e - 12 * pn, j = r >> 2, k4 = r & 3;
        u.A = OALL + ((size_t)32 * 256 * DMIX + (size_t)j * 1024 + (size_t)k4 * 256) * 2; u.B = WbT + (size_t)pn * 256 * DMIX * 2 + ((size_t)j * 1024 + (size_t)k4 * 256) * 512;
        u.pm = 32; u.pn = pn; u.kind = 1; u.aux = j; u.nt = 4; u.half = 1; u.ks = r; u.grp = pn; return true;
    }
};
__device__ __forceinline__ unsigned merged_img_off(int pm, int pn, int ai, int m, int bj, int wr, int wc, int fr, int fq) {
    const unsigned blk = (unsigned)pm * (32u * 2u * pg8::HTB) + (unsigned)(pn * 4 + 2 * bj + (wc >> 1)) * (2u * pg8::HTB) + (unsigned)ai * pg8::HTB + (unsigned)((4 * wr + m) * 2 + (wc & 1)) * 1024u;
    return blk + (unsigned)((fr * 64 + fq * 16) ^ ((fr >> 3) << 5));
}
struct EpiP3 {
    const bf16_t* Z; bf16_t* PART; bf16_t* MERGED; float* slabs; unsigned* cnt; volatile LAS unsigned* misc; unsigned* done3;
    __device__ __forceinline__ void operator()(f32x4 (&acc)[2][2][4][2], const pg8::Unit& u, int wr, int wc, int fr, int fq) const {
        const int row0 = u.pm * 256 + wr * 64 + fr, col0 = u.pn * 256 + wc * 32 + 8 * fq, j = u.aux;
        if (u.kind == 0) {
            const __amdgpu_buffer_rsrc_t mrs = __builtin_amdgcn_make_buffer_rsrc((void*)MERGED, (short)0, (int)((size_t)MPAD * DM * 2), 0x00020000);
#pragma unroll
            for (int ai = 0; ai < 2; ++ai) {
                u32x4 g[4][2], pp[4][2];
#pragma unroll
                for (int m = 0; m < 4; ++m)
#pragma unroll
                    for (int bj = 0; bj < 2; ++bj) g[m][bj] = __builtin_nontemporal_load((const u32x4*)gate_frag_ptr((bf16_t*)Z, u.pm, ZC_GT + j * DM + u.pn * 256, (ai * 4 + m) * 2 + bj));
#pragma unroll
                for (int m = 0; m < 4; ++m)
#pragma unroll
                    for (int bj = 0; bj < 2; ++bj) { pp[m][bj] = (u32x4){0u, 0u, 0u, 0u}; if (j > 0) pp[m][bj] = *(const u32x4*)(PART + ((size_t)((u.pm * 8 + u.pn) * 16 + (ai * 4 + m) * 2 + bj) * 512 + threadIdx.x) * 8); }
#pragma unroll
                for (int m = 0; m < 4; ++m) { const size_t row = (size_t)(row0 + ai * 128 + m * 16);
#pragma unroll
                    for (int bj = 0; bj < 2; ++bj) { const int col = col0 + bj * 128;
                        const u32x4 gg = g[m][bj], q = pp[m][bj];
                        f32x4 p0 = (f32x4){bf_lo(q.x), bf_hi(q.x), bf_lo(q.y), bf_hi(q.y)}, p1 = (f32x4){bf_lo(q.z), bf_hi(q.z), bf_lo(q.w), bf_hi(q.w)};
                        const f32x4 a0 = acc[ai][bj][m][0], a1 = acc[ai][bj][m][1];
                        p0[0] += bf_lo(gg.x) * a0[0]; p0[1] += bf_hi(gg.x) * a0[1]; p0[2] += bf_lo(gg.y) * a0[2]; p0[3] += bf_hi(gg.y) * a0[3];
                        p1[0] += bf_lo(gg.z) * a1[0]; p1[1] += bf_hi(gg.z) * a1[1]; p1[2] += bf_lo(gg.w) * a1[2]; p1[3] += bf_hi(gg.w) * a1[3];
                        u32x4 w; w.x = cvt_pk_bf16(p0[0], p0[1]); w.y = cvt_pk_bf16(p0[2], p0[3]); w.z = cvt_pk_bf16(p1[0], p1[1]); w.w = cvt_pk_bf16(p1[2], p1[3]);
                        if (j < 2) *(u32x4*)(PART + ((size_t)((u.pm * 8 + u.pn) * 16 + (ai * 4 + m) * 2 + bj) * 512 + threadIdx.x) * 8) = w;
                        else __builtin_amdgcn_raw_buffer_store_b128(w, mrs, merged_img_off(u.pm, u.pn, ai, m, bj, wr, wc, fr, fq), 0, 16); } }
            }
            if (j == 2) publish_count_wt(done3 + 64 * u.pm);
        } else {
#pragma unroll
            for (int m = 0; m < 4; ++m) { const size_t row = (size_t)(row0 + m * 16);
#pragma unroll
                for (int bj = 0; bj < 2; ++bj) { const int col = col0 + bj * 128;
                    const u32x4 g = __builtin_nontemporal_load((const u32x4*)(Z + row * DIN + ZC_GT + j * DM + col));
                    f32x4& a0 = acc[0][bj][m][0]; f32x4& a1 = acc[0][bj][m][1];
                    a0[0] *= bf_lo(g.x); a0[1] *= bf_hi(g.x); a0[2] *= bf_lo(g.y); a0[3] *= bf_hi(g.y);
                    a1[0] *= bf_lo(g.z); a1[1] *= bf_hi(g.z); a1[2] *= bf_lo(g.w); a1[3] *= bf_hi(g.w); } }
            const __amdgpu_buffer_rsrc_t mrs2 = __builtin_amdgcn_make_buffer_rsrc((void*)MERGED, (short)0, (int)((size_t)MPAD * DM * 2), 0x00020000);
            const unsigned cm = splitk_share<12, true>(acc, slabs + (size_t)u.grp * 12 * SLAB_FLOATS, u.ks, cnt + 64 * u.grp, misc);
#pragma unroll
            for (int m = 0; m < 4; ++m) { const size_t row = (size_t)(row0 + m * 16);
#pragma unroll
                for (int bj = 0; bj < 2; ++bj) { if (!((cm >> (bj * 4 + m)) & 1u)) continue;
                    const int col = col0 + bj * 128; const f32x4 p0 = acc[0][bj][m][0], p1 = acc[0][bj][m][1];
                    u32x4 w; w.x = cvt_pk_bf16(p0[0], p0[1]); w.y = cvt_pk_bf16(p0[2], p0[3]); w.z = cvt_pk_bf16(p1[0], p1[1]); w.w = cvt_pk_bf16(p1[2], p1[3]);
                    __builtin_amdgcn_raw_buffer_store_b128(w, mrs2, merged_img_off(32, u.pn, 0, m, bj, wr, wc, fr, fq), 0, 16); } }
            publish_count_wt(done3 + 64 * 32);
        }
    }
};
struct SchedP4 {
    int G, c; pg8::TileOrder to; const char* MERGED; const char* WoT; unsigned* done3;
    __device__ __forceinline__ bool next(int i, pg8::Unit& u) const {
        int e = -1;
        if (G == 256) {
            int qm, qn; to.map(c, qm, qn);
            if (qm >= 12 && qm < 16) { if (i == 0) e = (qm - 12) * 8 + qn; else i -= 1; }
        }
        const int L = i * G + c;
        if (e < 0 && L < 32 * 8) { int pm, pn; to.map(L, pm, pn);
            u.A = MERGED + (size_t)pm * 256 * DM * 2; u.B = WoT + (size_t)pn * 256 * DM * 2; u.pm = pm; u.pn = pn; u.kind = 0; u.aux = 0; u.nt = 32; u.half = 0; u.ks = 0; u.grp = 0; return true; }
        if (G != 256) e = L - 32 * 8 - 48;
        if (e < 0 || e >= 32) return false;
        const int pn = e >> 2, ks = e & 3;
        u.A = MERGED + (size_t)32 * 256 * DM * 2 + (size_t)ks * 512 * 512; u.B = WoT + (size_t)pn * 256 * DM * 2 + (size_t)ks * 512 * 512; u.pm = 32; u.pn = pn; u.kind = 1; u.aux = 0; u.nt = 8; u.half = 1; u.ks = ks; u.grp = pn; return true;
    }
    __device__ __forceinline__ void a_ready(const pg8::Unit& n) const {
        if (threadIdx.x == 0) poll_count(done3 + 64 * n.pm, n.kind == 0 ? 8u : 96u);
        asm volatile("" ::: "memory"); __builtin_amdgcn_s_barrier(); asm volatile("" ::: "memory");
    }
};
struct EpiP4 {
    bf16_t* OUTF; float* slabs; unsigned* cnt; volatile LAS unsigned* misc; unsigned* done4;
    __device__ __forceinline__ void operator()(f32x4 (&acc)[2][2][4][2], const pg8::Unit& u, int wr, int wc, int fr, int fq) const {
        const int row0 = u.pm * 256 + wr * 64 + fr, col0 = u.pn * 256 + wc * 32 + 8 * fq;
        const __amdgpu_buffer_rsrc_t ors = __builtin_amdgcn_make_buffer_rsrc((void*)OUTF, (short)0, (int)((size_t)MPAD * DM * 2), 0x00020000);
        unsigned cm = 0xffffu;
        if (u.kind != 0) cm = splitk_share<4, true>(acc, slabs + (size_t)u.grp * 4 * SLAB_FLOATS, u.ks, cnt + 64 * u.grp, misc);
#pragma unroll
        for (int ai = 0; ai < 2; ++ai) { if (ai == 1 && u.half) break;
#pragma unroll
            for (int m = 0; m < 4; ++m) { const unsigned ooff = (unsigned)((row0 + ai * 128 + m * 16) * DM + col0) * 2u;
#pragma unroll
                for (int bj = 0; bj < 2; ++bj) { if (!((cm >> ((ai * 2 + bj) * 4 + m)) & 1u)) continue;
                    const f32x4 v0 = acc[ai][bj][m][0], v1 = acc[ai][bj][m][1];
                    u32x4 w; w.x = cvt_pk_bf16(v0[0], v0[1]); w.y = cvt_pk_bf16(v0[2], v0[3]); w.z = cvt_pk_bf16(v1[0], v1[1]); w.w = cvt_pk_bf16(v1[2], v1[3]);
                    __builtin_amdgcn_raw_buffer_store_b128(w, ors, ooff, bj * 256, 16); } } }
        publish_count_wt(done4 + 64 * u.pm);
    }
};

template <bool IMG>
__device__ __forceinline__ void p0_transpose_item(const float* W, int N, bf16_t* WT, int ldt, LAS float* scr, int kb, int nb, int lane) {
    const int k0 = 64 * kb, n0 = 64 * nb;
    f32x4 v[16];
#pragma unroll
    for (int i = 0; i < 16; ++i) { const int idx = lane + 64 * i; v[i] = __builtin_nontemporal_load((const f32x4*)(W + (size_t)(k0 + (idx >> 4)) * N + n0 + 4 * (idx & 15))); }
#pragma unroll
    for (int i = 0; i < 16; ++i) { const int idx = lane + 64 * i, kr = idx >> 4; *(LAS f32x4*)(scr + kr * 68 + ((4 * (idx & 15)) ^ (((kr >> 3) & 3) << 3))) = v[i]; }
    asm volatile("s_waitcnt lgkmcnt(0)" ::: "memory");
    const int c = lane & 7;
#pragma unroll
    for (int j = 0; j < 8; ++j) { const int n = (lane >> 3) + 8 * j; const LAS float* s = scr + (8 * c) * 68 + (n ^ ((c & 3) << 3));
        u32x4 o; o.x = pk2(s[0 * 68], s[1 * 68]); o.y = pk2(s[2 * 68], s[3 * 68]); o.z = pk2(s[4 * 68], s[5 * 68]); o.w = pk2(s[6 * 68], s[7 * 68]);
        if (IMG) { const int ng = n0 + n, r = ng & 255, nh = r & 127, R = (nh & ~31) + pg8::perm32_inv(nh & 31);
            *(u32x4*)((char*)WT + ((size_t)(ng >> 8) * (ldt >> 6) + kb) * (2 * pg8::HTB) + (r >> 7) * pg8::HTB + pg8::lds_byte(R, 8 * c)) = o; }
        else *(u32x4*)(WT + (size_t)(n0 + n) * ldt + k0 + 8 * c) = o; }
    asm volatile("s_waitcnt lgkmcnt(0)" ::: "memory");
}
__device__ __forceinline__ void rms_row_to_bf16(const float* xrow, const float* g, bf16_t* orow, int lane) {
    const f32x4* xr = (const f32x4*)xrow + lane; const f32x4* gr = (const f32x4*)g + lane;
    f32x4 v[8]; float s = 0.f;
#pragma unroll
    for (int j = 0; j < 8; ++j) { v[j] = __builtin_nontemporal_load(xr + 64 * j); s += (v[j].x * v[j].x + v[j].y * v[j].y) + (v[j].z * v[j].z + v[j].w * v[j].w); }
    const float rs = 1.0f / sqrtf(wave_sum(s) * (1.0f / DM) + EPS);
    u32x2* o8 = (u32x2*)orow + lane;
#pragma unroll
    for (int j = 0; j < 8; ++j) { const f32x4 gg = gr[64 * j]; u32x2 w; w.x = pk2(v[j].x * rs * gg.x, v[j].y * rs * gg.y); w.y = pk2(v[j].z * rs * gg.z, v[j].w * rs * gg.w); o8[64 * j] = w; }
}
__device__ __forceinline__ void p0_prologue(const Params& P, LAS unsigned char* lds, int G, int wave, int lane) {
    LAS float* scr = (LAS float*)(lds + wave * 17408);
    const int gw = blockIdx.x * 8 + wave, NGW = G * 8;
    bf16_t* WinT = (bf16_t*)(P.ws + WS_WINT); bf16_t* WkvT = (bf16_t*)(P.ws + WS_WKVT);
    bf16_t* WrgT = (bf16_t*)(P.ws + WS_WRGT); bf16_t* WpT = (bf16_t*)(P.ws + WS_WPT);
    constexpr int I_WIN = 32 * 192, I_WKV = 32 * 32, I_RG = 2 * 8 * 4, I_WP = 4 * 16;
    constexpr int NITEMS = I_WIN + I_WKV + I_RG + I_WP;
    for (int it = gw; it < NITEMS; it += NGW) {
        int r = it;
        if (r < I_WIN) { p0_transpose_item<true>(P.w_in, DIN, WinT, 2048, scr, r / 192, r % 192, lane); continue; } r -= I_WIN;
        if (r < I_WKV) { p0_transpose_item<true>(P.w_kv, 2048, WkvT, 2048, scr, r / 32, r % 32, lane); continue; } r -= I_WKV;
        if (r < I_RG) { const int gate = r >> 5, blk = (r >> 2) & 7, sub = r & 3;
            p0_transpose_item<false>((gate ? P.w_rg_x : P.w_rg_a) + blk * 16384, 128, WrgT + (size_t)(gate * 8 + blk) * 16384, 128, scr, sub >> 1, sub & 1, lane); continue; } r -= I_RG;
        { const int grp = r >> 4, sub = r & 15;
            p0_transpose_item<false>(P.w_pool + grp * 65536, 256, WpT + (size_t)grp * 65536, 256, scr, sub >> 2, sub & 3, lane); }
    }
    { unsigned long long* GR = (unsigned long long*)(P.ws + WS_GR); for (int i = blockIdx.x * 512 + threadIdx.x; i < 4 * 8 * 16 * 128; i += G * 512) GR[i] = ~0ull; }
    bf16_t* U = (bf16_t*)(P.ws + WS_U); bf16_t* MEMN = (bf16_t*)(P.ws + WS_MEMN);
    for (int m = gw; m < MPAD + 1024; m += NGW) {
        if (m < MP) rms_row_to_bf16(P.x_prompt + (size_t)m * DM, P.g_pre, U + (size_t)m * DM, lane);
        else if (m < MTOT) rms_row_to_bf16(P.x_sample + (size_t)(m - MP) * DM, P.g_pre, U + (size_t)m * DM, lane);
        else if (m < MPAD) { u32x2* o8 = (u32x2*)(U + (size_t)m * DM) + lane;
#pragma unroll
            for (int j = 0; j < 8; ++j) o8[64 * j] = (u32x2){0u, 0u}; }
        else rms_row_to_bf16(P.mem + (size_t)(m - MPAD) * DM, P.g_mem, MEMN + (size_t)(m - MPAD) * DM, lane);
    }
}

__device__ __forceinline__ void deferred_prep(const Params& P, LAS unsigned char* lds, int G, int wave, int lane) {
    const int first = (G == 256) ? 80 : 0, nw = G - first;
    if ((int)blockIdx.x < first) return;
    LAS float* scr = (LAS float*)(lds + wave * 17408);
    const int gw = ((int)blockIdx.x - first) * 8 + wave, NGW = nw * 8;
    bf16_t* WbT = (bf16_t*)(P.ws + WS_WBT); bf16_t* WoT = (bf16_t*)(P.ws + WS_WOT);
    constexpr int I_WB = 48 * 32, I_WO = 32 * 32;
    for (int it = gw; it < I_WB + I_WO; it += NGW) {
        if (it < I_WB) p0_transpose_item<true>(P.w_branch, 2048, WbT, 3072, scr, it / 32, it % 32, lane);
        else { const int r = it - I_WB; p0_transpose_item<true>(P.w_out, 2048, WoT, 2048, scr, r / 32, r % 32, lane); }
    }
    for (int r = gw; r < NS * 14 + NS * 2; r += NGW) {
        const float* src; float* dst;
        if (r < NS * 14) { const int s = r / 14, k = r - 14 * s; src = P.st_pool + ((size_t)s * 15 + k + 1) * 1024; dst = P.out + OFF_NPS + ((size_t)s * 15 + k) * 1024; }
        else { const int q = r - NS * 14, s = q >> 1, k = q & 1; src = P.st_conv + ((size_t)s * 3 + k + 1) * 1024; dst = P.out + OFF_NCS + ((size_t)s * 3 + k) * 1024; }
#pragma unroll
        for (int j = 0; j < 4; ++j) __builtin_nontemporal_store(__builtin_nontemporal_load((const f32x4*)src + 64 * j + lane), (f32x4*)dst + 64 * j + lane);
    }
}

__device__ __forceinline__ f32x2 ldz2(const bf16_t* p) { const unsigned u = *(const unsigned*)p; return (f32x2){bf_lo(u), bf_hi(u)}; }
__device__ __forceinline__ f32x2 lds2(const LAS unsigned char* p) { const unsigned u = *(const LAS unsigned*)p; return (f32x2){bf_lo(u), bf_hi(u)}; }
__device__ __forceinline__ u32x4 mul_bf16x8(u32x4 a, u32x4 b) {
    u32x4 o; o.x = pk2(bf_lo(a.x) * bf_lo(b.x), bf_hi(a.x) * bf_hi(b.x)); o.y = pk2(bf_lo(a.y) * bf_lo(b.y), bf_hi(a.y) * bf_hi(b.y));
    o.z = pk2(bf_lo(a.z) * bf_lo(b.z), bf_hi(a.z) * bf_hi(b.z)); o.w = pk2(bf_lo(a.w) * bf_lo(b.w), bf_hi(a.w) * bf_hi(b.w)); return o;
}
__device__ __forceinline__ float one_minus_sq(float x, float a) {
    const float p = -x * (1.0f + x * (0.5f + x * 0.16666667f));
    const float d = __builtin_fmaf(-a, a, 1.0f);
    return x > -0.01f ? p : d;
}
constexpr unsigned long long GR_EMPTY = ~0ull;

template <bool SAMPLE>
__device__ __forceinline__ void rglru_unit(const Params& P, LAS unsigned char* lds, int b, int n, int c) {
    constexpr int NMT = SAMPLE ? 2 : 16;
    constexpr int NROW = NMT * 16;
    int tid_ = threadIdx.x; asm volatile("" : "+v"(tid_));
    const int tid = tid_, wid = __builtin_amdgcn_readfirstlane(tid >> 6), lane = tid & 63, fr = lane & 15, fq = lane >> 4;
    const bf16_t* Z = (const bf16_t*)(P.ws + WS_Z); bf16_t* OALL = (bf16_t*)(P.ws + WS_OALL); const bf16_t* WrgT = (const bf16_t*)(P.ws + WS_WRGT);
    unsigned long long* GR = (unsigned long long*)(P.ws + WS_GR);
    constexpr int XS = 272;
    LAS unsigned char* XR = lds; LAS unsigned char* HO = lds; LAS unsigned char* XC = lds + 259 * XS;
    const int rowbase = SAMPLE ? MP + 32 * c : b * SEQ + c * 256;
    __syncthreads();
    if (!SAMPLE) {
        u32x4 xv[9];
#pragma unroll
        for (int i = 0; i < 9; ++i) { const int v = tid + 512 * i, row = v >> 4, cv = v & 15; int t = c * 256 - 3 + row; t = t < 0 ? 0 : (t > SEQ - 1 ? SEQ - 1 : t);
            xv[i] = __builtin_nontemporal_load((const u32x4*)(Z + (size_t)(b * SEQ + t) * DIN + ZC_XR + n * 128 + cv * 8)); }
#pragma unroll
        for (int i = 0; i < 9; ++i) { const int v = tid + 512 * i, row = v >> 4, cv = v & 15; const bool neg = (c * 256 - 3 + row) < 0;
            if (row < 259) *(LAS u32x4*)(XR + row * XS + cv * 16) = neg ? (u32x4){0u, 0u, 0u, 0u} : xv[i]; }
    }
    bf16x8 wa[4], wx[4];
    { const bf16_t* pa = WrgT + ((size_t)(0 * 8 + n) * 128 + 16 * wid + fr) * 128 + 8 * fq; const bf16_t* px = WrgT + ((size_t)(1 * 8 + n) * 128 + 16 * wid + fr) * 128 + 8 * fq;
#pragma unroll
      for (int ks = 0; ks < 4; ++ks) { wa[ks] = *(const bf16x8*)(pa + 32 * ks); wx[ks] = *(const bf16x8*)(px + 32 * ks); } }
    const int e = n * 128 + 16 * wid + fr;
    const float c8 = -8.0f * log1pf(expf(-P.lam[e]));
    const float nbaL = -P.b_rg_a[e] * LOG2E, nbxL = -P.b_rg_x[e] * LOG2E, c8L = c8 * LOG2E, c82 = 2.0f * c8;
    {
      const int cp = tid & 63, seg = tid >> 6, ch = n * 128 + 2 * cp;
      const f32x2 w0 = *(const f32x2*)(P.conv_w + 0 * 1024 + ch), w1 = *(const f32x2*)(P.conv_w + 1 * 1024 + ch), w2 = *(const f32x2*)(P.conv_w + 2 * 1024 + ch), w3 = *(const f32x2*)(P.conv_w + 3 * 1024 + ch);
      const f32x2 cb = *(const f32x2*)(P.conv_b + ch);
      if (!SAMPLE) {
          __syncthreads();
          const int r0 = 32 * seg;
          f32x2 x3 = lds2(XR + (r0 + 0) * XS + 4 * cp), x2 = lds2(XR + (r0 + 1) * XS + 4 * cp), x1 = lds2(XR + (r0 + 2) * XS + 4 * cp);
#pragma unroll 8
          for (int i = 0; i < 32; ++i) { const int t = c * 256 + r0 + i;
              const f32x2 x0 = lds2(XR + (r0 + i + 3) * XS + 4 * cp);
              const f32x2 xc = cb + w0 * x3 + w1 * x2 + w2 * x1 + w3 * x0;
              *(LAS unsigned*)(XC + (r0 + i) * XS + 4 * cp) = pk2(xc.x, xc.y);
              if (t >= SEQ - 3) *(f32x2*)(P.out + OFF_NCP + (size_t)(b * 3 + (t - (SEQ - 3))) * 1024 + ch) = x0;
              x3 = x2; x2 = x1; x1 = x0; }
      } else {
#pragma unroll
          for (int i = 0; i < 4; ++i) { const int sl = 4 * seg + i, s = 32 * c + sl;
              const f32x2 x3 = *(const f32x2*)(P.st_conv + (size_t)(s * 3 + 0) * 1024 + ch), x2 = *(const f32x2*)(P.st_conv + (size_t)(s * 3 + 1) * 1024 + ch), x1 = *(const f32x2*)(P.st_conv + (size_t)(s * 3 + 2) * 1024 + ch);
              const f32x2 x0 = ldz2(Z + (size_t)(MP + s) * DIN + ZC_XR + ch);
              const f32x2 xc = cb + w0 * x3 + w1 * x2 + w2 * x1 + w3 * x0;
              *(LAS unsigned*)(XC + sl * XS + 4 * cp) = pk2(xc.x, xc.y);
              *(f32x2*)(P.out + OFF_NCS + (size_t)(s * 3 + 2) * 1024 + ch) = x0; }
      } }
    __syncthreads();
    unsigned cumA[NMT][2], hloc[NMT][2];
    float Ac = 1.f, Hc = 0.f;
#pragma unroll
    for (int mt = 0; mt < NMT; ++mt) {
        f32x4 racc = (f32x4){0.f, 0.f, 0.f, 0.f}, iacc = racc;
#pragma unroll
        for (int ks = 0; ks < 4; ++ks) { const bf16x8 a = *(const LAS bf16x8*)(XC + (16 * mt + fr) * XS + (32 * ks + 8 * fq) * 2);
            racc = __builtin_amdgcn_mfma_f32_16x16x32_bf16(a, wa[ks], racc, 0, 0, 0); iacc = __builtin_amdgcn_mfma_f32_16x16x32_bf16(a, wx[ks], iacc, 0, 0, 0); }
        float av[4], bv[4];
#pragma unroll
        for (int j = 0; j < 4; ++j) { const int row = 16 * mt + 4 * fq + j;
            const float r = __builtin_amdgcn_rcpf(1.0f + __builtin_amdgcn_exp2f(__builtin_fmaf(racc[j], -LOG2E, nbaL)));
            const float ig = __builtin_amdgcn_rcpf(1.0f + __builtin_amdgcn_exp2f(__builtin_fmaf(iacc[j], -LOG2E, nbxL)));
            av[j] = __builtin_amdgcn_exp2f(c8L * r);
            const float mult = __builtin_amdgcn_sqrtf(one_minus_sq(c82 * r, av[j]));
            const float xcv = bf2f(*(const LAS bf16_t*)(XC + row * XS + (16 * wid + fr) * 2));
            bv[j] = mult * ig * xcv; }
        if (!SAMPLE) {
            float Pj[4], Qj[4]; float pp = 1.f, qq = 0.f;
#pragma unroll
            for (int j = 0; j < 4; ++j) { qq = av[j] * qq + bv[j]; pp = av[j] * pp; Pj[j] = pp; Qj[j] = qq; }
            float Arun = Ac, Hrun = Hc, Ain = 1.f, Hin = 0.f;
#pragma unroll
            for (int g = 0; g < 4; ++g) { const float pg = __shfl(pp, fr + 16 * g), qg = __shfl(qq, fr + 16 * g); if (g == fq) { Ain = Arun; Hin = Hrun; } Hrun = pg * Hrun + qg; Arun = pg * Arun; }
            Ac = Arun; Hc = Hrun;
            cumA[mt][0] = cvt_pk_bf16(Pj[0] * Ain, Pj[1] * Ain); cumA[mt][1] = cvt_pk_bf16(Pj[2] * Ain, Pj[3] * Ain);
            hloc[mt][0] = cvt_pk_bf16(Pj[0] * Hin + Qj[0], Pj[1] * Hin + Qj[1]); hloc[mt][1] = cvt_pk_bf16(Pj[2] * Hin + Qj[2], Pj[3] * Hin + Qj[3]);
        } else {
            const int s0 = 32 * c + 16 * mt + 4 * fq;
            float hv[4];
#pragma unroll
            for (int j = 0; j < 4; ++j) { const float h0 = P.st_h[(size_t)(s0 + j) * 1024 + e]; hv[j] = av[j] * h0 + bv[j]; P.out[OFF_NHS + (size_t)(s0 + j) * 1024 + e] = hv[j]; }
            cumA[mt][0] = 0u; cumA[mt][1] = 0u; hloc[mt][0] = cvt_pk_bf16(hv[0], hv[1]); hloc[mt][1] = cvt_pk_bf16(hv[2], hv[3]);
        }
    }
    u32x4 gg[NROW / 32];
#pragma unroll
    for (int i = 0; i < NROW / 32; ++i) { const int v = tid + 512 * i, row = v >> 4, cv = v & 15; gg[i] = __builtin_nontemporal_load((const u32x4*)(Z + (size_t)(rowbase + row) * DIN + ZC_GR + n * 128 + cv * 8)); }
    float carry = 0.f;
    if (!SAMPLE) {
        unsigned long long* gbase = GR + (size_t)((b * 8 + n) * 8) * 128 + 16 * wid + fr;
        if (fq == 0) __hip_atomic_store(gbase + (size_t)c * 128, ((unsigned long long)__builtin_bit_cast(unsigned, Hc) << 32) | (unsigned long long)__builtin_bit_cast(unsigned, Ac), __ATOMIC_RELAXED, __HIP_MEMORY_SCOPE_AGENT);
        if (c > 0) {
            unsigned long long g[7]; unsigned spins = 0;
            for (;;) { bool ok = true;
#pragma unroll
                for (int cc = 0; cc < 7; ++cc) { g[cc] = __hip_atomic_load(gbase + (size_t)cc * 128, __ATOMIC_RELAXED, __HIP_MEMORY_SCOPE_AGENT); }
#pragma unroll
                for (int cc = 0; cc < 7; ++cc) ok = ok && (cc >= c || g[cc] != GR_EMPTY);
                if (__all(ok) || ++spins > (1u << 20)) break;
                __builtin_amdgcn_s_sleep(2); }
#pragma unroll
            for (int cc = 0; cc < 7; ++cc) { const float ga = __builtin_bit_cast(float, (unsigned)g[cc]), gh = __builtin_bit_cast(float, (unsigned)(g[cc] >> 32)); const float nc = ga * carry + gh; carry = (cc < c) ? nc : carry; }
        }
        if (c == 7 && fq == 0) P.out[OFF_NHP + (size_t)b * 1024 + e] = Ac * carry + Hc;
    }
#pragma unroll
    for (int mt = 0; mt < NMT; ++mt)
#pragma unroll
        for (int j = 0; j < 4; ++j) { const int row = 16 * mt + 4 * fq + j;
            const unsigned ca = cumA[mt][j >> 1], hl = hloc[mt][j >> 1];
            const float h = ((j & 1) ? bf_hi(ca) : bf_lo(ca)) * carry + ((j & 1) ? bf_hi(hl) : bf_lo(hl));
            *(LAS bf16_t*)(HO + row * XS + (16 * wid + fr) * 2) = (bf16_t)f2bf(h); }
    __syncthreads();
    {
#pragma unroll
      for (int i = 0; i < NROW / 32; ++i) { const int v = tid + 512 * i, row = v >> 4, cv = v & 15;
          const u32x4 ho = *(const LAS u32x4*)(HO + row * XS + cv * 16);
          *(u32x4*)(OALL + (size_t)(rowbase + row) * DMIX + n * 128 + cv * 8) = mul_bf16x8(ho, gg[i]); } }
}

template <bool SAMPLE>
__device__ __forceinline__ void pool_unit(const Params& P, LAS unsigned char* lds, int b, int g, int blk) {
    int tid_ = threadIdx.x; asm volatile("" : "+v"(tid_));
    const int tid = tid_, wid = __builtin_amdgcn_readfirstlane(tid >> 6), lane = tid & 63, fr = lane & 15, fq = lane >> 4;
    const bf16_t* Z = (const bf16_t*)(P.ws + WS_Z); bf16_t* OALL = (bf16_t*)(P.ws + WS_OALL); const bf16_t* WpT = (const bf16_t*)(P.ws + WS_WPT);
    constexpr int DS = 528;
    LAS unsigned char* XP = lds; LAS unsigned char* OUT = lds; LAS unsigned char* D = lds + 144 * DS;
    const int W = 2 << g;
    const int rowbase = SAMPLE ? MP + 16 * blk : b * SEQ + blk * 128;
    const int nmt = SAMPLE ? 1 : 8;
    __syncthreads();
    if (!SAMPLE) {
        u32x4 xv[9];
#pragma unroll
        for (int i = 0; i < 9; ++i) { const int v = tid + 512 * i, row = v >> 5, cv = v & 31; int t = blk * 128 - 15 + row; t = t < 0 ? 0 : (t > SEQ - 1 ? SEQ - 1 : t);
            xv[i] = __builtin_nontemporal_load((const u32x4*)(Z + (size_t)(b * SEQ + t) * DIN + ZC_XP + g * 256 + cv * 8)); }
#pragma unroll
        for (int i = 0; i < 9; ++i) { const int v = tid + 512 * i, row = v >> 5, cv = v & 31; const bool neg = (blk * 128 - 15 + row) < 0;
            *(LAS u32x4*)(XP + row * DS + cv * 16) = neg ? (u32x4){0u, 0u, 0u, 0u} : xv[i]; }
        __syncthreads();
    }
    { const int cp = tid & 127, seg = tid >> 7, ch = g * 256 + 2 * cp;
      if (!SAMPLE) {
          const int r0 = 15 + 32 * seg;
          f32x2 s = (f32x2){0.f, 0.f};
          for (int k = 1; k < W; ++k) s += lds2(XP + (r0 - k) * DS + 4 * cp);
#pragma unroll 8
          for (int i = 0; i < 32; ++i) { const int t = blk * 128 + 32 * seg + i;
              const f32x2 x0 = lds2(XP + (r0 + i) * DS + 4 * cp); s += x0;
              const float inv = 1.0f / (float)((t + 1) < W ? (t + 1) : W);
              const f32x2 d = s * inv - x0;
              *(LAS unsigned*)(D + (32 * seg + i) * DS + 4 * cp) = pk2(d.x, d.y);
              s -= lds2(XP + (r0 + i - W + 1) * DS + 4 * cp);
              if (t >= SEQ - 15) *(f32x2*)(P.out + OFF_NPP + (size_t)(b * 15 + (t - (SEQ - 15))) * 1024 + ch) = x0; }
      } else {
          const float inv = 1.0f / (float)W;
#pragma unroll
          for (int i = 0; i < 4; ++i) { const int sl = seg + 4 * i, s_ = 16 * blk + sl;
              const f32x2 x0 = ldz2(Z + (size_t)(MP + s_) * DIN + ZC_XP + ch);
              const float* hp = P.st_pool + (size_t)s_ * 15 * 1024 + ch;
              f32x2 hv[15];
#pragma unroll
              for (int k = 1; k < 16; ++k) hv[k - 1] = *(const f32x2*)(hp + (size_t)(15 - k) * 1024);
              f32x2 s = x0;
#pragma unroll
              for (int k = 1; k < 16; ++k) { const f32x2 a = s + hv[k - 1]; s = (k < W) ? a : s; }
              *(f32x2*)(P.out + OFF_NPS + ((size_t)s_ * 15 + 14) * 1024 + ch) = x0;
              const f32x2 d = s * inv - x0;
              *(LAS unsigned*)(D + sl * DS + 4 * cp) = pk2(d.x, d.y); }
      } }
    __syncthreads();
    u32x4 ggp[SAMPLE ? 1 : 8];
#pragma unroll
    for (int i = 0; i < (SAMPLE ? 1 : 8); ++i) { const int v = tid + 512 * i, row = v >> 5, cv = v & 31;
        ggp[i] = __builtin_nontemporal_load((const u32x4*)(Z + (size_t)(rowbase + row) * DIN + ZC_GP + g * 256 + cv * 8)); }
    {
      bf16x8 bw[2][8];
#pragma unroll
      for (int nt = 0; nt < 2; ++nt) { const bf16_t* pw = WpT + ((size_t)g * 256 + 32 * wid + 16 * nt + fr) * 256 + 8 * fq;
#pragma unroll
          for (int ks = 0; ks < 8; ++ks) bw[nt][ks] = *(const bf16x8*)(pw + 32 * ks); }
      const float ps0 = P.pool_scale[g * 256 + 32 * wid + fr], ps1 = P.pool_scale[g * 256 + 32 * wid + 16 + fr];
#pragma unroll 2
      for (int mt = 0; mt < nmt; ++mt) {
          f32x4 a0 = (f32x4){0.f, 0.f, 0.f, 0.f}, a1 = a0;
#pragma unroll
          for (int ks = 0; ks < 8; ++ks) { const bf16x8 a = *(const LAS bf16x8*)(D + (16 * mt + fr) * DS + (32 * ks + 8 * fq) * 2);
              a0 = __builtin_amdgcn_mfma_f32_16x16x32_bf16(a, bw[0][ks], a0, 0, 0, 0); a1 = __builtin_amdgcn_mfma_f32_16x16x32_bf16(a, bw[1][ks], a1, 0, 0, 0); }
#pragma unroll
          for (int j = 0; j < 4; ++j) { const int row = 16 * mt + 4 * fq + j;
              *(LAS bf16_t*)(OUT + row * DS + (32 * wid + fr) * 2) = (bf16_t)f2bf(a0[j] * ps0); *(LAS bf16_t*)(OUT + row * DS + (32 * wid + 16 + fr) * 2) = (bf16_t)f2bf(a1[j] * ps1); }
      } }
    __syncthreads();
#pragma unroll
    for (int i = 0; i < (SAMPLE ? 1 : 8); ++i) { const int v = tid + 512 * i, row = v >> 5, cv = v & 31;
        const u32x4 ho = *(const LAS u32x4*)(OUT + row * DS + cv * 16);
        *(u32x4*)(OALL + (size_t)(rowbase + row) * DMIX + 1024 + g * 256 + cv * 8) = mul_bf16x8(ho, ggp[i]); }
}

__device__ __forceinline__ void attn_stage(LAS unsigned char* lds, const bf16_t* src  , int wid, int lane) {
#pragma unroll
    for (int i = 0; i < 16; ++i) { const int piece = wid * 16 + i, row = 2 * piece + (lane >> 5), p = lane & 31;
        __builtin_amdgcn_global_load_lds((const unsigned*)(src + (size_t)row * 1024 + ((p ^ (row & 15)) << 3)), (LAS unsigned*)(lds + piece * 1024), 16, 0, 0); }
}
__device__ __forceinline__ void attn_unit(const Params& P, LAS unsigned char* lds, int b, int h, int blk) {
    int tid_ = threadIdx.x; asm volatile("" : "+v"(tid_));
    const int tid = tid_, wid = __builtin_amdgcn_readfirstlane(tid >> 6), lane = tid & 63, fr = lane & 15, fq = lane >> 4;
    const bf16_t* Z = (const bf16_t*)(P.ws + WS_Z); bf16_t* OALL = (bf16_t*)(P.ws + WS_OALL); const bf16_t* KB = (const bf16_t*)(P.ws + WS_KB); const bf16_t* VT = (const bf16_t*)(P.ws + WS_VT);
    const int m0 = b * SEQ + blk * 128 + 16 * wid;
    __syncthreads();
    attn_stage(lds, KB + (size_t)(b * 256) * 1024 + h * 256, wid, lane);
    bf16x8 qf[8];
    {
#pragma unroll
      for (int ks = 0; ks < 8; ++ks) qf[ks] = *(const bf16x8*)q_frag_ptr((bf16_t*)Z, m0 >> 4, ZC_Q + h * 256, ks); }
    asm volatile("s_waitcnt vmcnt(0)" ::: "memory");
    __syncthreads();
    f32x4 st[16];
#pragma unroll
    for (int t = 0; t < 16; ++t) { f32x4 a = (f32x4){0.f, 0.f, 0.f, 0.f};
#pragma unroll
        for (int ks = 0; ks < 8; ++ks) { const bf16x8 kf = *(const LAS bf16x8*)(lds + (16 * t + fr) * 512 + (((4 * ks + fq) ^ fr) << 4)); a = __builtin_amdgcn_mfma_f32_16x16x32_bf16(kf, qf[ks], a, 0, 0, 0); }
        st[t] = a; }
    __syncthreads();
    attn_stage(lds, VT + (size_t)(h * 256) * 1024 + b * 256, wid, lane);
    float mx = -3.0e38f;
#pragma unroll
    for (int t = 0; t < 16; ++t) mx = fmaxf(mx, fmaxf(fmaxf(st[t][0], st[t][1]), fmaxf(st[t][2], st[t][3])));
    mx = fmaxf(mx, __shfl_xor(mx, 16)); mx = fmaxf(mx, __shfl_xor(mx, 32));
    const float sc = LOG2E * 0.0625f; float sum = 0.f;
#pragma unroll
    for (int t = 0; t < 16; ++t)
#pragma unroll
        for (int j = 0; j < 4; ++j) { const float p = __builtin_amdgcn_exp2f((st[t][j] - mx) * sc); st[t][j] = p; sum += p; }
    sum += __shfl_xor(sum, 16); sum += __shfl_xor(sum, 32);
    const float inv = 1.0f / sum;
    bf16x8 pf[8];
#pragma unroll
    for (int s = 0; s < 8; ++s) { u32x4 w; w.x = cvt_pk_bf16(st[2 * s][0], st[2 * s][1]); w.y = cvt_pk_bf16(st[2 * s][2], st[2 * s][3]); w.z = cvt_pk_bf16(st[2 * s + 1][0], st[2 * s + 1][1]); w.w = cvt_pk_bf16(st[2 * s + 1][2], st[2 * s + 1][3]);
        pf[s] = __builtin_bit_cast(bf16x8, w); }
    asm volatile("s_waitcnt vmcnt(0)" ::: "memory");
    __syncthreads();
    u32x4 gg[8];
#pragma unroll
    for (int i = 0; i < 8; ++i) { const int v = lane + 64 * i, row = v >> 5, cv = v & 31; gg[i] = __builtin_nontemporal_load((const u32x4*)(Z + (size_t)(m0 + row) * DIN + ZC_GX + h * 256 + cv * 8)); }
    u32x2 ov[16];
#pragma unroll
    for (int dt = 0; dt < 16; ++dt) { f32x4 a = (f32x4){0.f, 0.f, 0.f, 0.f};
#pragma unroll
        for (int s = 0; s < 8; ++s) { const LAS unsigned char* rp = lds + (16 * dt + fr) * 512 + 8 * (fq & 1);
            const u32x2 lo = *(const LAS u32x2*)(rp + (((4 * s + (fq >> 1)) ^ fr) << 4)), hi = *(const LAS u32x2*)(rp + (((4 * s + 2 + (fq >> 1)) ^ fr) << 4));
            const u32x4 w = (u32x4){lo.x, lo.y, hi.x, hi.y};
            a = __builtin_amdgcn_mfma_f32_16x16x32_bf16(__builtin_bit_cast(bf16x8, w), pf[s], a, 0, 0, 0); }
        ov[dt].x = pk2(a[0] * inv, a[1] * inv); ov[dt].y = pk2(a[2] * inv, a[3] * inv); }
    __syncthreads();
#pragma unroll
    for (int dt = 0; dt < 16; ++dt) *(LAS u32x2*)(lds + (16 * wid + fr) * 528 + (16 * dt + 4 * fq) * 2) = ov[dt];
    asm volatile("s_waitcnt lgkmcnt(0)" ::: "memory");
    {
#pragma unroll
      for (int i = 0; i < 8; ++i) { const int v = lane + 64 * i, row = v >> 5, cv = v & 31;
          const u32x4 ho = *(const LAS u32x4*)(lds + (16 * wid + row) * 528 + cv * 16);
          *(u32x4*)(OALL + (size_t)(m0 + row) * DMIX + 2048 + h * 256 + cv * 8) = mul_bf16x8(ho, gg[i]); } }
}

__device__ __forceinline__ void sattn_unit(const Params& P, LAS unsigned char* lds, int s, int h) {
    int tid_ = threadIdx.x; asm volatile("" : "+v"(tid_));
    const int tid = tid_, wid = __builtin_amdgcn_readfirstlane(tid >> 6), lane = tid & 63;
    const bf16_t* Z = (const bf16_t*)(P.ws + WS_Z); bf16_t* OALL = (bf16_t*)(P.ws + WS_OALL);
    LAS float* SC = (LAS float*)lds; LAS float* PS = SC + 256; LAS float* PO = PS + 256;
    __syncthreads();
    f32x4 q4;
    { const u32x2 qq = *(const u32x2*)(Z + (size_t)(MP + s) * DIN + ZC_Q + h * 256 + 4 * lane); q4 = (f32x4){bf_lo(qq.x), bf_hi(qq.x), bf_lo(qq.y), bf_hi(qq.y)}; }
    const float* kb = P.cache_k + ((size_t)(s * 256 + 32 * wid) * 4 + h) * 256 + 4 * lane;
    const float* vb = P.cache_v + ((size_t)(s * 256 + 32 * wid) * 4 + h) * 256 + 4 * lane;
    float mysc = 0.f;
    f32x4 v4[32];
    { f32x4 k4[32];
#pragma unroll
      for (int i = 0; i < 32; ++i) k4[i] = __builtin_nontemporal_load((const f32x4*)(kb + (size_t)i * 1024));
#pragma unroll
      for (int i = 0; i < 16; ++i) v4[i] = __builtin_nontemporal_load((const f32x4*)(vb + (size_t)i * 1024));
      float p[32];
#pragma unroll
      for (int i = 0; i < 32; ++i) p[i] = (k4[i].x * q4.x + k4[i].y * q4.y) + (k4[i].z * q4.z + k4[i].w * q4.w);
      float q16[16], q8[8], q4v[4], q2[2];
      { const bool hi = (lane & 32) != 0;
#pragma unroll
        for (int j = 0; j < 16; ++j) { const float send = hi ? p[j] : p[j + 16], keep = hi ? p[j + 16] : p[j]; q16[j] = keep + __shfl_xor(send, 32); } }
      { const bool hi = (lane & 16) != 0;
#pragma unroll
        for (int j = 0; j < 8; ++j) { const float send = hi ? q16[j] : q16[j + 8], keep = hi ? q16[j + 8] : q16[j]; q8[j] = keep + __shfl_xor(send, 16); } }
      { const bool hi = (lane & 8) != 0;
#pragma unroll
        for (int j = 0; j < 4; ++j) { const float send = hi ? q8[j] : q8[j + 4], keep = hi ? q8[j + 4] : q8[j]; q4v[j] = keep + __shfl_xor(send, 8); } }
      { const bool hi = (lane & 4) != 0;
#pragma unroll
        for (int j = 0; j < 2; ++j) { const float send = hi ? q4v[j] : q4v[j + 2], keep = hi ? q4v[j + 2] : q4v[j]; q2[j] = keep + __shfl_xor(send, 4); } }
      { const bool hi = (lane & 2) != 0; const float send = hi ? q2[0] : q2[1], keep = hi ? q2[1] : q2[0]; mysc = keep + __shfl_xor(send, 2); }
      mysc += __shfl_xor(mysc, 1); }
#pragma unroll
    for (int i = 16; i < 32; ++i) v4[i] = __builtin_nontemporal_load((const f32x4*)(vb + (size_t)i * 1024));
    if ((lane & 1) == 0) SC[32 * wid + (lane >> 1)] = mysc;
    __syncthreads();
    { float v[4]; float mx = -3.0e38f;
#pragma unroll
      for (int k = 0; k < 4; ++k) { v[k] = SC[lane + 64 * k]; mx = fmaxf(mx, v[k]); }
      mx = wave_max(mx); float sum = 0.f; const float sc = LOG2E * 0.0625f;
#pragma unroll
      for (int k = 0; k < 4; ++k) { v[k] = __builtin_amdgcn_exp2f((v[k] - mx) * sc); sum += v[k]; }
      sum = wave_sum(sum); const float inv = 1.0f / sum;
      if (wid == 0) {
#pragma unroll
          for (int k = 0; k < 4; ++k) PS[lane + 64 * k] = v[k] * inv; } }
    __syncthreads();
    { f32x4 a = (f32x4){0.f, 0.f, 0.f, 0.f};
#pragma unroll
      for (int i = 0; i < 32; ++i) { const float p = PS[32 * wid + i]; a += v4[i] * p; }
      *(LAS f32x4*)(PO + wid * 256 + 4 * lane) = a; }
    __syncthreads();
    if (tid < 256) { float o = 0.f;
#pragma unroll
        for (int w = 0; w < 8; ++w) o += PO[w * 256 + tid];
        const float gx = bf2f(Z[(size_t)(MP + s) * DIN + ZC_GX + h * 256 + tid]);
        OALL[(size_t)(MP + s) * DMIX + 2048 + h * 256 + tid] = (bf16_t)f2bf(o * gx); }
}

__device__ __forceinline__ void p5_rows(const Params& P, int m0, int mstep, int mend, int lane) {
    const bf16_t* OUTB = (const bf16_t*)(P.ws + WS_OUTB);
    for (int m = m0; m < mend; m += mstep) {
        const u32x4* orow = (const u32x4*)(OUTB + (size_t)m * DM) + lane;
        const f32x4* xrow = (const f32x4*)(m < MP ? P.x_prompt + (size_t)m * DM : P.x_sample + (size_t)(m - MP) * DM) + 2 * lane;
        const f32x4* gr = (const f32x4*)P.g_post + 2 * lane;
        u32x4 v[4]; f32x4 xa[4], xb[4]; float s = 0.f;
#pragma unroll
        for (int j = 0; j < 4; ++j) { v[j] = orow[64 * j]; xa[j] = xrow[128 * j]; xb[j] = xrow[128 * j + 1]; }
#pragma unroll
        for (int j = 0; j < 4; ++j) { const float a0 = bf_lo(v[j].x), a1 = bf_hi(v[j].x), a2 = bf_lo(v[j].y), a3 = bf_hi(v[j].y), a4 = bf_lo(v[j].z), a5 = bf_hi(v[j].z), a6 = bf_lo(v[j].w), a7 = bf_hi(v[j].w);
            s += ((a0 * a0 + a1 * a1) + (a2 * a2 + a3 * a3)) + ((a4 * a4 + a5 * a5) + (a6 * a6 + a7 * a7)); }
        const float rs = 1.0f / sqrtf(wave_sum(s) * (1.0f / DM) + EPS);
        f32x4* yrow = (f32x4*)(P.out + OFF_Y + (size_t)m * DM) + 2 * lane;
#pragma unroll
        for (int j = 0; j < 4; ++j) { const f32x4 g0 = gr[128 * j], g1 = gr[128 * j + 1];
            const f32x4 o0 = (f32x4){bf_lo(v[j].x), bf_hi(v[j].x), bf_lo(v[j].y), bf_hi(v[j].y)}, o1 = (f32x4){bf_lo(v[j].z), bf_hi(v[j].z), bf_lo(v[j].w), bf_hi(v[j].w)};
            yrow[128 * j] = xa[j] + o0 * rs * g0; yrow[128 * j + 1] = xb[j] + o1 * rs * g1; }
    }
}

__global__ void __launch_bounds__(512, 2) fwd_kernel(Params P) {
    extern __shared__ __attribute__((aligned(16))) unsigned char lds_raw[];
    LAS unsigned char* lds = (LAS unsigned char*)lds_raw;
    cg::grid_group grid = cg::this_grid();
    const int tid = threadIdx.x, lane = tid & 63, wave = __builtin_amdgcn_readfirstlane(tid >> 6);
    const int G = gridDim.x;
    const int lo = P.ph_lo, hi = P.ph_hi;
    volatile LAS unsigned* MISC = (volatile LAS unsigned*)(lds + LDS_MISC_OFF);
    if (tid < 16) MISC[tid] = 0u;
    __syncthreads();
    const XcdBarrier xbar = xcd_barrier_post((unsigned*)(P.ws + WS_CTL), MISC);
#define GSYNC(k) do { if (USE_CG_SEAM(k)) grid.sync(); else xcd_barrier(xbar); } while (0)
#define IN(k) (lo <= (k) && (k) < hi)
#define BOTH(k) (IN(k) && IN((k) + 1))
    if (IN(0)) { if (PROBE_REPEAT == 0) { p0_prologue(P, lds, G, wave, lane); GSYNC(9); } p0_prologue(P, lds, G, wave, lane); if (BOTH(0)) GSYNC(0); }
    if (IN(1)) {
        SchedP1 S; S.mode = 0; S.G = G; S.c = blockIdx.x; S.to.init(32, 48); S.U = (const char*)(P.ws + WS_U); S.WinT = (const char*)(P.ws + WS_WINT); S.MEMN = (const char*)(P.ws + WS_MEMN); S.WkvT = (const char*)(P.ws + WS_WKVT);
        EpiP1T<false> E; E.Z = (bf16_t*)(P.ws + WS_Z); E.out = P.out; E.KB = (bf16_t*)(P.ws + WS_KB); E.VT = (bf16_t*)(P.ws + WS_VT); E.slabs = (float*)(P.ws + WS_OALL); E.cnt = (unsigned*)(P.ws + WS_CTL) + CW_CNT + 64 * CNT_P1S; E.misc = MISC; E.done = (unsigned*)(P.ws + WS_CTL) + CW_DONE;
        if (PROBE_REPEAT == 1) { pg8::gemm_phase<EpiP1T<false>, SchedP1>(lds, 2048, 0, S, E); GSYNC(9); }
        pg8::gemm_phase<EpiP1T<false>, SchedP1>(lds, 2048, 0, S, E);
        if (BOTH(1)) GSYNC(9);
    }
    if (IN(2)) {
        constexpr int U_RGP = 256, U_RGS = 32, U_ATT = 256, U_PP = 256, U_PS = 32, U_SA = 512;
        constexpr int NU = U_RGP + U_RGS + U_ATT + U_PP + U_PS + U_SA;
        unsigned* done = (unsigned*)(P.ws + WS_CTL) + CW_DONE;
        { SchedP1 S; S.mode = 1; S.G = G; S.c = blockIdx.x; S.to.init(32, 48); S.U = (const char*)(P.ws + WS_U); S.WinT = (const char*)(P.ws + WS_WINT); S.MEMN = (const char*)(P.ws + WS_MEMN); S.WkvT = (const char*)(P.ws + WS_WKVT);
          EpiP1T<true> E; E.Z = (bf16_t*)(P.ws + WS_Z); E.out = P.out; E.KB = (bf16_t*)(P.ws + WS_KB); E.VT = (bf16_t*)(P.ws + WS_VT); E.slabs = (float*)(P.ws + WS_PART); E.cnt = (unsigned*)(P.ws + WS_CTL) + CW_CNT + 64 * CNT_P1S; E.misc = MISC; E.done = done;
          pg8::gemm_phase<EpiP1T<true>, SchedP1>(lds, 2048, 0, S, E); }
        if (G == 256) {
            const int c = blockIdx.x;
            deferred_prep(P, lds, G, wave, lane);
            pool_unit<false>(P, lds, c >> 6, (c >> 4) & 3, c & 15);
            rglru_unit<false>(P, lds, c >> 6, (c >> 3) & 7, c & 7);
            wait_done(done);
            attn_unit(P, lds, c >> 6, (c >> 4) & 3, c & 15);
            {
              const int s0 = c < 80 ? c : (c < 160 ? 80 + 3 * (c - 80) : 320 + 2 * (c - 160)), ns = c < 80 ? 1 : (c < 160 ? 3 : 2);
              for (int k = 0; k < ns; ++k) sattn_unit(P, lds, (s0 + k) >> 2, (s0 + k) & 3); }
            if (c >= 224) rglru_unit<true>(P, lds, 0, (c - 224) >> 2, (c - 224) & 3);
            else if (c >= 192) pool_unit<true>(P, lds, 0, (c - 192) >> 3, (c - 192) & 7);
        } else {
        deferred_prep(P, lds, G, wave, lane);
        wait_done(done);
        for (int u = blockIdx.x; u < NU; u += G) {
            int r = u;
            if (r < U_RGP) { rglru_unit<false>(P, lds, r >> 6, (r >> 3) & 7, r & 7); continue; } r -= U_RGP;
            if (r < U_RGS) { rglru_unit<true>(P, lds, 0, r >> 2, r & 3); continue; } r -= U_RGS;
            if (r < U_ATT) { attn_unit(P, lds, r >> 6, (r >> 4) & 3, r & 15); continue; } r -= U_ATT;
            if (r < U_PP) { pool_unit<false>(P, lds, r >> 6, (r >> 4) & 3, r & 15); continue; } r -= U_PP;
            if (r < U_PS) { pool_unit<true>(P, lds, 0, r >> 3, r & 7); continue; } r -= U_PS;
            sattn_unit(P, lds, r >> 2, r & 3);
        }
        }
        __syncthreads();
        if (BOTH(2)) GSYNC(9);
    }
    if (IN(3)) {
        SchedP3 S; S.G = G; S.c = blockIdx.x; S.to.init(32, 8); S.OALL = (const char*)(P.ws + WS_OALL); S.WbT = (const char*)(P.ws + WS_WBT);
        EpiP3 E; E.Z = (const bf16_t*)(P.ws + WS_Z); E.PART = (bf16_t*)(P.ws + WS_PART); E.MERGED = (bf16_t*)(P.ws + WS_MERGED); E.slabs = (float*)(P.ws + WS_U); E.cnt = (unsigned*)(P.ws + WS_CTL) + CW_CNT + 64 * CNT_P3S; E.misc = MISC; E.done3 = (unsigned*)(P.ws + WS_CTL) + CW_DONE + 128;
        pg8::gemm_phase<EpiP3, SchedP3>(lds, DMIX, 0, S, E);
        if (BOTH(3) && !IN(4)) GSYNC(9);
    }
    if (IN(4)) {
        SchedP4 S; S.G = G; S.c = blockIdx.x; S.to.init(32, 8); S.MERGED = (const char*)(P.ws + WS_MERGED); S.WoT = (const char*)(P.ws + WS_WOT); S.done3 = (unsigned*)(P.ws + WS_CTL) + CW_DONE + 128;
        { pg8::Unit u0; if (S.next(0, u0)) { if (tid == 0) poll_count(S.done3 + 64 * u0.pm, u0.kind == 0 ? 8u : 96u); } __syncthreads(); }
        EpiP4 E; E.OUTF = (bf16_t*)(P.ws + WS_OUTB); E.slabs = (float*)(P.ws + WS_U + 24 * MiB); E.cnt = (unsigned*)(P.ws + WS_CTL) + CW_CNT + 64 * CNT_P4S; E.misc = MISC; E.done4 = (unsigned*)(P.ws + WS_CTL) + CW_DONE4;
        pg8::gemm_phase<EpiP4, SchedP4>(lds, 0, 0, S, E);
        if (BOTH(4) && G != 256) GSYNC(9);
    }
    if (IN(5)) {
        if (G == 256 && IN(4)) {
            unsigned* done4 = (unsigned*)(P.ws + WS_CTL) + CW_DONE4;
            pg8::TileOrder to; to.init(32, 8); int pm, pn; to.map(blockIdx.x, pm, pn);
            if (tid == 0) poll_count(done4 + 64 * pm, 8u);
            __syncthreads();
            p5_rows(P, pm * 256 + pn * 32 + wave, 8, pm * 256 + pn * 32 + 32, lane);
            if (pm >= 16 && pm < 18) {
                const int sr = ((pm - 16) * 8 + pn) * 8;
                if (tid == 0) poll_count(done4 + 64 * 32, 32u);
                __syncthreads();
                p5_rows(P, MP + sr + wave, 8, MP + sr + 8, lane);
            }
        } else p5_rows(P, blockIdx.x * 8 + wave, G * 8, MTOT, lane);
    }
#undef IN
#undef BOTH
}

extern "C" void kernel_launch(void* const* d_in, const int* in_sizes, int n_in, void* d_out, int out_size, void* d_ws, size_t ws_size, hipStream_t stream) {
    static int grid = 0;
    if (grid == 0) {
        if (n_in != 24 || (size_t)out_size != OUT_TOTAL || ws_size < WS_END) { fprintf(stderr, "kernel_launch: unexpected problem (n_in %d, out %d, ws %zu); nothing launched\n", n_in, out_size, ws_size); grid = -1; return; }
        int dev = 0, cus = 0, per_cu = 0;
        if (hipGetDevice(&dev) != hipSuccess || hipDeviceGetAttribute(&cus, hipDeviceAttributeMultiprocessorCount, dev) != hipSuccess) { grid = -1; return; }
        if (hipFuncSetAttribute((const void*)fwd_kernel, hipFuncAttributeMaxDynamicSharedMemorySize, LDS_BYTES) != hipSuccess) { fprintf(stderr, "kernel_launch: hipFuncSetAttribute failed\n"); grid = -1; return; }
        if (hipOccupancyMaxActiveBlocksPerMultiprocessor(&per_cu, (const void*)fwd_kernel, 512, LDS_BYTES) != hipSuccess || per_cu < 1) { fprintf(stderr, "kernel_launch: occupancy query failed (%d)\n", per_cu); (void)hipGetLastError(); grid = -1; return; }
        grid = cus * per_cu;
    }
    if (grid < 0) return;
    Params p{};
    p.x_prompt = (const float*)d_in[0]; p.x_sample = (const float*)d_in[1]; p.mem = (const float*)d_in[2]; p.st_h = (const float*)d_in[3]; p.st_conv = (const float*)d_in[4]; p.st_pool = (const float*)d_in[5];
    p.cache_k = (const float*)d_in[6]; p.cache_v = (const float*)d_in[7]; p.g_pre = (const float*)d_in[8]; p.w_in = (const float*)d_in[9]; p.conv_w = (const float*)d_in[10]; p.conv_b = (const float*)d_in[11];
    p.w_rg_a = (const float*)d_in[12]; p.b_rg_a = (const float*)d_in[13]; p.w_rg_x = (const float*)d_in[14]; p.b_rg_x = (const float*)d_in[15]; p.lam = (const float*)d_in[16]; p.w_pool = (const float*)d_in[17];
    p.pool_scale = (const float*)d_in[18]; p.g_mem = (const float*)d_in[19]; p.w_kv = (const float*)d_in[20]; p.w_branch = (const float*)d_in[21]; p.w_out = (const float*)d_in[22]; p.g_post = (const float*)d_in[23];
    p.out = (float*)d_out; p.ws = (unsigned char*)d_ws;
    if (hipMemsetAsync((char*)d_ws + WS_CTL, 0, CTL_ZERO_BYTES, stream) != hipSuccess) { fprintf(stderr, "kernel_launch: memset failed\n"); return; }
#if MK_N_LAUNCHES == 1
    p.ph_lo = 0; p.ph_hi = 6;
    void* args[] = {&p};
    hipError_t e = hipLaunchCooperativeKernel((const void*)fwd_kernel, dim3(grid), dim3(512), args, LDS_BYTES, stream);
    if (e != hipSuccess) fprintf(stderr, "kernel_launch: cooperative launch failed: %s (grid %d)\n", hipGetErrorString(e), grid);
#else
    for (int ph = 0; ph < 6; ++ph) { p.ph_lo = ph; p.ph_hi = ph + 1; hipLaunchKernelGGL(fwd_kernel, dim3(grid), dim3(512), LDS_BYTES, stream, p); }
#endif
}
```
